# Optimizing an MI355X kernel written in HIP

```python
import math
import numpy as np
import jax
import jax.numpy as jnp
from jax import lax

D_MODEL = 1024
BATCH = 4
SEQ = 4096
DEPTH = 4

HEAD_DIM = 64
Q_BLOCK = 128
EPS = 1e-6
NEG = -1e30

DIFF_HEADS = D_MODEL // 256
DIFF_VDIM = 2 * HEAD_DIM

NSA_HEADS = D_MODEL // 128
NSA_GROUPS = max(1, NSA_HEADS // 4)
NSA_HPG = NSA_HEADS // NSA_GROUPS
CMP_BLOCK = 32
CMP_STRIDE = 16
CMP_HIDDEN = 2 * HEAD_DIM
SLC_BLOCK = 64
SLC_TOPK = 16
WINDOW = 512
FORCE_BONUS = 1e4

FOX_HEADS = D_MODEL // HEAD_DIM

N_EXPERTS = 32
TOP_K = 4
D_FF = D_MODEL
SWIGLU_LIMIT = 7.0
SWIGLU_ALPHA = 1.702
MOE_BLOCK = 512

N_EVEN = (DEPTH + 1) // 2
N_ODD = DEPTH // 2

DIFF_QK = DIFF_HEADS * 2 * HEAD_DIM
DIFF_V = DIFF_HEADS * DIFF_VDIM
NSA_Q = NSA_HEADS * HEAD_DIM
NSA_KV = NSA_GROUPS * HEAD_DIM
NSA_GATE = 3 * NSA_HEADS
EVEN_WIDTHS = (DIFF_QK, DIFF_QK, DIFF_V, NSA_Q, NSA_KV, NSA_KV, NSA_KV, NSA_KV, NSA_KV, NSA_KV, NSA_GATE)
EVEN_IN = sum(EVEN_WIDTHS)
EVEN_MIX = DIFF_V + NSA_Q
FOX_W = FOX_HEADS * HEAD_DIM
ODD_IN = 3 * FOX_W + FOX_HEADS

kernel_name = 'hybrid_diff_nsa_fox_moe_adaln'


def rmsnorm(x, g):
    xf = x.astype(jnp.float32)
    y = xf * lax.rsqrt(jnp.mean(xf * xf, axis=-1, keepdims=True) + EPS)
    return (y * g.astype(jnp.float32)).astype(x.dtype)


def alibi_slopes(n):
    return jnp.asarray(2.0 ** (-8.0 * np.arange(1, n + 1) / n), dtype=jnp.float32)


def masked_softmax(s, mask):
    s = jnp.where(mask, s.astype(jnp.float32), NEG)
    m = jnp.max(s, axis=-1, keepdims=True)
    p = jnp.where(mask, jnp.exp(s - m), 0.0)
    return p / jnp.maximum(jnp.sum(p, axis=-1, keepdims=True), 1e-30)


def sweep_query_blocks(fn, *arrays):
    B, S = arrays[0].shape[:2]
    nb = S // Q_BLOCK
    blocked = tuple(jnp.swapaxes(a.reshape(B, nb, Q_BLOCK, *a.shape[2:]), 0, 1) for a in arrays)
    out = lax.map(lambda args: fn(args[0], *args[1:]), (jnp.arange(nb), *blocked))
    return jnp.swapaxes(out, 0, 1).reshape(B, S, *out.shape[3:])


def diff_attention(q, k, v, lam, lam_init, subln_g):
    B, S, H, _, Dh = q.shape
    scale = Dh ** -0.5
    slopes = alibi_slopes(H)
    kpos = jnp.arange(S)

    def block(i, qb):
        qpos = i * Q_BLOCK + jnp.arange(Q_BLOCK)
        dist = (qpos[:, None] - kpos[None, :]).astype(jnp.float32)
        bias = -slopes[:, None, None] * jnp.abs(dist)
        s = jnp.einsum('bqhcd,bkhcd->bhcqk', qb, k).astype(jnp.float32) * scale + bias[None, :, None]
        p = jax.nn.softmax(jnp.where(dist >= 0, s, NEG), axis=-1)
        p = p[:, :, 0] - lam * p[:, :, 1]
        return jnp.einsum('bhqk,bkhe->bqhe', p.astype(v.dtype), v)

    o = sweep_query_blocks(block, q)
    o = rmsnorm(o, subln_g) * (1.0 - lam_init)
    return o.reshape(B, S, H * v.shape[-1])


def compress_blocks(x, blk_idx, pos_emb, w1, w2):
    B, _, G, Dh = x.shape
    blocks = x[:, blk_idx] + pos_emb[:, None, :]
    blocks = jnp.moveaxis(blocks, 3, 2).reshape(B, blk_idx.shape[0], G, -1)
    return jax.nn.silu(blocks @ w1) @ w2


def nsa_attention(q, kc, vc, ks, vs, kw, vw, gate_logits, cmp_pos, cmp_w1, cmp_w2):
    B, S, G, Hg, Dh = q.shape
    scale = Dh ** -0.5
    slopes = alibi_slopes(G * Hg).reshape(G, Hg)
    pos = jnp.arange(S)

    n_cmp = (S - CMP_BLOCK) // CMP_STRIDE + 1
    blk_idx = np.arange(n_cmp)[:, None] * CMP_STRIDE + np.arange(CMP_BLOCK)[None, :]
    k_cmp = compress_blocks(kc, blk_idx, cmp_pos[0], cmp_w1[0], cmp_w2[0])
    v_cmp = compress_blocks(vc, blk_idx, cmp_pos[1], cmp_w1[1], cmp_w2[1])
    cend = jnp.asarray(blk_idx[:, -1])
    dist_c = (pos[:, None] - cend[None, :]).astype(jnp.float32)
    s_c = jnp.einsum('bsghd,bngd->bghsn', q, k_cmp).astype(jnp.float32) * scale \
        - slopes[:, :, None, None] * dist_c
    p_c = masked_softmax(s_c, dist_c >= 0)
    o_cmp = jnp.einsum('bghsn,bngd->bsghd', p_c.astype(v_cmp.dtype), v_cmp)

    n_slc = S // SLC_BLOCK
    top = min(SLC_TOPK, n_slc)
    ci = np.arange(n_cmp)[:, None] * CMP_STRIDE
    sj = np.arange(n_slc)[None, :] * SLC_BLOCK
    overlap = jnp.asarray(((ci < sj + SLC_BLOCK) & (ci + CMP_BLOCK > sj)).astype(np.float32))
    imp = jnp.einsum('bghsn,nj->bgsj', p_c, overlap)
    blk = jnp.arange(n_slc)[None, :]
    cur = (pos // SLC_BLOCK)[:, None]
    avail = blk <= cur
    forced = (blk == 0) | (blk == cur) | (blk == cur - 1)
    score = jnp.where(avail, imp + jnp.where(forced, FORCE_BONUS, 0.0), NEG)
    top_s, top_i = lax.top_k(score, top)
    top_i = jnp.swapaxes(top_i, 1, 2)
    top_valid = jnp.swapaxes(top_s > 0.5 * NEG, 1, 2)

    ks_b = jnp.moveaxis(ks.reshape(B, n_slc, SLC_BLOCK, G, Dh), 3, 1)
    vs_b = jnp.moveaxis(vs.reshape(B, n_slc, SLC_BLOCK, G, Dh), 3, 1)
    bi = jnp.arange(B)[:, None, None, None]
    gi = jnp.arange(G)[None, :, None, None]
    within = jnp.arange(SLC_BLOCK)

    def slc_block(i, qb, ib, vb):
        ib = jnp.swapaxes(ib, 1, 2)
        vb = jnp.swapaxes(vb, 1, 2)
        kg = ks_b[bi, gi, ib]
        vg = vs_b[bi, gi, ib]
        qpos = i * Q_BLOCK + jnp.arange(Q_BLOCK)
        kpos = ib[..., None] * SLC_BLOCK + within
        d = (qpos[None, None, :, None, None] - kpos).astype(jnp.float32)
        mask = (vb[..., None] & (d >= 0)).reshape(B, G, 1, Q_BLOCK, top * SLC_BLOCK)
        s = jnp.einsum('btghd,bgtmld->bghtml', qb, kg).astype(jnp.float32) * scale \
            - slopes[None, :, :, None, None, None] * d[:, :, None]
        p = masked_softmax(s.reshape(B, G, Hg, Q_BLOCK, top * SLC_BLOCK), mask)
        vg = vg.reshape(B, G, Q_BLOCK, top * SLC_BLOCK, Dh)
        return jnp.einsum('bghtk,bgtkd->btghd', p.astype(vg.dtype), vg)

    o_slc = sweep_query_blocks(slc_block, q, top_i, top_valid)

    kw_p = jnp.pad(kw, ((0, 0), (WINDOW, 0), (0, 0), (0, 0)))
    vw_p = jnp.pad(vw, ((0, 0), (WINDOW, 0), (0, 0), (0, 0)))
    span = WINDOW + Q_BLOCK

    def win_block(i, qb):
        start = i * Q_BLOCK
        kb = lax.dynamic_slice_in_dim(kw_p, start, span, axis=1)
        vb = lax.dynamic_slice_in_dim(vw_p, start, span, axis=1)
        qpos = start + jnp.arange(Q_BLOCK)
        kpos = start - WINDOW + jnp.arange(span)
        d = (qpos[:, None] - kpos[None, :]).astype(jnp.float32)
        mask = (d >= 0) & (d < WINDOW) & (kpos >= 0)[None, :]
        s = jnp.einsum('btghd,bkgd->bghtk', qb, kb).astype(jnp.float32) * scale \
            - slopes[:, :, None, None] * d
        p = masked_softmax(s, mask)
        return jnp.einsum('bghtk,bkgd->btghd', p.astype(vb.dtype), vb)

    o_win = sweep_query_blocks(win_block, q)

    g = jax.nn.sigmoid(gate_logits.astype(jnp.float32))
    o = g[..., 0:1] * o_cmp + g[..., 1:2] * o_slc + g[..., 2:3] * o_win
    return o.astype(q.dtype).reshape(B, S, G * Hg * Dh)


def even_mixer(h, w_in, w_out, lam_p, subln_g, cmp_pos, cmp_w1, cmp_w2, gate_b, lam_init):
    B, S, _ = h.shape
    splits = np.cumsum(EVEN_WIDTHS)[:-1].tolist()
    aq, ak, av, bq, bkc, bvc, bks, bvs, bkw, bvw, bg = jnp.split(h @ w_in, splits, axis=-1)
    aq = aq.reshape(B, S, DIFF_HEADS, 2, HEAD_DIM)
    ak = ak.reshape(B, S, DIFF_HEADS, 2, HEAD_DIM)
    av = av.reshape(B, S, DIFF_HEADS, DIFF_VDIM)
    lam_p = lam_p.astype(jnp.float32)
    lam = jnp.exp(jnp.sum(lam_p[0] * lam_p[1])) - jnp.exp(jnp.sum(lam_p[2] * lam_p[3])) + lam_init
    o_a = diff_attention(aq, ak, av, lam, lam_init, subln_g)

    def kv(t):
        return t.reshape(B, S, NSA_GROUPS, HEAD_DIM)

    o_b = nsa_attention(bq.reshape(B, S, NSA_GROUPS, NSA_HPG, HEAD_DIM),
                        kv(bkc), kv(bvc), kv(bks), kv(bvs), kv(bkw), kv(bvw),
                        (bg + gate_b).reshape(B, S, NSA_GROUPS, NSA_HPG, 3),
                        cmp_pos, cmp_w1, cmp_w2)
    return jnp.concatenate([o_a, o_b], axis=-1) @ w_out


def forgetting_attention(q, k, v, f_logit):
    B, S, H, Dh = q.shape
    scale = Dh ** -0.5
    cum = jnp.cumsum(jax.nn.log_sigmoid(f_logit.astype(jnp.float32)), axis=1)
    cum_k = jnp.swapaxes(cum, 1, 2)
    kpos = jnp.arange(S)

    def block(i, qb, cb):
        qpos = i * Q_BLOCK + jnp.arange(Q_BLOCK)
        decay = jnp.swapaxes(cb, 1, 2)[..., None] - cum_k[:, :, None, :]
        s = jnp.einsum('bqhd,bkhd->bhqk', qb, k).astype(jnp.float32) * scale + decay
        s = jnp.where((qpos[:, None] >= kpos[None, :]), s, NEG)
        p = jax.nn.softmax(s, axis=-1)
        return jnp.einsum('bhqk,bkhd->bqhd', p.astype(v.dtype), v)

    return sweep_query_blocks(block, q, cum)


def odd_mixer(h, w_in, w_out, f_b):
    B, S, _ = h.shape
    q, k, v, f = jnp.split(h @ w_in, [FOX_W, 2 * FOX_W, 3 * FOX_W], axis=-1)
    shp = (B, S, FOX_HEADS, HEAD_DIM)
    o = forgetting_attention(q.reshape(shp), k.reshape(shp), v.reshape(shp), f + f_b)
    return o.reshape(B, S, FOX_W) @ w_out


def moe(h, router_w, router_b, w_gate, b_gate, w_up, b_up, w_down, b_down):
    B, S, D = h.shape
    x = h.reshape(-1, D)
    T = x.shape[0]
    logits = (x @ router_w + router_b).astype(jnp.float32)
    top_val, top_idx = lax.top_k(logits, TOP_K)
    gate = jax.nn.softmax(top_val, axis=-1)
    e_flat = top_idx.reshape(-1)
    g_flat = gate.reshape(-1)
    tok_flat = jnp.repeat(jnp.arange(T), TOP_K)
    M = T * TOP_K
    order = jnp.argsort(e_flat)
    e_sorted = e_flat[order]
    counts = jnp.bincount(e_flat, length=N_EXPERTS)
    starts = jnp.cumsum(counts) - counts
    padded = ((counts + MOE_BLOCK - 1) // MOE_BLOCK) * MOE_BLOCK
    pends = jnp.cumsum(padded)
    pstarts = pends - padded
    dest = pstarts[e_sorted] + (jnp.arange(M) - starts[e_sorted])
    P = -(-M // MOE_BLOCK) * MOE_BLOCK + N_EXPERTS * MOE_BLOCK
    nb = P // MOE_BLOCK
    tok_pad = jnp.zeros((P,), jnp.int32).at[dest].set(tok_flat[order].astype(jnp.int32))
    gate_pad = jnp.zeros((P,), jnp.float32).at[dest].set(g_flat[order])
    block_expert = jnp.minimum(
        jnp.searchsorted(pends, jnp.arange(nb) * MOE_BLOCK, side='right'), N_EXPERTS - 1)
    xg = x[tok_pad].reshape(nb, MOE_BLOCK, D)

    def expert_block(args):
        xb, e = args
        hg = jnp.minimum(xb @ w_gate[e] + b_gate[e], SWIGLU_LIMIT)
        hu = jnp.clip(xb @ w_up[e] + b_up[e], -SWIGLU_LIMIT, SWIGLU_LIMIT)
        a = hg * jax.nn.sigmoid(SWIGLU_ALPHA * hg) * (hu + 1.0)
        return a @ w_down[e] + b_down[e]

    y = lax.map(expert_block, (xg, block_expert)).reshape(P, D)
    out = jnp.zeros_like(x).at[tok_pad].add(y * gate_pad[:, None].astype(y.dtype))
    return out.reshape(B, S, D)


def setup_inputs(seed: int = 0) -> dict:
    key = jax.random.key(seed)
    k = jax.random.split(key, 26)

    def nrm(kk, shape, scale):
        return scale * jax.random.normal(kk, shape, jnp.float32)

    D, E, F = D_MODEL, N_EXPERTS, D_FF
    return {
        'x': nrm(k[0], (BATCH, SEQ, D), 1.0),
        'c': nrm(k[1], (BATCH, D), 1.0),
        'ada_w': nrm(k[2], (DEPTH, D, 6 * D), 0.5 * D ** -0.5),
        'ada_b': nrm(k[3], (DEPTH, 6 * D), 0.01),
        'norm_mix_g': 1.0 + nrm(k[4], (DEPTH, D), 0.05),
        'norm_ffn_g': 1.0 + nrm(k[5], (DEPTH, D), 0.05),
        'even_w_in': nrm(k[6], (N_EVEN, D, EVEN_IN), D ** -0.5),
        'even_w_out': nrm(k[7], (N_EVEN, EVEN_MIX, D), EVEN_MIX ** -0.5),
        'diff_lambda': nrm(k[8], (N_EVEN, 4, HEAD_DIM), 0.1),
        'diff_subln_g': 1.0 + nrm(k[9], (N_EVEN, DIFF_VDIM), 0.05),
        'nsa_cmp_pos': nrm(k[10], (N_EVEN, 2, CMP_BLOCK, HEAD_DIM), 0.1),
        'nsa_cmp_w1': nrm(k[11], (N_EVEN, 2, CMP_BLOCK * HEAD_DIM, CMP_HIDDEN), (CMP_BLOCK * HEAD_DIM) ** -0.5),
        'nsa_cmp_w2': nrm(k[12], (N_EVEN, 2, CMP_HIDDEN, HEAD_DIM), CMP_HIDDEN ** -0.5),
        'nsa_gate_b': nrm(k[13], (N_EVEN, NSA_GATE), 0.01),
        'odd_w_in': nrm(k[14], (N_ODD, D, ODD_IN), D ** -0.5),
        'odd_w_out': nrm(k[15], (N_ODD, FOX_W, D), FOX_W ** -0.5),
        'fox_f_b': jax.random.uniform(k[16], (N_ODD, FOX_HEADS), jnp.float32, 1.0, 4.0),
        'router_w': nrm(k[17], (DEPTH, D, E), D ** -0.5),
        'router_b': nrm(k[18], (DEPTH, E), 0.01),
        'moe_w_gate': nrm(k[19], (DEPTH, E, D, F), D ** -0.5),
        'moe_b_gate': nrm(k[20], (DEPTH, E, F), 0.01),
        'moe_w_up': nrm(k[21], (DEPTH, E, D, F), D ** -0.5),
        'moe_b_up': nrm(k[22], (DEPTH, E, F), 0.01),
        'moe_w_down': nrm(k[23], (DEPTH, E, F, D), F ** -0.5),
        'moe_b_down': nrm(k[24], (DEPTH, E, D), 0.01),
        'final_g': 1.0 + nrm(k[25], (D,), 0.05),
    }


def reference(x, c, ada_w, ada_b, norm_mix_g, norm_ffn_g, even_w_in, even_w_out,
              diff_lambda, diff_subln_g, nsa_cmp_pos, nsa_cmp_w1, nsa_cmp_w2, nsa_gate_b,
              odd_w_in, odd_w_out, fox_f_b, router_w, router_b, moe_w_gate, moe_b_gate,
              moe_w_up, moe_b_up, moe_w_down, moe_b_down, final_g):
    cond = jax.nn.silu(c)
    for l in range(DEPTH):
        mod = (cond @ ada_w[l] + ada_b[l])[:, None, :]
        sh1, sc1, g1, sh2, sc2, g2 = jnp.split(mod, 6, axis=-1)
        h = rmsnorm(x, norm_mix_g[l]) * (1.0 + sc1) + sh1
        if l % 2 == 0:
            e = l // 2
            lam_init = 0.8 - 0.6 * math.exp(-0.3 * l)
            m = even_mixer(h, even_w_in[e], even_w_out[e], diff_lambda[e], diff_subln_g[e],
                           nsa_cmp_pos[e], nsa_cmp_w1[e], nsa_cmp_w2[e], nsa_gate_b[e], lam_init)
        else:
            o = l // 2
            m = odd_mixer(h, odd_w_in[o], odd_w_out[o], fox_f_b[o])
        x = x + g1 * m
        h = rmsnorm(x, norm_ffn_g[l]) * (1.0 + sc2) + sh2
        x = x + g2 * moe(h, router_w[l], router_b[l], moe_w_gate[l], moe_b_gate[l],
                         moe_w_up[l], moe_b_up[l], moe_w_down[l], moe_b_down[l])
    return rmsnorm(x, final_g)
```

```cpp
#include <hip/hip_runtime.h>
#include <stdint.h>
#include <stdio.h>

#define LAS __attribute__((address_space(3)))
#define CAS_ __attribute__((address_space(4)))
#define GAS_ __attribute__((address_space(1)))
typedef unsigned short bf16;
typedef unsigned v4u __attribute__((ext_vector_type(4)));
typedef unsigned v2u __attribute__((ext_vector_type(2)));
typedef float f32x4 __attribute__((ext_vector_type(4)));

constexpr int NB = 4, S = 4096, D = 1024, T = NB * S, DEPTH = 4;
constexpr int EVEN_IN = 2840, ODD_IN = 3088, QP = 3072;
constexpr int NE = 32, TOPK = 4, FF = 1024;
constexpr int PMAX = T * TOPK + NE * 256;
constexpr float EPS = 1e-6f, NEGBIG = -1e30f;
constexpr int C_AQ = 0, C_AK = 512, C_AV = 1024, C_BQ = 1536, C_KC = 2048, C_VC = 2176, C_KS = 2304, C_VS = 2432, C_KW = 2560, C_VW = 2688, C_BG = 2816;
constexpr int NCMP = 255;

constexpr size_t MiB = 1u << 20;
constexpr size_t WS_CTL = 0, CTL_ZERO_BYTES = 1 * MiB;
constexpr size_t WS_MOD = 1 * MiB;
constexpr size_t WS_KCMP = 2 * MiB;
constexpr size_t WS_VCMP = 2 * MiB + 512 * 1024;
constexpr size_t WS_WXT = 3 * MiB;
constexpr size_t WS_RWT = 3 * MiB + 512 * 1024;
constexpr size_t WS_GL = 4 * MiB;
constexpr size_t WS_TOPE = 6 * MiB;
constexpr size_t WS_TOPG = 6 * MiB + 256 * 1024;
constexpr size_t WS_SLOT = 6 * MiB + 512 * 1024;
constexpr size_t WS_RPOS = 6 * MiB + 768 * 1024;
constexpr size_t WS_RGATE = 7 * MiB;
constexpr size_t WS_CUM = 7 * MiB + 512 * 1024;
constexpr size_t WS_XCUR = 8 * MiB;
constexpr size_t WS_H = 72 * MiB;
constexpr size_t WS_QKV = 104 * MiB;
constexpr size_t WS_AO = 200 * MiB;
constexpr size_t WS_XG = 232 * MiB;
constexpr size_t WS_ACT = 376 * MiB;
constexpr size_t WS_Y = 520 * MiB;
constexpr size_t WS_CUMF = 664 * MiB;
constexpr size_t WS_WINT = 666 * MiB;
constexpr size_t WS_WOUTT = 690 * MiB;
constexpr size_t WS_WGUT = 698 * MiB;
constexpr size_t WS_WDT = 1210 * MiB;
constexpr size_t WS_W1T = 1466 * MiB;
constexpr size_t WS_POSB = 1468 * MiB;
constexpr size_t WS_CHTOT = 1468 * MiB + 65536;
constexpr size_t WS_ETOK = 1470 * MiB;
constexpr size_t WS_EGATE = 1472 * MiB;
constexpr size_t WS_END = 1474 * MiB;
constexpr size_t DUMMY_OFF = 1480 * MiB;
constexpr int CW_BAR = 4096;
constexpr int CW_CNT = 1024;
constexpr int CW_FQ = 2048;
constexpr int CW_EQ = 2560;
constexpr int CW_KN2 = 3584;
constexpr int CW_KNP = 8192;
constexpr int CW_KN = 3072;

constexpr int LDS_BYTES = 147456;
constexpr int NWAVES = 8, NTHR = 512;

__device__ __forceinline__ float bf2f(unsigned v) { return __uint_as_float(v << 16); }
__device__ __forceinline__ unsigned f2bf(float f) { unsigned u = __float_as_uint(f); return (u + 0x7fffu + ((u >> 16) & 1u)) >> 16; }
__device__ __forceinline__ unsigned pk2(float lo, float hi) { return f2bf(lo) | (f2bf(hi) << 16); }
template <int M> __device__ __forceinline__ float shx(float v) {
    if constexpr (M == 32) { const unsigned u = __float_as_uint(v); auto rr = __builtin_amdgcn_permlane32_swap(u, u, false, false); return __uint_as_float(rr[0] ^ rr[1] ^ u); }
    else return __int_as_float(__builtin_amdgcn_ds_swizzle(__float_as_int(v), 0x1F | (M << 10)));
}
__device__ __forceinline__ float shl_(float v, int src_lane) { return __int_as_float(__builtin_amdgcn_ds_bpermute(src_lane << 2, __float_as_int(v))); }
__device__ __forceinline__ int shl_(int v, int src_lane) { return __builtin_amdgcn_ds_bpermute(src_lane << 2, v); }
__device__ __forceinline__ float wave_sum(float v) { v += shx<1>(v); v += shx<2>(v); v += shx<4>(v); v += shx<8>(v); v += shx<16>(v); v += shx<32>(v); return v; }
__device__ __forceinline__ float wave_max(float v) { v = fmaxf(v, shx<1>(v)); v = fmaxf(v, shx<2>(v)); v = fmaxf(v, shx<4>(v)); v = fmaxf(v, shx<8>(v)); v = fmaxf(v, shx<16>(v)); v = fmaxf(v, shx<32>(v)); return v; }
__device__ __forceinline__ float sigmoidf_(float x) { return 1.f / (1.f + __expf(-x)); }
__device__ __forceinline__ float alibi8(int h) { return exp2f(-(float)(h + 1)); }
__device__ __forceinline__ float alibi4(int h) { return exp2f(-2.f * (float)(h + 1)); }

#define XB_TMO      128
#define XB_XCNT(j)  (256  + 64 * (j))
#define XB_XSUB(j)  (1280 + 64 * (j))
#define XB_XGEN(j)  (2304 + 64 * (j))
#define XB_TOP      3328
#define XB_TOPGEN   3392
#define XCD_BAR_WORDS 3456
#define XB_SPIN_CAP (1u << 24)
__device__ __forceinline__ unsigned xb_ld(unsigned* p)              { return __hip_atomic_load(p, __ATOMIC_RELAXED, __HIP_MEMORY_SCOPE_AGENT); }
__device__ __forceinline__ unsigned xb_add(unsigned* p, unsigned v) { return __hip_atomic_fetch_add(p, v, __ATOMIC_RELAXED, __HIP_MEMORY_SCOPE_AGENT); }
__device__ __forceinline__ unsigned xb_xcc_id() { return (unsigned)__builtin_amdgcn_s_getreg((3 << 11) | 20) & 0xFu; }
#define XB_SPIN(cond, bar) do { unsigned _sp = 0; while (cond) { __builtin_amdgcn_s_sleep(1); \
    if ((++_sp & 255u) == 0u) { if (xb_ld(&(bar)[XB_TMO])) break; if (_sp > XB_SPIN_CAP) { atomicAdd(&(bar)[XB_TMO], 1u); break; } } } } while (0)
struct XcdBarrier { unsigned* bar; unsigned x; volatile LAS unsigned* st; };
__device__ __forceinline__ XcdBarrier xcd_barrier_post(unsigned* bar, volatile LAS unsigned* st) {
    XcdBarrier b; b.bar = bar; b.x = xb_xcc_id(); b.st = st;
    if (threadIdx.x == 0) (void)xb_add(&bar[XB_XCNT(b.x)], 1u);
    return b;
}
__device__ __forceinline__ void xcd_barrier_complete(unsigned* bar, unsigned x, unsigned& nloc, unsigned& nx) {
    const unsigned G = gridDim.x * gridDim.y * gridDim.z;
    unsigned sum, cnt, mine, sp = 0u;
    for (;;) {
        sum = 0u; cnt = 0u; mine = 0u;
#pragma unroll
        for (unsigned j = 0; j < 16; ++j) { const unsigned c = xb_ld(&bar[XB_XCNT(j)]); sum += c; cnt += (c > 0u) ? 1u : 0u; mine = (j == x) ? c : mine; }
        if (sum == G) break;
        __builtin_amdgcn_s_sleep(1);
        if ((++sp & 255u) == 0u) { if (xb_ld(&bar[XB_TMO])) break; if (sp > XB_SPIN_CAP) { atomicAdd(&bar[XB_TMO], 1u); break; } }
    }
    nloc = mine > 0u ? mine : 1u; nx = cnt > 0u ? cnt : 1u;
}
__device__ __forceinline__ void xcd_barrier(const XcdBarrier& b) {
    asm volatile("s_waitcnt vmcnt(0)" ::: "memory");
    __syncthreads();
    if (threadIdx.x == 0) {
        unsigned* bar = b.bar; asm volatile("" : "+s"(bar));
        __builtin_amdgcn_s_waitcnt(0);
        unsigned nloc = b.st[0], nx = b.st[1];
        if (nloc == 0u) { xcd_barrier_complete(bar, b.x, nloc, nx); b.st[0] = nloc; b.st[1] = nx; }
        const unsigned old = xb_add(&bar[XB_XSUB(b.x)], 1u);
        const unsigned gen = old / nloc;
        if (old + 1u == (gen + 1u) * nloc) {
            __builtin_amdgcn_fence(__ATOMIC_RELEASE, "agent");
            asm volatile("s_waitcnt vmcnt(0)" ::: "memory");
            const unsigned og = xb_add(&bar[XB_TOP], 1u);
            const unsigned tg = og / nx;
            if (og + 1u == (tg + 1u) * nx) xb_add(&bar[XB_TOPGEN], 1u);
            else XB_SPIN(xb_ld(&bar[XB_TOPGEN]) == tg, bar);
            __builtin_amdgcn_fence(__ATOMIC_ACQUIRE, "agent");
            xb_add(&bar[XB_XGEN(b.x)], 1u);
            asm volatile("s_waitcnt vmcnt(0)" ::: "memory");
        } else {
            XB_SPIN(xb_ld(&bar[XB_XGEN(b.x)]) == gen, bar);
            __builtin_amdgcn_fence(__ATOMIC_ACQUIRE, "agent");
            asm volatile("s_waitcnt vmcnt(0)" ::: "memory");
        }
    }
    __syncthreads();
}

struct Args { const float* in[26]; float* out; unsigned char* ws; int ph_lo, ph_hi; };
enum { I_X = 0, I_C, I_ADAW, I_ADAB, I_NMG, I_NFG, I_EWIN, I_EWOUT, I_DLAM, I_DSUB, I_CPOS, I_CW1, I_CW2, I_GATEB, I_OWIN, I_OWOUT, I_FOXB,
       I_RW, I_RB, I_WG, I_BG, I_WU, I_BU, I_WD, I_BD, I_FINALG };

struct Ctx {
    const float* const* in; float* out; unsigned char* ws; LAS unsigned char* lds;
    int tid, lane, wave, gw, NGW;
};
#define PHASE_PROLOG(C0) Ctx C = (C0); { GAS_ unsigned char* wsg_ = (GAS_ unsigned char*)C.ws; asm volatile("" : "+s"(wsg_), "+s"(C.wave)); C.ws = (unsigned char*)wsg_; } { unsigned z_ = 0u; asm volatile("" : "+s"(z_)); C.lane = (int)__builtin_amdgcn_mbcnt_hi(~0u, __builtin_amdgcn_mbcnt_lo(~0u, z_)); } C.tid = C.wave * 64 + C.lane; asm volatile("" : "+v"(C.tid)); C.gw = blockIdx.x * NWAVES + C.wave; \
    unsigned char* ws = C.ws; CAS_ const unsigned char* in_ = (CAS_ const unsigned char*)__builtin_amdgcn_kernarg_segment_ptr(); asm volatile("" : "+s"(in_)); (void)ws; (void)in_
#define WSP(T_, off) ((T_*)(ws + (off)))
#define INP(i) ((const float*)(GAS_ const float*)*(CAS_ const unsigned long long*)(in_ + 8 * (i)))

__device__ __forceinline__ void p_prologue(const Ctx& C0) {
    PHASE_PROLOG(C0);
    LAS float* sc = (LAS float*)C.lds;
    LAS float* red = sc + 4096;
    for (int i = C.tid; i < 4096; i += NTHR) { const float v = INP(I_C)[i]; sc[i] = v * sigmoidf_(v); }
    __syncthreads();
    float* mod = WSP(float, WS_MOD);
    for (int item = blockIdx.x; item < 4 * 48; item += gridDim.x) {
        const int l = item / 48, n0 = (item % 48) * 128, cg = C.tid & 31, kgp = C.tid >> 5;
        const float* w = INP(I_ADAW) + (size_t)l * D * 6144 + n0 + 4 * cg;
        f32x4 acc[4];
#pragma unroll
        for (int b = 0; b < 4; ++b) acc[b] = (f32x4){0.f, 0.f, 0.f, 0.f};
#pragma unroll 1
        for (int k0 = kgp * 64; k0 < kgp * 64 + 64; k0 += 16) {
            f32x4 wv[16];
#pragma unroll
            for (int i = 0; i < 16; ++i) wv[i] = *(const f32x4*)(w + (size_t)(k0 + i) * 6144);
#pragma unroll
            for (int i = 0; i < 16; ++i)
#pragma unroll
                for (int b = 0; b < 4; ++b) acc[b] = acc[b] + wv[i] * sc[b * 1024 + k0 + i];
        }
#pragma unroll
        for (int b = 0; b < 4; ++b) *(LAS f32x4*)(red + (kgp * 4 + b) * 128 + 4 * cg) = acc[b];
        __syncthreads();
        { const int b = C.tid >> 7, col = C.tid & 127; float s = INP(I_ADAB)[l * 6144 + n0 + col];
#pragma unroll
          for (int q = 0; q < 16; ++q) s += red[(q * 4 + b) * 128 + col];
          mod[((size_t)l * 4 + b) * 6144 + n0 + col] = s; }
        __syncthreads();
    }
    float* wxt = WSP(float, WS_WXT); float* rwt = WSP(float, WS_RWT);
    const float* p_ewin = INP(I_EWIN); const float* p_owin = INP(I_OWIN); const float* p_rw = INP(I_RW);
    const int gt = blockIdx.x * NTHR + C.tid, NGT = gridDim.x * NTHR;
    for (int i = gt; i < 4 * 32 * 1024; i += NGT) {
        const int l = i >> 15, j = (i >> 10) & 31, k = i & 1023;
        const bool even = (l & 1) == 0; const int e = l >> 1;
        float v = 0.f;
        if (even) { if (j < 24) v = p_ewin[((size_t)e * D + k) * EVEN_IN + C_BG + j]; }
        else      { if (j < 16) v = p_owin[((size_t)e * D + k) * ODD_IN + 3072 + j]; }
        wxt[i] = v;
        rwt[i] = p_rw[((size_t)l * D + k) * NE + j];
    }
    __syncthreads();
    for (int item = blockIdx.x; item < 4; item += gridDim.x) {
        const float* pos = INP(I_CPOS) + (size_t)item * 2048; const float* w1 = INP(I_CW1) + (size_t)item * 2048 * 128;
        const int j = C.tid & 127, part = C.tid >> 7; float s = 0.f;
#pragma unroll 1
        for (int i0 = part * 512; i0 < part * 512 + 512; i0 += 16) { float wv[16];
#pragma unroll
            for (int i = 0; i < 16; ++i) wv[i] = w1[(size_t)(i0 + i) * 128 + j];
#pragma unroll
            for (int i = 0; i < 16; ++i) s += pos[i0 + i] * wv[i]; }
        red[part * 128 + j] = s;
        __syncthreads();
        if (C.tid < 128) WSP(float, WS_POSB)[item * 128 + C.tid] = (red[C.tid] + red[128 + C.tid]) + (red[256 + C.tid] + red[384 + C.tid]);
        __syncthreads();
    }
}

__device__ __forceinline__ void moe_tile_prefix(const unsigned* cnt, LAS int* tp, int tid) {
    if (tid < 64) {
        int tl = 0; if (tid < 32) tl = ((int)cnt[tid] + 255) >> 8;
        int inc = tl;
#pragma unroll
        for (int o = 1; o < 32; o <<= 1) { const int u = shl_(inc, tid - o); if (tid >= o) inc += u; }
        if (tid < 32) { tp[tid + 1] = inc; tp[64 + tid] = (int)cnt[tid]; }
        if (tid == 0) tp[0] = 0;
    }
    __syncthreads();
}


template <int N, int MASK> struct TreeStage {
    template <int NV> static __device__ __forceinline__ void run(float (&v)[NV], int lane) {
        const bool up = (lane & MASK) != 0;
#pragma unroll
        for (int i = 0; i < N / 2; ++i) { const float a = v[i], b = v[i + N / 2]; const float send = up ? a : b, keep = up ? b : a; v[i] = keep + shx<MASK>(send); }
        TreeStage<N / 2, MASK / 2>::run(v, lane);
    }
};
template <int MASK> struct TreeStage<1, MASK> { template <int NV> static __device__ __forceinline__ void run(float (&)[NV], int) {} };
template <int NV> __device__ __forceinline__ float tree_reduce(float (&v)[NV], int lane) {
    TreeStage<NV, 32>::run(v, lane);
    float r = v[0];
    if (NV == 16) r += shx<2>(r);
    r += shx<1>(r);
    return r;
}

template <int NV> __device__ __forceinline__ void norm1_extras(const f32x4 (&h)[2][4], const LAS float* wl_in, int nx, int lane, float (&res)[2]) {
    const LAS float* wl = wl_in; asm volatile("" : "+v"(wl) : "v"(h[0][0].x), "v"(h[1][0].x), "v"(h[0][3].w), "v"(h[1][3].w));
    float v0[NV], v1[NV];
#pragma unroll
    for (int c = 0; c < NV; ++c) {
        float p0 = 0.f, p1 = 0.f;
        if (c < nx) {
            typedef float f32x2_ __attribute__((ext_vector_type(2)));
            f32x2_ a0 = {0.f, 0.f}, a1 = {0.f, 0.f};
#pragma unroll
            for (int j = 0; j < 4; ++j) { const f32x4 w = *(const LAS f32x4*)(wl + c * 1024 + 4 * (lane + 64 * j));
                a0 = __builtin_elementwise_fma(h[0][j].xy, w.xy, a0); a0 = __builtin_elementwise_fma(h[0][j].zw, w.zw, a0);
                a1 = __builtin_elementwise_fma(h[1][j].xy, w.xy, a1); a1 = __builtin_elementwise_fma(h[1][j].zw, w.zw, a1); }
            p0 = a0.x + a0.y; p1 = a1.x + a1.y;
        }
        asm volatile("" : "+v"(p0), "+v"(p1));
        v0[c] = p0; v1[c] = p1;
    }
    res[0] = tree_reduce<NV>(v0, lane); res[1] = tree_reduce<NV>(v1, lane);
}
__device__ __forceinline__ void router_dots4(const f32x4 (&h)[4][4], const LAS float* wl_in, int lane, float (&res)[4]) {
    typedef float f32x2_ __attribute__((ext_vector_type(2)));
    const LAS float* wl = wl_in; asm volatile("" : "+v"(wl) : "v"(h[0][0].x), "v"(h[1][0].x), "v"(h[2][3].w), "v"(h[3][3].w));
    float v[4][16];
    const bool up = (lane & 32) != 0;
#pragma unroll
    for (int c = 0; c < 32; ++c) {
        f32x2_ a[4];
#pragma unroll
        for (int r = 0; r < 4; ++r) a[r] = (f32x2_){0.f, 0.f};
#pragma unroll
        for (int j = 0; j < 4; ++j) { const f32x4 w = *(const LAS f32x4*)(wl + c * 1024 + 4 * (lane + 64 * j));
#pragma unroll
            for (int r = 0; r < 4; ++r) { a[r] = __builtin_elementwise_fma(h[r][j].xy, w.xy, a[r]); a[r] = __builtin_elementwise_fma(h[r][j].zw, w.zw, a[r]); } }
        float p[4];
#pragma unroll
        for (int r = 0; r < 4; ++r) p[r] = a[r].x + a[r].y;
        asm volatile("" : "+v"(p[0]), "+v"(p[1]), "+v"(p[2]), "+v"(p[3]));
#pragma unroll
        for (int r = 0; r < 4; ++r) {
            if (c < 16) v[r][c] = p[r];
            else { const float lo = v[r][c - 16], hi = p[r]; const float send = up ? lo : hi, keep = up ? hi : lo; v[r][c - 16] = keep + shx<32>(send); }
        }
    }
#pragma unroll
    for (int r = 0; r < 4; ++r) { TreeStage<16, 16>::run(v[r], lane); float t = v[r][0]; t += shx<1>(t); res[r] = t; }
}
__device__ __forceinline__ void p_norm1(const Ctx& C0, int l, int dup = 0) {
    PHASE_PROLOG(C0);
    unsigned char* wsw = ws + (dup ? DUMMY_OFF : (size_t)0);
    const bf16* xcur = WSP(bf16, WS_XCUR); const float* mod = WSP(float, WS_MOD);
    const bf16* Y = WSP(bf16, WS_Y); const int* tope = WSP(int, WS_TOPE); const int* slot = WSP(int, WS_SLOT);
    v2u xn[2][4]; int ten[2][4], sln[2][4];
#define N1_FETCH(tn) do { _Pragma("unroll") for (int rr = 0; rr < 2; ++rr) { \
        _Pragma("unroll") for (int j = 0; j < 4; ++j) xn[rr][j] = *(const v2u*)(xcur + (size_t)((tn) + rr) * D + 4 * (C.lane + 64 * j)); \
        _Pragma("unroll") for (int k = 0; k < 4; ++k) { ten[rr][k] = tope[((tn) + rr) * 4 + k]; sln[rr][k] = slot[((tn) + rr) * 4 + k]; } } } while (0)
    if (l > 0 && (int)blockIdx.x < T / 64) N1_FETCH((int)blockIdx.x * 64 + C.wave * 8);
    LAS int* tpl = (LAS int*)(C.lds + 102400);
    if (l > 0) moe_tile_prefix(WSP(unsigned, WS_CTL) + CW_CNT + (l - 1) * 32, tpl, C.tid);
    const float* wxt = WSP(float, WS_WXT) + (size_t)(l & 3) * 32 * 1024;
    const bool even = (l & 1) == 0;
    LAS float* wl = (LAS float*)C.lds;
    LAS float* lsgl = (LAS float*)(C.lds + 98304);
    const int nx = even ? 24 : 16;
    const float* p_x = INP(I_X); const float* p_fg = INP(I_FINALG); const float* p_nmg = INP(I_NMG); const float* p_gb = INP(I_GATEB); const float* p_fb = INP(I_FOXB);
    if (l < 4) {
        for (int i = C.tid; i < nx * 256; i += NTHR) *(LAS f32x4*)(wl + 4 * i) = *(const f32x4*)(wxt + 4 * i);
        __syncthreads(); }
    for (int chunk = blockIdx.x; chunk < T / 64; chunk += gridDim.x) {
        const int b = (chunk * 64) / S;
        const float* mrow = mod + ((size_t)(l & 3) * 4 + b) * 6144;
        if (l > 0 && chunk != (int)blockIdx.x) N1_FETCH(chunk * 64 + C.wave * 8);
#pragma unroll 1
        for (int pr = 0; pr < 4; ++pr) {
            const int t0 = chunk * 64 + C.wave * 8 + pr * 2;
            f32x4 v[2][4];
#pragma unroll
            for (int rr = 0; rr < 2; ++rr)
#pragma unroll
                for (int j = 0; j < 4; ++j) {
                    if (l == 0) v[rr][j] = *(const f32x4*)(p_x + (size_t)(t0 + rr) * D + 4 * (C.lane + 64 * j));
                    else { const v2u u = xn[rr][j];
                        v[rr][j] = (f32x4){bf2f(u.x & 0xffffu), bf2f(u.x >> 16), bf2f(u.y & 0xffffu), bf2f(u.y >> 16)}; } }
            if (l > 0) {
                const float* g2 = mod + ((size_t)(l - 1) * 4 + b) * 6144 + 5 * 1024;
                int rp[2][4];
#pragma unroll
                for (int rr = 0; rr < 2; ++rr)
#pragma unroll
                    for (int k = 0; k < 4; ++k) rp[rr][k] = 256 * tpl[ten[rr][k]] + sln[rr][k];
                if (pr < 3) N1_FETCH(t0 + 2);
                f32x4 s[2][4];
#pragma unroll
                for (int rr = 0; rr < 2; ++rr)
#pragma unroll
                    for (int j = 0; j < 4; ++j) s[rr][j] = (f32x4){0.f, 0.f, 0.f, 0.f};
#pragma unroll
                for (int rr = 0; rr < 2; ++rr)
#pragma unroll
                    for (int k = 0; k < 4; ++k)
#pragma unroll
                        for (int j = 0; j < 4; ++j) { const v2u u = *(const v2u*)(Y + (size_t)rp[rr][k] * D + 4 * (C.lane + 64 * j));
                            s[rr][j].x += bf2f(u.x & 0xffffu); s[rr][j].y += bf2f(u.x >> 16); s[rr][j].z += bf2f(u.y & 0xffffu); s[rr][j].w += bf2f(u.y >> 16); }
#pragma unroll
                for (int j = 0; j < 4; ++j) { const f32x4 g = *(const f32x4*)(g2 + 4 * (C.lane + 64 * j));
#pragma unroll
                    for (int rr = 0; rr < 2; ++rr) { v[rr][j] = v[rr][j] + g * s[rr][j];
                        if (l < 4) { v2u o; o.x = pk2(v[rr][j].x, v[rr][j].y); o.y = pk2(v[rr][j].z, v[rr][j].w);
                            *(v2u*)((bf16*)(wsw + WS_XCUR) + (size_t)(t0 + rr) * D + 4 * (C.lane + 64 * j)) = o; } } }
            }
            float ss[2];
#pragma unroll
            for (int rr = 0; rr < 2; ++rr) { float a = 0.f;
#pragma unroll
                for (int j = 0; j < 4; ++j) a += (v[rr][j].x * v[rr][j].x + v[rr][j].y * v[rr][j].y) + (v[rr][j].z * v[rr][j].z + v[rr][j].w * v[rr][j].w);
                ss[rr] = a; }
            ss[0] = wave_sum(ss[0]); ss[1] = wave_sum(ss[1]);
            const float r0 = rsqrtf(ss[0] * (1.f / D) + EPS), r1 = rsqrtf(ss[1] * (1.f / D) + EPS);
            if (l == 4) {
#pragma unroll
                for (int j = 0; j < 4; ++j) { const f32x4 g = *(const f32x4*)(p_fg + 4 * (C.lane + 64 * j));
                    float* ob = dup ? (float*)(wsw + WS_XCUR) : C.out;
                    *(f32x4*)(ob + (size_t)t0 * D + 4 * (C.lane + 64 * j)) = v[0][j] * r0 * g;
                    *(f32x4*)(ob + (size_t)(t0 + 1) * D + 4 * (C.lane + 64 * j)) = v[1][j] * r1 * g; }
                continue;
            }
            f32x4 h[2][4];
#pragma unroll
            for (int j = 0; j < 4; ++j) { const int i0 = 4 * (C.lane + 64 * j);
                const f32x4 g = *(const f32x4*)(p_nmg + l * D + i0), sh = *(const f32x4*)(mrow + i0), scl = *(const f32x4*)(mrow + 1024 + i0);
                const f32x4 gs = g * (scl + 1.f);
                h[0][j] = v[0][j] * r0 * gs + sh; h[1][j] = v[1][j] * r1 * gs + sh;
#pragma unroll
                for (int rr = 0; rr < 2; ++rr) { v2u o; o.x = pk2(h[rr][j].x, h[rr][j].y); o.y = pk2(h[rr][j].z, h[rr][j].w);
                    *(v2u*)((bf16*)(wsw + WS_H) + (size_t)(t0 + rr) * D + i0) = o; } }
            float res[2];
            if (even) {
                norm1_extras<32>(h, wl, 24, C.lane, res);
                const int c = C.lane >> 1;
                if ((C.lane & 1) == 0 && c < 24) { const float gb = p_gb[(l >> 1) * 24 + c];
                    ((float*)(wsw + WS_GL))[(size_t)t0 * 32 + c] = res[0] + gb; ((float*)(wsw + WS_GL))[(size_t)(t0 + 1) * 32 + c] = res[1] + gb; }
            } else {
                norm1_extras<16>(h, wl, 16, C.lane, res);
                const int c = C.lane >> 2;
                if ((C.lane & 3) == 0) { const float fb = p_fb[(l >> 1) * 16 + c];
#pragma unroll
                    for (int rr = 0; rr < 2; ++rr) { const float z = res[rr] + fb; lsgl[(C.wave * 8 + pr * 2 + rr) * 16 + c] = fminf(z, 0.f) - log1pf(__expf(-fabsf(z))); } }
            }
        }
#undef N1_FETCH
        if (l < 4 && !even) {
            __syncthreads();
            if (C.tid < 16 && !dup) { float run = 0.f; float* cum = WSP(float, WS_CUMF);
                for (int i = 0; i < 64; ++i) { run += lsgl[i * 16 + C.tid]; cum[(size_t)(chunk * 64 + i) * 16 + C.tid] = run; }
                WSP(float, WS_CHTOT)[chunk * 16 + C.tid] = run; }
            __syncthreads();
        }
    }
}

template <int NW, class TileFn, class Epi>
__device__ __forceinline__ void simple_gemm(Ctx& C, const bf16* Abase, int lda, int MT, int NT, int K, int ldw, const TileFn& tf, const Epi& epi) {
    LAS float* As = (LAS float*)C.lds;
    LAS float* Ws = As + 64 * 17;
    const int ty = C.tid >> 5, tx = C.tid & 31;
    for (int tile = blockIdx.x; tile < MT * NT; tile += gridDim.x) {
        const int mt = tile / NT, nt = tile % NT;
        const float* W0 = nullptr; const float* W1 = nullptr;
        if (!tf(mt, nt, W0, W1)) continue;
        float acc[NW][4][4];
#pragma unroll
        for (int w = 0; w < NW; ++w)
#pragma unroll
            for (int i = 0; i < 4; ++i)
#pragma unroll
                for (int j = 0; j < 4; ++j) acc[w][i][j] = 0.f;
        for (int k0 = 0; k0 < K; k0 += 16) {
            __syncthreads();
            { const int r = C.tid >> 3, kk = (C.tid & 7) * 2;
              const unsigned u = *(const unsigned*)(Abase + (size_t)(mt * 64 + r) * lda + k0 + kk);
              As[r * 17 + kk] = bf2f(u & 0xffffu); As[r * 17 + kk + 1] = bf2f(u >> 16); }
#pragma unroll
            for (int w = 0; w < NW; ++w) { const float* Wp = w == 0 ? W0 : W1;
                const int kk = C.tid >> 5, c4 = (C.tid & 31) * 4;
                *(LAS f32x4*)(Ws + (w * 16 + kk) * 128 + c4) = *(const f32x4*)(Wp + (size_t)(k0 + kk) * ldw + nt * 128 + c4); }
            __syncthreads();
#pragma unroll
            for (int kk = 0; kk < 16; ++kk) {
                float a[4];
#pragma unroll
                for (int i = 0; i < 4; ++i) a[i] = As[(ty * 4 + i) * 17 + kk];
#pragma unroll
                for (int w = 0; w < NW; ++w) { const f32x4 wv = *(const LAS f32x4*)(Ws + (w * 16 + kk) * 128 + tx * 4);
#pragma unroll
                    for (int i = 0; i < 4; ++i) { acc[w][i][0] += a[i] * wv.x; acc[w][i][1] += a[i] * wv.y; acc[w][i][2] += a[i] * wv.z; acc[w][i][3] += a[i] * wv.w; } }
            }
        }
#pragma unroll
        for (int i = 0; i < 4; ++i) epi(mt * 64 + ty * 4 + i, nt * 128 + tx * 4, acc[0][i], acc[NW - 1][i]);
    }
    __syncthreads();
}

__device__ __forceinline__ int expert_of_row(const unsigned* cnt, int r0) {
    int start = 0;
    for (int e = 0; e < NE; ++e) { const int pad = ((int)cnt[e] + 255) & ~255; if (r0 < start + pad) return e; start += pad; }
    return -1;
}


namespace pg8 {
typedef short bf16x8 __attribute__((ext_vector_type(8)));
typedef unsigned u32x4 __attribute__((ext_vector_type(4)));
constexpr int BM = 256, BK = 64, HALF = 128, HTB = HALF * BK * 2, STAGE_BYTES = 8 * HTB, NXCD = 8, WGM = 8;
__device__ __forceinline__ int lds_byte(int r, int c) { const int st = (r >> 4) * 2 + (c >> 5), rr = r & 15, cc = c & 31, ob = rr * 64 + cc * 2; return st * 1024 + (ob ^ (((ob >> 9) & 1) << 5)); }
__device__ __forceinline__ void stage_rc(int b, int& R, int& C) { const int st = b / 1024, sb = b % 1024, swz = sb ^ (((sb >> 9) & 1) << 5); R = (st >> 1) * 16 + swz / 64; C = (st & 1) * 32 + (swz % 64) / 2; }
__device__ __forceinline__ int perm32(int rho) { const int n = rho >> 4, i = rho & 15; return 8 * (i >> 2) + 4 * n + (i & 3); }
struct Unit { int pm, pn, pb; };
struct Gemm { const bf16* A; const bf16* Bt; int K; };
struct StaticOrder {
    int nM, nN, nwg, G, c;
    __device__ void init(int M, int N, int G_, int c_) { nM = M / BM; nN = N / BM; nwg = nM * nN; G = G_; c = c_; }
    __device__ bool next(int i, Unit& u) const {
        const long L = (long)i * G + c; if (L >= nwg) return false;
        int wgid = (int)L; { const int q = nwg / NXCD, r = nwg % NXCD, xcd = wgid % NXCD, off = wgid / NXCD; wgid = (xcd < r ? xcd * (q + 1) : r * (q + 1) + (xcd - r) * q) + off; }
        const int nig = WGM * nN, gid = wgid / nig, fm = gid * WGM, gsz = (nM - fm) < WGM ? (nM - fm) : WGM;
        u.pm = fm + ((wgid % nig) % gsz); u.pn = (wgid % nig) / gsz; u.pb = u.pn; return true;
    }
    __device__ __forceinline__ const int* a_ptr(const Unit&, int) const { return nullptr; }
};
struct MoeOrder {
    const LAS int* tp; int NPN, G, c; const int* etok;
    __device__ bool next(int i, Unit& u) const {
        const int L = i * G + c; const int pm = L / NPN; if (pm >= __builtin_amdgcn_readfirstlane(tp[32])) return false;
        int e = 0;
        for (int k = 1; k < 32; ++k) e += (pm >= tp[k]) ? 1 : 0;
        e = __builtin_amdgcn_readfirstlane(e);
        u.pm = pm; u.pn = L - pm * NPN; u.pb = e * NPN + u.pn; return true;
    }
    __device__ __forceinline__ const int* a_ptr(const Unit& u, int row) const {
        const int e = u.pb / NPN; int s = (u.pm - tp[e]) * 256 + row; const int ce = tp[64 + e] - 1; s = s < ce ? s : ce;
        return etok + e * 16384 + s;
    }
};
__device__ __forceinline__ unsigned cvt_pk_bf16(float lo, float hi) { unsigned r; asm volatile("v_cvt_pk_bf16_f32 %0, %1, %2" : "=v"(r) : "v"(lo), "v"(hi)); return r; }

template <class Epi, class Sched, bool ALIGN_EPI, bool SP2, bool GATHER = false>
__device__ __forceinline__ void gemm_phase(LAS unsigned char* lds, const int tid, const Gemm g, const Sched& S, const Epi& E_in) {
    Epi E = E_in;
    const int wid = __builtin_amdgcn_readfirstlane(tid >> 6), lane = tid & 63, wr = wid >> 2, wc = wid & 3, fr = lane & 15, fq = lane >> 4;
    const int K = g.K, nt = K / BK;
    unsigned voffA[2], voffB[2];
#pragma unroll
    for (int i = 0; i < 2; ++i) { int R, C; stage_rc(tid * 16 + i * 8192, R, C); const int Rb = Epi::PERM ? ((R & ~31) + perm32(R & 31)) : R;
        voffA[i] = (unsigned)(R * K + C) * 2u; voffB[i] = (unsigned)(Rb * K + C) * 2u; }
    const size_t kstep = (size_t)(BK * 2);
    const size_t hstep = (size_t)HALF * K * 2;
    const size_t tstep = 2 * hstep;
    const unsigned ldsw = (unsigned)wid * 1024u;
    const int aoff = lds_byte(wr * 64 + fr, fq * 8), boff = lds_byte(wc * 32 + fr, fq * 8);
#define PG8_SA(b, h) (((b) * 2 + (h)) * HTB)
#define PG8_SB(b, h) ((4 + (b) * 2 + (h)) * HTB)
#define PG8_STAGE(bufoff, gbase, voff) do { _Pragma("unroll") for (int _i = 0; _i < 2; ++_i) \
        __builtin_amdgcn_global_load_lds((const unsigned*)((const char*)(gbase) + (voff)[_i]), (LAS unsigned*)(lds + (bufoff) + ldsw + _i * 8192), 16, 0, 0); } while (0)
#define PG8_STAGE2(bufoff, gbase, o0, o1) do { \
        __builtin_amdgcn_global_load_lds((const unsigned*)((const char*)(gbase) + (o0)), (LAS unsigned*)(lds + (bufoff) + ldsw), 16, 0, 0); \
        __builtin_amdgcn_global_load_lds((const unsigned*)((const char*)(gbase) + (o1)), (LAS unsigned*)(lds + (bufoff) + ldsw + 8192), 16, 0, 0); } while (0)
#define PG8_LDA(dst, b, h) do { _Pragma("unroll") for (int m = 0; m < 4; ++m) _Pragma("unroll") for (int k = 0; k < 2; ++k) dst[m][k] = *(const LAS bf16x8*)(lds + PG8_SA(b, h) + aoff + m * 2048 + k * 1024); } while (0)
#define PG8_LDB(dst, b, h) do { _Pragma("unroll") for (int n = 0; n < 2; ++n) _Pragma("unroll") for (int k = 0; k < 2; ++k) dst[n][k] = *(const LAS bf16x8*)(lds + PG8_SB(b, h) + boff + n * 2048 + k * 1024); } while (0)
#define PG8_MMA(ai, bj, At, Bt) do { __builtin_amdgcn_s_setprio(1); _Pragma("unroll") for (int m = 0; m < 4; ++m) _Pragma("unroll") for (int n = 0; n < 2; ++n) _Pragma("unroll") for (int k = 0; k < 2; ++k) \
        acc[ai][bj][m][n] = __builtin_amdgcn_mfma_f32_16x16x32_bf16(Bt[n][k], At[m][k], acc[ai][bj][m][n], 0, 0, 0); __builtin_amdgcn_s_setprio(0); } while (0)
#define PG8_WAIT_V(n) asm volatile("s_waitcnt vmcnt(" #n ")" ::: "memory")
#define PG8_WAIT_L(n) asm volatile("s_waitcnt lgkmcnt(" #n ")" ::: "memory")
#define PG8_BAR __builtin_amdgcn_s_barrier()
#define PG8_SCHED __builtin_amdgcn_sched_barrier(0)
    Unit cur, nxt; int ui = 0;
    if (!S.next(0, cur)) return;
    f32x4 acc[2][2][4][2];
#pragma unroll
    for (int a = 0; a < 2; ++a)
#pragma unroll
        for (int b = 0; b < 2; ++b)
#pragma unroll
            for (int m = 0; m < 4; ++m)
#pragma unroll
                for (int n = 0; n < 2; ++n) acc[a][b][m][n] = (f32x4){0.f, 0.f, 0.f, 0.f};
    bf16x8 At[4][2], B0[2][2], B1[2][2];
    static_assert(!GATHER || SP2, "gathered A rows: SP2 loop only");
    const size_t ahs = GATHER ? (size_t)0 : hstep;
    constexpr int GOFF = STAGE_BYTES + 1024;
    unsigned vA[2][2], cc[2];
#pragma unroll
    for (int i = 0; i < 2; ++i) { int R, C; stage_rc(tid * 16 + i * 8192, R, C); cc[i] = (unsigned)(C * 2); vA[0][i] = voffA[i]; vA[1][i] = voffA[i]; }
    if constexpr (GATHER) {
#pragma unroll
        for (int h = 0; h < 2; ++h)
#pragma unroll
            for (int i = 0; i < 2; ++i) { int R, C; stage_rc(tid * 16 + i * 8192, R, C); vA[h][i] = (unsigned)(*S.a_ptr(cur, h * HALF + R)) * 2048u + cc[i]; }
    }
    const char* cA = (const char*)g.A + (GATHER ? (size_t)0 : (size_t)cur.pm * tstep); const char* cB = (const char*)g.Bt + (size_t)cur.pb * tstep;
    if constexpr (SP2) {
        PG8_STAGE(PG8_SB(0, 0), cB, voffB); PG8_STAGE(PG8_SB(0, 1), cB + hstep, voffB); PG8_STAGE2(PG8_SA(0, 0), cA, vA[0][0], vA[0][1]); PG8_STAGE2(PG8_SA(0, 1), cA + ahs, vA[1][0], vA[1][1]);
        if (wr == 1) PG8_BAR;
        PG8_WAIT_V(2); PG8_BAR;
        PG8_STAGE(PG8_SB(1, 0), cB + kstep, voffB); PG8_STAGE2(PG8_SA(1, 0), cA + kstep, vA[0][0], vA[0][1]); PG8_STAGE(PG8_SB(1, 1), cB + hstep + kstep, voffB);
        PG8_WAIT_V(6); PG8_BAR;
    } else {
        PG8_STAGE(PG8_SB(0, 0), cB, voffB); PG8_STAGE(PG8_SA(0, 0), cA, voffA); PG8_STAGE(PG8_SB(0, 1), cB + hstep, voffB); PG8_STAGE(PG8_SA(0, 1), cA + hstep, voffA);
        if (wr == 1) PG8_BAR;
        PG8_WAIT_V(4); PG8_BAR;
        PG8_STAGE(PG8_SB(1, 0), cB + kstep, voffB); PG8_STAGE(PG8_SA(1, 0), cA + kstep, voffA); PG8_STAGE(PG8_SB(1, 1), cB + hstep + kstep, voffB);
        PG8_WAIT_V(6); PG8_BAR;
    }
    for (;;) {
        const bool has_next = S.next(ui + 1, nxt);
        E.prefetch(lds, cur, ui, wid, lane);
        const char* nA = GATHER ? (const char*)g.A : (has_next ? (const char*)g.A + (size_t)nxt.pm * tstep : cA); const char* nB = has_next ? (const char*)g.Bt + (size_t)nxt.pb * tstep : cB;
        if constexpr (GATHER) {
            if (has_next) {
#pragma unroll
                for (int h = 0; h < 2; ++h)
#pragma unroll
                    for (int i = 0; i < 2; ++i) { int R, C; stage_rc(tid * 16 + i * 8192, R, C);
                        __builtin_amdgcn_global_load_lds((const unsigned*)S.a_ptr(nxt, h * HALF + R), (LAS unsigned*)(lds + GOFF + (h * 2 + i) * 2048 + wid * 256), 4, 0, 0); }
            }
        }
        for (int t = 0; t < nt; t += 2) {
            const bool last = (t == nt - 2);
            const char* a1 = cA + (size_t)(t + 1) * kstep;
            const char* a2 = last ? nA : cA + (size_t)(t + 2) * kstep; const char* b2 = last ? nB : cB + (size_t)(t + 2) * kstep;
            const char* a3 = a2 + kstep; const char* b3 = b2 + kstep;
            if constexpr (SP2) {
            PG8_LDB(B0, 0, 0); PG8_LDB(B1, 0, 1); PG8_SCHED; PG8_LDA(At, 0, 0); PG8_STAGE2(PG8_SA(1, 1), a1 + ahs, vA[1][0], vA[1][1]);
            if constexpr (GATHER) { if (last && has_next) {
#pragma unroll
                for (int h = 0; h < 2; ++h)
#pragma unroll
                    for (int i = 0; i < 2; ++i) vA[h][i] = *(const LAS unsigned*)(lds + GOFF + (h * 2 + i) * 2048 + tid * 4) * 2048u + cc[i]; } }
            PG8_WAIT_V(8); PG8_WAIT_L(0); PG8_BAR; PG8_MMA(0, 0, At, B0); PG8_MMA(0, 1, At, B1); PG8_BAR; PG8_SCHED;
            PG8_LDA(At, 0, 1); PG8_STAGE(PG8_SB(0, 0), b2, voffB); PG8_STAGE(PG8_SB(0, 1), b2 + hstep, voffB); PG8_STAGE2(PG8_SA(0, 0), a2, vA[0][0], vA[0][1]);
            PG8_WAIT_V(8); PG8_WAIT_L(0); PG8_BAR; PG8_MMA(1, 0, At, B0); PG8_MMA(1, 1, At, B1); PG8_BAR; PG8_SCHED;
            PG8_LDB(B0, 1, 0); PG8_LDB(B1, 1, 1); PG8_SCHED; PG8_LDA(At, 1, 0); PG8_STAGE2(PG8_SA(0, 1), a2 + ahs, vA[1][0], vA[1][1]);
            PG8_WAIT_V(8); PG8_WAIT_L(0); PG8_BAR; PG8_MMA(0, 0, At, B0); PG8_MMA(0, 1, At, B1); PG8_BAR; PG8_SCHED;
            PG8_LDA(At, 1, 1); PG8_STAGE(PG8_SB(1, 0), b3, voffB); PG8_STAGE(PG8_SB(1, 1), b3 + hstep, voffB); PG8_STAGE2(PG8_SA(1, 0), a3, vA[0][0], vA[0][1]);
            PG8_WAIT_V(8); PG8_WAIT_L(0); PG8_BAR; PG8_MMA(1, 0, At, B0); PG8_MMA(1, 1, At, B1); PG8_BAR; PG8_SCHED;
            } else {
            PG8_LDB(B0, 0, 0); PG8_SCHED; PG8_LDA(At, 0, 0); PG8_STAGE(PG8_SA(1, 1), a1 + hstep, voffA);
            PG8_WAIT_L(8); PG8_BAR; PG8_WAIT_L(0); PG8_MMA(0, 0, At, B0); PG8_BAR; PG8_SCHED;
            PG8_LDB(B1, 0, 1); PG8_STAGE(PG8_SB(0, 0), b2, voffB);
            PG8_BAR; PG8_WAIT_L(0); PG8_MMA(0, 1, At, B1); PG8_BAR;
            PG8_LDA(At, 0, 1); PG8_STAGE(PG8_SA(0, 0), a2, voffA);
            PG8_BAR; PG8_WAIT_L(0); PG8_MMA(1, 0, At, B0); PG8_BAR; PG8_SCHED;
            PG8_STAGE(PG8_SB(0, 1), b2 + hstep, voffB);
            PG8_WAIT_V(6); PG8_BAR; PG8_MMA(1, 1, At, B1); PG8_BAR;
            PG8_LDB(B0, 1, 0); PG8_SCHED; PG8_LDA(At, 1, 0); PG8_STAGE(PG8_SA(0, 1), a2 + hstep, voffA);
            PG8_WAIT_L(8); PG8_BAR; PG8_WAIT_L(0); PG8_MMA(0, 0, At, B0); PG8_BAR; PG8_SCHED;
            PG8_LDB(B1, 1, 1); PG8_STAGE(PG8_SB(1, 0), b3, voffB);
            PG8_BAR; PG8_WAIT_L(0); PG8_MMA(0, 1, At, B1); PG8_BAR;
            PG8_LDA(At, 1, 1); PG8_STAGE(PG8_SA(1, 0), a3, voffA);
            PG8_BAR; PG8_WAIT_L(0); PG8_MMA(1, 0, At, B0); PG8_BAR; PG8_SCHED;
            PG8_STAGE(PG8_SB(1, 1), b3 + hstep, voffB);
            PG8_WAIT_V(6); PG8_BAR; PG8_MMA(1, 1, At, B1); PG8_BAR;
            }
        }
        if constexpr (ALIGN_EPI) { if (wr == 0) PG8_BAR; }
        E.bind(lds, ui);
        { int te = tid; asm volatile("" : "+v"(te));
          E(acc, cur, wr, wc, te & 15, (te & 63) >> 4); }
        if (!has_next) break;
#pragma unroll
        for (int a = 0; a < 2; ++a)
#pragma unroll
            for (int b = 0; b < 2; ++b)
#pragma unroll
                for (int m = 0; m < 4; ++m)
#pragma unroll
                    for (int n = 0; n < 2; ++n) acc[a][b][m][n] = (f32x4){0.f, 0.f, 0.f, 0.f};
        cur = nxt; cA = nA; cB = nB; ++ui;
        if constexpr (ALIGN_EPI) { if (wr == 1) PG8_BAR; }
    }
    PG8_WAIT_V(0);
    if constexpr (!ALIGN_EPI) { if (wr == 0) PG8_BAR; }
    PG8_BAR;
#undef PG8_SA
#undef PG8_SB
#undef PG8_STAGE
#undef PG8_LDA
#undef PG8_STAGE2
#undef PG8_LDB
#undef PG8_MMA
#undef PG8_WAIT_V
#undef PG8_WAIT_L
#undef PG8_BAR
#undef PG8_SCHED
}

struct EpiQKV {
    static constexpr bool PERM = true;
    __device__ __forceinline__ void prefetch(LAS unsigned char*, const Unit&, int, int, int) const {}
    __device__ __forceinline__ void bind(LAS unsigned char*, int) {}
    bf16* O; int ldc; unsigned* knp; int klo, khi;
    __device__ __forceinline__ void operator()(const f32x4 (&acc)[2][2][4][2], const Unit& u, int wr, int wc, int fr, int fq) const {
        const int row0 = u.pm * BM + wr * 64 + fr, col0 = u.pn * BM + wc * 32 + 8 * fq;
        if (u.pn >= klo && u.pn < khi) {
#pragma unroll
            for (int bj = 0; bj < 2; ++bj) { float mx = 0.f;
#pragma unroll
                for (int ai = 0; ai < 2; ++ai)
#pragma unroll
                    for (int m = 0; m < 4; ++m) { const f32x4 a = acc[ai][bj][m][0], c = acc[ai][bj][m][1];
                        float s2 = ((a[0] * a[0] + a[1] * a[1]) + (a[2] * a[2] + a[3] * a[3])) + ((c[0] * c[0] + c[1] * c[1]) + (c[2] * c[2] + c[3] * c[3]));
                        s2 += shx<16>(s2); s2 += shx<32>(s2); mx = fmaxf(mx, s2); }
                mx = fmaxf(mx, shx<1>(mx)); mx = fmaxf(mx, shx<2>(mx)); mx = fmaxf(mx, shx<4>(mx)); mx = fmaxf(mx, shx<8>(mx));
                if ((fr | fq) == 0) __hip_atomic_fetch_max(knp + (u.pm >> 4) * 96 + u.pn * 8 + bj * 4 + wc, __float_as_uint(mx), __ATOMIC_RELAXED, __HIP_MEMORY_SCOPE_AGENT); }
        }
#pragma unroll
        for (int ai = 0; ai < 2; ++ai)
#pragma unroll
            for (int m = 0; m < 4; ++m) { bf16* rowp = O + (size_t)(row0 + ai * HALF + m * 16) * ldc + col0;
#pragma unroll
                for (int bj = 0; bj < 2; ++bj) { const f32x4 v0 = acc[ai][bj][m][0], v1 = acc[ai][bj][m][1];
                    u32x4 w; w.x = cvt_pk_bf16(v0[0], v0[1]); w.y = cvt_pk_bf16(v0[2], v0[3]); w.z = cvt_pk_bf16(v1[0], v1[1]); w.w = cvt_pk_bf16(v1[2], v1[3]);
                    *(u32x4*)(rowp + bj * HALF) = w; } }
    }
};
struct EpiOut {
    static constexpr bool PERM = true;
    __device__ __forceinline__ void prefetch(LAS unsigned char*, const Unit&, int, int, int) const {}
    __device__ __forceinline__ void bind(LAS unsigned char*, int) {}
    const float* x32; const bf16* xprev; bf16* xout; const float* g1;
    __device__ __forceinline__ void operator()(const f32x4 (&acc)[2][2][4][2], const Unit& u, int wr, int wc, int fr, int fq) const {
        const int row0 = u.pm * BM + wr * 64 + fr, col0 = u.pn * BM + wc * 32 + 8 * fq;
        const float* gv = g1 + (size_t)(u.pm >> 4) * 6144 + col0;
        f32x4 gg[2][2];
#pragma unroll
        for (int bj = 0; bj < 2; ++bj)
#pragma unroll
            for (int n = 0; n < 2; ++n) gg[bj][n] = *(const f32x4*)(gv + bj * HALF + n * 4);
#pragma unroll
        for (int ai = 0; ai < 2; ++ai)
#pragma unroll
            for (int m = 0; m < 4; ++m) { const size_t ro = (size_t)(row0 + ai * HALF + m * 16) * 1024 + col0;
#pragma unroll
                for (int bj = 0; bj < 2; ++bj) { f32x4 p0, p1;
                    if (x32) { p0 = *(const f32x4*)(x32 + ro + bj * HALF); p1 = *(const f32x4*)(x32 + ro + bj * HALF + 4); }
                    else { const u32x4 q = *(const u32x4*)(xprev + ro + bj * HALF);
                        p0 = (f32x4){bf2f(q.x & 0xffffu), bf2f(q.x >> 16), bf2f(q.y & 0xffffu), bf2f(q.y >> 16)};
                        p1 = (f32x4){bf2f(q.z & 0xffffu), bf2f(q.z >> 16), bf2f(q.w & 0xffffu), bf2f(q.w >> 16)}; }
                    const f32x4 o0 = p0 + gg[bj][0] * acc[ai][bj][m][0], o1 = p1 + gg[bj][1] * acc[ai][bj][m][1];
                    u32x4 w; w.x = cvt_pk_bf16(o0[0], o0[1]); w.y = cvt_pk_bf16(o0[2], o0[3]); w.z = cvt_pk_bf16(o1[0], o1[1]); w.w = cvt_pk_bf16(o1[2], o1[3]);
                    *(u32x4*)(xout + ro + bj * HALF) = w; } }
    }
};
constexpr int EOFF = STAGE_BYTES + 1024 + 8192;
struct EpiMoe1 {
    static constexpr bool PERM = true;
    bf16* act; const float* bgate; const float* bup;
    const LAS float* eb;
    __device__ __forceinline__ void prefetch(LAS unsigned char* lds, const Unit& u, int ui, int wid, int lane) const {
        if (wid < 4) { const float* src = ((wid & 2) ? bup : bgate) + (u.pb >> 3) * 1024 + u.pn * HALF + (wid & 1) * 64 + lane;
            __builtin_amdgcn_global_load_lds((const unsigned*)src, (LAS unsigned*)(lds + EOFF + (ui & 1) * 2048 + wid * 256), 4, 0, 0); }
    }
    __device__ __forceinline__ void bind(LAS unsigned char* lds, int ui) { eb = (const LAS float*)(lds + EOFF + (ui & 1) * 2048); }
    __device__ __forceinline__ void operator()(const f32x4 (&acc)[2][2][4][2], const Unit& u, int wr, int wc, int fr, int fq) const {
        const int row0 = u.pm * BM + wr * 64 + fr, col0 = u.pn * HALF + wc * 32 + 8 * fq;
        f32x4 bg[2], bu[2];
#pragma unroll
        for (int n = 0; n < 2; ++n) { bg[n] = *(const LAS f32x4*)(eb + wc * 32 + 8 * fq + 4 * n); bu[n] = *(const LAS f32x4*)(eb + 128 + wc * 32 + 8 * fq + 4 * n); }
#pragma unroll
        for (int ai = 0; ai < 2; ++ai)
#pragma unroll
            for (int m = 0; m < 4; ++m) { float o[8];
#pragma unroll
                for (int n = 0; n < 2; ++n) {
                    const f32x4 ag = acc[ai][0][m][n] + bg[n], au = acc[ai][1][m][n] + bu[n];
                    f32x4 hg, hu;
#pragma unroll
                    for (int j = 0; j < 4; ++j) { hg[j] = fminf(ag[j], 7.f); hu[j] = fminf(fmaxf(au[j], -7.f), 7.f); }
                    const f32x4 t = hg * (-1.702f * 1.44269504f);
                    f32x4 e;
#pragma unroll
                    for (int j = 0; j < 4; ++j) e[j] = __builtin_amdgcn_exp2f(t[j]);
                    const f32x4 d = e + 1.f;
                    f32x4 r;
#pragma unroll
                    for (int j = 0; j < 4; ++j) r[j] = __builtin_amdgcn_rcpf(d[j]);
                    const f32x4 ov = (hg * r) * (hu + 1.f);
#pragma unroll
                    for (int j = 0; j < 4; ++j) o[n * 4 + j] = ov[j]; }
                u32x4 w; w.x = cvt_pk_bf16(o[0], o[1]); w.y = cvt_pk_bf16(o[2], o[3]); w.z = cvt_pk_bf16(o[4], o[5]); w.w = cvt_pk_bf16(o[6], o[7]);
                *(u32x4*)(act + (size_t)(row0 + ai * HALF + m * 16) * 1024 + col0) = w; }
    }
};
struct EpiMoe2 {
    static constexpr bool PERM = true;
    bf16* y; const float* bdown; const float* egate; const LAS int* tp;
    const LAS float* eb;
    __device__ __forceinline__ void prefetch(LAS unsigned char* lds, const Unit& u, int ui, int wid, int lane) const {
        const int e = u.pb >> 2;
        const float* src;
        if (wid < 4) src = bdown + e * 1024 + u.pn * BM + wid * 64 + lane;
        else { int s = (u.pm - tp[e]) * 256 + (wid - 4) * 64 + lane; const int ce = tp[64 + e] - 1; s = s < ce ? s : ce; src = egate + e * 16384 + s; }
        __builtin_amdgcn_global_load_lds((const unsigned*)src, (LAS unsigned*)(lds + EOFF + (ui & 1) * 2048 + wid * 256), 4, 0, 0);
    }
    __device__ __forceinline__ void bind(LAS unsigned char* lds, int ui) { eb = (const LAS float*)(lds + EOFF + (ui & 1) * 2048); }
    __device__ __forceinline__ void operator()(const f32x4 (&acc)[2][2][4][2], const Unit& u, int wr, int wc, int fr, int fq) const {
        const int row0 = u.pm * BM + wr * 64 + fr, col0 = u.pn * BM + wc * 32 + 8 * fq;
        f32x4 bd[2][2];
#pragma unroll
        for (int bj = 0; bj < 2; ++bj)
#pragma unroll
            for (int n = 0; n < 2; ++n) bd[bj][n] = *(const LAS f32x4*)(eb + wc * 32 + 8 * fq + bj * HALF + 4 * n);
#pragma unroll
        for (int ai = 0; ai < 2; ++ai)
#pragma unroll
            for (int m = 0; m < 4; ++m) { const int rl = wr * 64 + fr + ai * HALF + m * 16, row = u.pm * BM + rl; const float gt = eb[256 + rl];
#pragma unroll
                for (int bj = 0; bj < 2; ++bj) { const f32x4 v0 = (acc[ai][bj][m][0] + bd[bj][0]) * gt, v1 = (acc[ai][bj][m][1] + bd[bj][1]) * gt;
                    u32x4 w; w.x = cvt_pk_bf16(v0[0], v0[1]); w.y = cvt_pk_bf16(v0[2], v0[3]); w.z = cvt_pk_bf16(v1[0], v1[1]); w.w = cvt_pk_bf16(v1[2], v1[3]);
                    *(u32x4*)(y + (size_t)row * 1024 + col0 + bj * HALF) = w; } }
        (void)row0;
    }
};
}

struct TItem { const float* W; bf16* WT; int ld, K, drow0, k0, n0; };
__device__ __forceinline__ void ti_load(float (&v)[32], const TItem& t, int lane) {
#pragma unroll
    for (int i = 0; i < 32; ++i) v[i] = __builtin_nontemporal_load(t.W + (size_t)(t.k0 + 2 * i + (lane >> 5)) * t.ld + t.n0 + (lane & 31));
}
__device__ __forceinline__ void ti_emit(const TItem& t, const LAS float* scr, int lane) {
    const int c = lane & 7;
#pragma unroll
    for (int j = 0; j < 4; ++j) { const int n = (lane >> 3) + 8 * j;
        float s[8];
#pragma unroll
        for (int q = 0; q < 8; ++q) { const int kk = 8 * c + q; s[q] = scr[kk * 32 + ((n + kk) & 31)]; }
        v4u o; o.x = pk2(s[0], s[1]); o.y = pk2(s[2], s[3]); o.z = pk2(s[4], s[5]); o.w = pk2(s[6], s[7]);
        *(v4u*)(t.WT + (size_t)(t.drow0 + n) * t.K + t.k0 + 8 * c) = o; }
    asm volatile("s_waitcnt lgkmcnt(0)" ::: "memory");
}
__device__ __forceinline__ void ti_store(const float (&v)[32], const TItem& t, LAS float* scr, int lane) {
#pragma unroll
    for (int i = 0; i < 32; ++i) { const int kk = 2 * i + (lane >> 5); scr[kk * 32 + (((lane & 31) + kk) & 31)] = v[i]; }
    asm volatile("s_waitcnt lgkmcnt(0)" ::: "memory");
    ti_emit(t, scr, lane);
}
constexpr int CVT_SMALL = 4 * 32 * 4 + (2 * 16 * 88 + 2 * 16 * 96) + 4 * 16 * 32, CVT_MOE_L = 32 * 3 * 16 * 32;
struct CvtPtrs { const float *cw1, *ewin, *owin, *ewout, *owout, *wg, *wu, *wd; unsigned char* ws; };
__device__ __forceinline__ TItem cvt_decode(const CvtPtrs& P, int it) {
    constexpr int IT_IN_E = 16 * 88, IT_IN_O = 16 * 96, IT_OUT = 16 * 32, IT_MOE = 16 * 32;
    constexpr int N_IN = 2 * IT_IN_E + 2 * IT_IN_O, N_OUT = 4 * IT_OUT, N_W1 = 4 * 32 * 4;
    unsigned char* ws = P.ws;
    TItem t; int r = it;
    if (r < N_W1) { const int m = r >> 7, kb = (r & 127) >> 2, nb = r & 3;
        t.W = P.cw1 + (size_t)m * 2048 * 128; t.ld = 128; t.K = 2048; t.WT = WSP(bf16, WS_W1T) + (size_t)m * 128 * 2048; t.drow0 = 32 * nb; t.k0 = 64 * kb; t.n0 = 32 * nb; return t; }
    r -= N_W1;
    if (r < N_IN) {
        int l; bool even;
        if (r < 2 * IT_IN_E) { const int e = r / IT_IN_E; r -= e * IT_IN_E; l = 2 * e; even = true; }
        else { r -= 2 * IT_IN_E; const int e = r / IT_IN_O; r -= e * IT_IN_O; l = 2 * e + 1; even = false; }
        const int nblk = even ? 88 : 96, kb = r / nblk, nb = r % nblk;
        t.W = even ? P.ewin + (size_t)(l >> 1) * D * EVEN_IN : P.owin + (size_t)(l >> 1) * D * ODD_IN; t.ld = even ? EVEN_IN : ODD_IN; t.K = D;
        t.WT = WSP(bf16, WS_WINT) + (size_t)l * 3072 * 1024; t.drow0 = 32 * nb; t.k0 = 64 * kb; t.n0 = 32 * nb; return t;
    }
    r -= N_IN;
    if (r < N_OUT) {
        const int l = r / IT_OUT; r -= l * IT_OUT; const int kb = r / 32, nb = r % 32;
        t.W = (l & 1) ? P.owout + (size_t)(l >> 1) * D * D : P.ewout + (size_t)(l >> 1) * D * D; t.ld = D; t.K = D;
        t.WT = WSP(bf16, WS_WOUTT) + (size_t)l * 1024 * 1024; t.drow0 = 32 * nb; t.k0 = 64 * kb; t.n0 = 32 * nb; return t;
    }
    r -= N_OUT;
    { const int le = r / (3 * IT_MOE); r -= le * 3 * IT_MOE; const int which = r / IT_MOE; r -= which * IT_MOE; const int kb = r / 32, nb = r % 32, n0 = 32 * nb;
      t.k0 = 64 * kb; t.n0 = n0;
      if (which < 2) { t.W = (which == 0 ? P.wg : P.wu) + (size_t)le * D * FF; t.ld = FF; t.K = D; t.WT = WSP(bf16, WS_WGUT) + (size_t)le * 2048 * 1024; t.drow0 = (n0 >> 7) * 256 + which * 128 + (n0 & 127); }
      else { t.W = P.wd + (size_t)le * FF * D; t.ld = D; t.K = FF; t.WT = WSP(bf16, WS_WDT) + (size_t)le * 1024 * 1024; t.drow0 = n0; } }
    return t;
}
__device__ __forceinline__ void p_convert(const Ctx& C0) {
    PHASE_PROLOG(C0);
    LAS float* scr = (LAS float*)(C.lds + 32768) + C.wave * 2048;
    CvtPtrs P; P.cw1 = INP(I_CW1); P.ewin = INP(I_EWIN); P.owin = INP(I_OWIN); P.ewout = INP(I_EWOUT); P.owout = INP(I_OWOUT); P.wg = INP(I_WG); P.wu = INP(I_WU); P.wd = INP(I_WD); P.ws = ws;
    constexpr int NITEMS = CVT_SMALL;
    int it = C.gw;
    if (it >= NITEMS) return;
    float va[32], vb[32];
    TItem ta = cvt_decode(P, it), tb = ta;
    ti_load(va, ta, C.lane);
    for (;;) {
        int nx = it + C.NGW; bool hb = nx < NITEMS;
        if (hb) { tb = cvt_decode(P, nx); ti_load(vb, tb, C.lane); }
        ti_store(va, ta, scr, C.lane);
        if (!hb) break;
        it = nx; nx = it + C.NGW; const bool ha = nx < NITEMS;
        if (ha) { ta = cvt_decode(P, nx); ti_load(va, ta, C.lane); }
        ti_store(vb, tb, scr, C.lane);
        if (!ha) break;
        it = nx;
    }
}

__device__ __forceinline__ void p_cmp(const Ctx& C0, int l) {
    PHASE_PROLOG(C0); const int e = l >> 1;
    const bf16* QKV = WSP(bf16, WS_QKV);
    LAS float* in = (LAS float*)C.lds;
    LAS float* red = in + 2048;
    LAS float* hid = red + 512;
    LAS float* red2 = hid + 128;
    if (blockIdx.x == 0) { for (int i = C.tid; i < 2 * NB * 2 * 64; i += NTHR) { const int kv2 = i / (NB * 2 * 64), r = i % (NB * 2 * 64), bb = r / 128, gd = r % 128;
        WSP(bf16, kv2 ? WS_VCMP : WS_KCMP)[((size_t)(bb * 256 + 255) * 2) * 64 + gd] = 0; } }
    for (int item = blockIdx.x; item < NB * NCMP * 2 * 2; item += gridDim.x) {
        const int kv = item & 1, g = (item >> 1) & 1, n = (item >> 2) % NCMP, b = (item >> 2) / NCMP;
        const float* pos = INP(I_CPOS) + ((size_t)e * 2 + kv) * 32 * 64;
        const float* w1 = INP(I_CW1) + ((size_t)e * 2 + kv) * 2048 * 128;
        const float* w2 = INP(I_CW2) + ((size_t)e * 2 + kv) * 128 * 64;
        const int col = (kv ? C_VC : C_KC) + g * 64;
        for (int i = C.tid; i < 2048; i += NTHR) { const int ll = i >> 6, dd = i & 63;
            in[i] = bf2f(QKV[(size_t)(b * S + 16 * n + ll) * QP + col + dd]) + pos[ll * 64 + dd]; }
        __syncthreads();
        { const int j = C.tid & 127, part = C.tid >> 7; float s = 0.f;
          for (int i = part * 512; i < part * 512 + 512; ++i) s += in[i] * w1[(size_t)i * 128 + j];
          red[part * 128 + j] = s; }
        __syncthreads();
        if (C.tid < 128) { const float s = red[C.tid] + red[128 + C.tid] + red[256 + C.tid] + red[384 + C.tid]; hid[C.tid] = s * sigmoidf_(s); }
        __syncthreads();
        { const int d = C.tid & 63, part = C.tid >> 6; float s = 0.f;
          for (int j = part * 16; j < part * 16 + 16; ++j) s += hid[j] * w2[j * 64 + d];
          red2[part * 64 + d] = s; }
        __syncthreads();
        if (C.tid < 64) { float s = 0.f;
#pragma unroll
            for (int p = 0; p < 8; ++p) s += red2[p * 64 + C.tid];
            bf16* dst = WSP(bf16, kv ? WS_VCMP : WS_KCMP);
            dst[((size_t)(b * 256 + n) * 2 + g) * 64 + C.tid] = (bf16)f2bf(s); }
        __syncthreads();
    }
}

__device__ __forceinline__ void p_cmp_mfma(const Ctx& C0, int l) {
    PHASE_PROLOG(C0); const int e = l >> 1;
    typedef short bf16x8 __attribute__((ext_vector_type(8)));
    const bf16* QKV = WSP(bf16, WS_QKV);
    LAS float* red = (LAS float*)C.lds;
    LAS float* hid = red + 8 * 16 * 128;
    const float* p_cw2 = INP(I_CW2);
    const int r = C.lane & 15, kg = C.lane >> 4;
    for (int u = blockIdx.x; u < 256; u += gridDim.x) {
        const int kv = u & 1, g = (u >> 1) & 1, b = (u >> 2) & 3, n0 = (u >> 4) * 16;
        const bf16* w1t = WSP(bf16, WS_W1T) + (size_t)(e * 2 + kv) * 128 * 2048;
        const int col = (kv ? C_VC : C_KC) + g * 64;
        const int n = n0 + r; const bool nvalid = n < NCMP;
        f32x4 acc[8];
#pragma unroll
        for (int j = 0; j < 8; ++j) acc[j] = (f32x4){0.f, 0.f, 0.f, 0.f};
#pragma unroll 2
        for (int ks = 0; ks < 8; ++ks) {
            const int ltok = 4 * C.wave + (ks >> 1), dd = (ks & 1) * 32 + kg * 8;
            bf16x8 a = (bf16x8){0, 0, 0, 0, 0, 0, 0, 0};
            if (nvalid) a = *(const bf16x8*)(QKV + (size_t)(b * S + 16 * n + ltok) * QP + col + dd);
            const int k0 = ltok * 64 + dd;
#pragma unroll
            for (int j = 0; j < 8; ++j) { const bf16x8 bb = *(const bf16x8*)(w1t + (size_t)(j * 16 + r) * 2048 + k0);
                acc[j] = __builtin_amdgcn_mfma_f32_16x16x32_bf16(a, bb, acc[j], 0, 0, 0); }
        }
#pragma unroll
        for (int j = 0; j < 8; ++j)
#pragma unroll
            for (int i = 0; i < 4; ++i) red[(C.wave * 16 + 4 * kg + i) * 128 + j * 16 + r] = acc[j][i];
        __syncthreads();
        const float* posb = WSP(float, WS_POSB) + (e * 2 + kv) * 128;
        for (int idx = C.tid; idx < 2048; idx += NTHR) { float s = posb[idx & 127];
#pragma unroll
            for (int w = 0; w < 8; ++w) s += red[(w * 16 + (idx >> 7)) * 128 + (idx & 127)];
            hid[idx] = s * sigmoidf_(s); }
        __syncthreads();
        { const int row = C.tid >> 5, d2 = (C.tid & 31) * 2; const float* w2 = p_cw2 + (size_t)(e * 2 + kv) * 128 * 64;
          float s0 = 0.f, s1 = 0.f;
#pragma unroll 8
          for (int j = 0; j < 128; ++j) { const float h = hid[row * 128 + j]; const float2 w = *(const float2*)(w2 + j * 64 + d2); s0 += h * w.x; s1 += h * w.y; }
          const int nn = n0 + row;
          bf16* dst = WSP(bf16, kv ? WS_VCMP : WS_KCMP) + ((size_t)(b * 256 + nn) * 2 + g) * 64 + d2;
          *(unsigned*)dst = (nn < NCMP) ? pk2(s0, s1) : 0u; }
        __syncthreads();
    }
}
__device__ __forceinline__ void p_scan(const Ctx& C0) {
    PHASE_PROLOG(C0);
    const float* GL = WSP(float, WS_GL); float* CUM = WSP(float, WS_CUMF);
    for (int item = C.gw; item < NB * 16; item += C.NGW) {
        const int b = item >> 4, h = item & 15;
        float loc = 0.f;
        for (int i = 0; i < 64; ++i) loc += GL[(size_t)(b * S + C.lane * 64 + i) * 32 + h];
        float inc = loc;
#pragma unroll
        for (int o = 1; o < 64; o <<= 1) { const float u = shl_(inc, C.lane - o); if (C.lane >= o) inc += u; }
        float run = inc - loc;
        for (int i = 0; i < 64; ++i) { run += GL[(size_t)(b * S + C.lane * 64 + i) * 32 + h]; CUM[(size_t)(b * S + C.lane * 64 + i) * 16 + h] = run; }
    }
}

template <int NO> struct RowState { float m, l; float o[NO]; };
template <int NO> __device__ __forceinline__ void rs_init(RowState<NO>& st) { st.m = NEGBIG; st.l = 0.f;
#pragma unroll
    for (int i = 0; i < NO; ++i) st.o[i] = 0.f; }
__device__ __forceinline__ float dot64(const LAS float* q, const bf16* krow) {
    float s = 0.f;
#pragma unroll
    for (int c = 0; c < 8; ++c) { const v4u u = *(const v4u*)(krow + c * 8); const LAS float* qq = q + c * 8;
        s += qq[0] * bf2f(u.x & 0xffffu) + qq[1] * bf2f(u.x >> 16) + qq[2] * bf2f(u.y & 0xffffu) + qq[3] * bf2f(u.y >> 16)
           + qq[4] * bf2f(u.z & 0xffffu) + qq[5] * bf2f(u.z >> 16) + qq[6] * bf2f(u.w & 0xffffu) + qq[7] * bf2f(u.w >> 16); }
    return s;
}
template <int NO> __device__ __forceinline__ void attn_chunk(RowState<NO>& st, float s, bool valid, const bf16* vbase, int vpitch, int lane) {
    const float cm = wave_max(valid ? s : NEGBIG);
    const float mnew = fmaxf(st.m, cm);
    const float p = valid ? __expf(s - mnew) : 0.f;
    const float f = __expf(st.m - mnew);
    st.l = st.l * f + wave_sum(p);
#pragma unroll
    for (int i = 0; i < NO; ++i) st.o[i] *= f;
    const unsigned long long act = __ballot(p != 0.f);
    if (act) {
        for (int j = 0; j < 64; ++j) {
            const float pj = shl_(p, j);
            if (pj != 0.f) {
#pragma unroll
                for (int i = 0; i < NO; ++i) st.o[i] += pj * bf2f(vbase[(size_t)j * vpitch + lane + 64 * i]);
            }
        }
    }
    st.m = mnew;
}

__device__ __forceinline__ void attn_diff_row(const Ctx& C0, int l, int item) {
    PHASE_PROLOG(C0); const int e = l >> 1;
    const bf16* QKV = WSP(bf16, WS_QKV); bf16* AO = WSP(bf16, WS_AO);
    LAS float* ql = (LAS float*)C.lds + C.wave * 1024;
    const int s = item % S, h = (item / S) & 3, b = item / (4 * S);
    const int t = b * S + s;
    const float slope = alibi4(h);
    const float lam_init = 0.8f - 0.6f * __expf(-0.3f * (float)l);
    float lam;
    { const float* lp = INP(I_DLAM) + e * 256; int tl0 = C.tid; asm volatile("" : "+v"(tl0)); const int ln0 = tl0 & 63; const float a1 = wave_sum(lp[ln0] * lp[64 + ln0]), a2 = wave_sum(lp[128 + ln0] * lp[192 + ln0]);
      lam = __uint_as_float(__builtin_amdgcn_readfirstlane(__float_as_uint(__expf(a1) - __expf(a2) + lam_init))); }
    float res[2];
    res[0] = 0.f; res[1] = 0.f;
#pragma unroll
    for (int c = 0; c < 2; ++c) {
        ql[C.lane] = 0.125f * bf2f(QKV[(size_t)t * QP + C_AQ + h * 128 + c * 64 + C.lane]);
        RowState<2> st; rs_init(st);
        for (int k0 = 0; k0 <= s; k0 += 64) {
            const int kp = k0 + C.lane; const bool valid = kp <= s;
            float sc = NEGBIG;
            if (valid) sc = dot64(ql, QKV + (size_t)(b * S + kp) * QP + C_AK + h * 128 + c * 64) - slope * (float)(s - kp);
            attn_chunk<2>(st, sc, valid, QKV + (size_t)(b * S + k0) * QP + C_AV + h * 128, QP, C.lane);
        }
        const float inv = 1.f / st.l, w = (c == 0) ? 1.f : -lam;
        res[0] += w * st.o[0] * inv; res[1] += w * st.o[1] * inv;
    }
    const float ms = wave_sum(res[0] * res[0] + res[1] * res[1]) * (1.f / 128.f);
    const float r = rsqrtf(ms + EPS) * (1.f - lam_init);
    const float* sg = INP(I_DSUB) + e * 128;
    AO[(size_t)t * D + h * 128 + C.lane] = (bf16)f2bf(res[0] * r * sg[C.lane]);
    AO[(size_t)t * D + h * 128 + 64 + C.lane] = (bf16)f2bf(res[1] * r * sg[64 + C.lane]);
}

__device__ __forceinline__ void attn_nsa_row(const Ctx& C0, int l, int item) {
    PHASE_PROLOG(C0);
    const bf16* QKV = WSP(bf16, WS_QKV); bf16* AO = WSP(bf16, WS_AO);
    const bf16* KC = WSP(bf16, WS_KCMP); const bf16* VC = WSP(bf16, WS_VCMP); const float* GL = WSP(float, WS_GL);
    LAS float* ql = (LAS float*)C.lds + C.wave * 1024;
    LAS float* pl = ql + 256;
    LAS float* ps = pl + 256;
    const int s = item % S, g = (item / S) & 1, b = item / (2 * S);
    const int t = b * S + s, lane = C.lane;
#pragma unroll
    for (int hg = 0; hg < 4; ++hg) ql[hg * 64 + lane] = 0.125f * bf2f(QKV[(size_t)t * QP + C_BQ + (g * 4 + hg) * 64 + lane]);
#pragma unroll
    for (int i = 0; i < 4; ++i) ps[lane + 64 * i] = 0.f;
    float out[4];
#pragma unroll
    for (int hg = 0; hg < 4; ++hg) {
        const float slope = alibi8(g * 4 + hg);
        float sc[4]; bool vd[4]; float mx = NEGBIG;
#pragma unroll
        for (int i = 0; i < 4; ++i) { const int n = lane + 64 * i; vd[i] = (n < NCMP) && (16 * n + 31 <= s); sc[i] = NEGBIG;
            if (vd[i]) sc[i] = dot64(ql + hg * 64, KC + ((size_t)(b * 256 + n) * 2 + g) * 64) - slope * (float)(s - (16 * n + 31));
            mx = fmaxf(mx, sc[i]); }
        mx = wave_max(mx);
        float p[4], sum = 0.f;
#pragma unroll
        for (int i = 0; i < 4; ++i) { p[i] = vd[i] ? __expf(sc[i] - mx) : 0.f; sum += p[i]; }
        sum = wave_sum(sum);
        const float inv = 1.f / fmaxf(sum, 1e-30f);
#pragma unroll
        for (int i = 0; i < 4; ++i) { p[i] *= inv; pl[lane + 64 * i] = p[i]; ps[lane + 64 * i] += p[i]; }
        float o = 0.f;
        const int nmax = (s >= 31) ? ((s - 31) >> 4) : -1;
        for (int n = 0; n <= nmax && n < NCMP; ++n) o += pl[n] * bf2f(VC[((size_t)(b * 256 + n) * 2 + g) * 64 + lane]);
        out[hg] = sigmoidf_(GL[(size_t)t * 32 + (g * 4 + hg) * 3 + 0]) * o;
    }
    const int cur = s >> 6;
    float imp = 0.f;
#pragma unroll
    for (int d = -1; d <= 3; ++d) { const int n = 4 * lane + d; if (n >= 0 && n < NCMP) imp += ps[n]; }
    const bool avail = lane <= cur, forced = (lane == 0) || (lane == cur) || (lane == cur - 1);
    const float score = avail ? imp + (forced ? 1e4f : 0.f) : NEGBIG;
    int rank = 0;
    for (int j = 0; j < 64; ++j) { const float sj = shl_(score, j); rank += (sj > score || (sj == score && j < lane)) ? 1 : 0; }
    const unsigned long long sel = __ballot(avail && rank < 16);
#pragma unroll
    for (int hg = 0; hg < 4; ++hg) {
        const float slope = alibi8(g * 4 + hg);
        RowState<1> st; rs_init(st);
        for (int j = 0; j <= cur; ++j) {
            if (!((sel >> j) & 1ull)) continue;
            const int kp = 64 * j + lane; const bool valid = kp <= s;
            float sc = NEGBIG;
            if (valid) sc = dot64(ql + hg * 64, QKV + (size_t)(b * S + kp) * QP + C_KS + g * 64) - slope * (float)(s - kp);
            attn_chunk<1>(st, sc, valid, QKV + (size_t)(b * S + 64 * j) * QP + C_VS + g * 64, QP, lane);
        }
        out[hg] += sigmoidf_(GL[(size_t)t * 32 + (g * 4 + hg) * 3 + 1]) * st.o[0] / fmaxf(st.l, 1e-30f);
    }
#pragma unroll
    for (int hg = 0; hg < 4; ++hg) {
        const float slope = alibi8(g * 4 + hg);
        RowState<1> st; rs_init(st);
        const int lo = (s - 511 > 0) ? ((s - 511) >> 6) : 0;
        for (int j = lo; j <= cur; ++j) {
            const int kp = 64 * j + lane; const bool valid = (kp <= s) && (s - kp < 512);
            float sc = NEGBIG;
            if (valid) sc = dot64(ql + hg * 64, QKV + (size_t)(b * S + kp) * QP + C_KW + g * 64) - slope * (float)(s - kp);
            attn_chunk<1>(st, sc, valid, QKV + (size_t)(b * S + 64 * j) * QP + C_VW + g * 64, QP, lane);
        }
        out[hg] += sigmoidf_(GL[(size_t)t * 32 + (g * 4 + hg) * 3 + 2]) * st.o[0] / fmaxf(st.l, 1e-30f);
    }
#pragma unroll
    for (int hg = 0; hg < 4; ++hg) AO[(size_t)t * D + 512 + (g * 4 + hg) * 64 + lane] = (bf16)f2bf(out[hg]);
}

__device__ __forceinline__ void attn_fox_row(const Ctx& C0, int item) {
    PHASE_PROLOG(C0);
    const bf16* QKV = WSP(bf16, WS_QKV); bf16* AO = WSP(bf16, WS_AO); const float* CUM = WSP(float, WS_CUMF);
    LAS float* ql = (LAS float*)C.lds + C.wave * 1024;
    const int s = item % S, h = (item / S) & 15, b = item / (16 * S);
    const int t = b * S + s;
    ql[C.lane] = 0.125f * bf2f(QKV[(size_t)t * QP + h * 64 + C.lane]);
    const float cq = CUM[(size_t)t * 16 + h];
    RowState<1> st; rs_init(st);
    for (int k0 = 0; k0 <= s; k0 += 64) {
        const int kp = k0 + C.lane; const bool valid = kp <= s;
        float sc = NEGBIG;
        if (valid) sc = dot64(ql, QKV + (size_t)(b * S + kp) * QP + 1024 + h * 64) + (cq - CUM[(size_t)(b * S + kp) * 16 + h]);
        attn_chunk<1>(st, sc, valid, QKV + (size_t)(b * S + k0) * QP + 2048 + h * 64, QP, C.lane);
    }
    AO[(size_t)t * D + h * 64 + C.lane] = (bf16)f2bf(st.o[0] / st.l);
}


namespace fa {
typedef float f32x16 __attribute__((ext_vector_type(16)));
typedef short bf16x8 __attribute__((ext_vector_type(8)));
typedef short s16x4 __attribute__((ext_vector_type(4)));
constexpr int KCH = 1040, KT = 8 * KCH, VDB = 4160;
constexpr float LOG2E = 1.4426950408889634f, QSCALE = 0.125f * LOG2E, THR = 20.f;
#define FA_NEG_INF (-__builtin_inff())
__device__ __forceinline__ int crow(int r, int hi) { return (r & 3) + 8 * (r >> 2) + 4 * hi; }
__device__ __forceinline__ unsigned cvtpk(float lo, float hi) { unsigned r; asm("v_cvt_pk_bf16_f32 %0, %1, %2" : "=v"(r) : "v"(lo), "v"(hi)); return r; }
__device__ __forceinline__ float swapmax(float m) { auto rr = __builtin_amdgcn_permlane32_swap(__float_as_uint(m), __float_as_uint(m), false, false); return fmaxf(__uint_as_float(rr[0]), __uint_as_float(rr[1])); }
__device__ __forceinline__ float swapsum(float m) { auto rr = __builtin_amdgcn_permlane32_swap(__float_as_uint(m), __float_as_uint(m), false, false); return __uint_as_float(rr[0]) + __uint_as_float(rr[1]); }
#define FA_SYNC() asm volatile("s_waitcnt lgkmcnt(0)\n\ts_barrier" ::: "memory")

template <int NK, int NVH> struct Stage { v4u k[NK]; v4u v[NVH]; };
template <int NK, int NVH> __device__ __forceinline__ void tile_issue(Stage<NK, NVH>& st, const bf16* K0, const bf16* K1, int kpitch, const bf16* V, int vpitch, int tid) {
    const int row = tid >> 3, c = tid & 7;
    st.k[0] = *(const v4u*)(K0 + (size_t)row * kpitch + c * 8);
    if constexpr (NK == 2) st.k[1] = *(const v4u*)(K1 + (size_t)row * kpitch + c * 8);
#pragma unroll
    for (int i = 0; i < NVH; ++i) st.v[i] = *(const v4u*)(V + (size_t)row * vpitch + (c + 8 * i) * 8);
}
template <int NK, int NVH> __device__ __forceinline__ void tile_commit(const Stage<NK, NVH>& st, LAS unsigned char* kbuf, LAS unsigned char* vbuf, int tid) {
    const int row = tid >> 3, c = tid & 7;
#pragma unroll
    for (int i = 0; i < NK; ++i) *(LAS v4u*)(kbuf + i * KT + c * KCH + row * 16) = st.k[i];
#pragma unroll
    for (int i = 0; i < NVH; ++i) { const int c16 = c + 8 * i; *(LAS v4u*)(vbuf + (c16 >> 2) * VDB + row * 64 + (c16 & 3) * 16) = st.v[i]; }
}
__device__ __forceinline__ void load_q(bf16x8 (&qr)[4], const bf16* qrow, int hi) {
#pragma unroll
    for (int d0 = 0; d0 < 4; ++d0) { const v4u u = *(const v4u*)(qrow + d0 * 16 + hi * 8);
        v4u w;
        w.x = cvtpk(bf2f(u.x & 0xffffu) * QSCALE, bf2f(u.x >> 16) * QSCALE); w.y = cvtpk(bf2f(u.y & 0xffffu) * QSCALE, bf2f(u.y >> 16) * QSCALE);
        w.z = cvtpk(bf2f(u.z & 0xffffu) * QSCALE, bf2f(u.z >> 16) * QSCALE); w.w = cvtpk(bf2f(u.w & 0xffffu) * QSCALE, bf2f(u.w >> 16) * QSCALE);
        qr[d0] = __builtin_bit_cast(bf16x8, w); }
}
template <int NDB> __device__ __forceinline__ void pv_step(f32x16 (&o)[NDB], const LAS unsigned char* vt, int lane, const bf16x8 (&pa)[4]) {
    typedef short v4i16_t __attribute__((ext_vector_type(4)));
    const int hi = lane >> 5;
    const LAS unsigned char* vb = vt + ((lane >> 4) & 1) * 32 + (lane & 3) * 8 + (4 * hi + ((lane & 15) >> 2)) * 64;
#pragma unroll
    for (int dp = 0; dp < NDB; dp += 2) {
        s16x4 lo[2][4], h4[2][4];
#pragma unroll
        for (int dd = 0; dd < 2; ++dd)
#pragma unroll
            for (int ks = 0; ks < 4; ++ks) {
                lo[dd][ks] = __builtin_bit_cast(s16x4, __builtin_amdgcn_ds_read_tr16_b64_v4i16((LAS v4i16_t*)(vb + (dp + dd) * VDB + ks * 1024)));
                h4[dd][ks] = __builtin_bit_cast(s16x4, __builtin_amdgcn_ds_read_tr16_b64_v4i16((LAS v4i16_t*)(vb + (dp + dd) * VDB + ks * 1024 + 512))); }
        __builtin_amdgcn_sched_barrier(0);
#pragma unroll
        for (int ks = 0; ks < 4; ++ks)
#pragma unroll
            for (int dd = 0; dd < 2; ++dd) {
                const bf16x8 B = (bf16x8){lo[dd][ks][0], lo[dd][ks][1], lo[dd][ks][2], lo[dd][ks][3], h4[dd][ks][0], h4[dd][ks][1], h4[dd][ks][2], h4[dd][ks][3]};
                o[dp + dd] = __builtin_amdgcn_mfma_f32_32x32x16_bf16(pa[ks], B, o[dp + dd], 0, 0, 0); }
    }
}
__device__ __forceinline__ void qk_tile(f32x16& p0, f32x16& p1, const bf16x8 (&qr)[4], const LAS unsigned char* kt, int lane) {
    const LAS unsigned char* kb = kt + (lane >> 5) * KCH + (lane & 31) * 16;
    p0 = (f32x16){0.f, 0.f, 0.f, 0.f, 0.f, 0.f, 0.f, 0.f, 0.f, 0.f, 0.f, 0.f, 0.f, 0.f, 0.f, 0.f}; p1 = p0;
#pragma unroll
    for (int d0 = 0; d0 < 4; ++d0) {
        const bf16x8 b0 = *(const LAS bf16x8*)(kb + d0 * 2 * KCH), b1 = *(const LAS bf16x8*)(kb + d0 * 2 * KCH + 512);
        p0 = __builtin_amdgcn_mfma_f32_32x32x16_bf16(b0, qr[d0], p0, 0, 0, 0);
        p1 = __builtin_amdgcn_mfma_f32_32x32x16_bf16(b1, qr[d0], p1, 0, 0, 0);
    }
}
__device__ __forceinline__ float max3f(float a, float b, float c) { return __builtin_fmaxf(__builtin_fmaxf(a, b), c); }
__device__ __forceinline__ float rowmax32(const f32x16& p0, const f32x16& p1) {
    float a = max3f(p0[0], p0[1], p1[0]), b = max3f(p0[2], p0[3], p1[1]);
    a = max3f(a, p1[2], p1[3]);
#pragma unroll
    for (int r = 4; r < 16; r += 4) { a = max3f(a, p0[r], p0[r + 1]); b = max3f(b, p0[r + 2], p0[r + 3]); a = max3f(a, p1[r], p1[r + 1]); b = max3f(b, p1[r + 2], p1[r + 3]); }
    return __builtin_fmaxf(a, b);
}
template <int NDB> __device__ __forceinline__ void softmax_pv(float& mhat, float& lsum, f32x16 (&o)[NDB], f32x16& p0, f32x16& p1, float off, float ladj, const LAS unsigned char* vt, LAS float* wsf, int lane) {
    const int r32 = lane & 31, hi = lane >> 5;
    typedef short v4i16_t __attribute__((ext_vector_type(4)));
    s16x4 vlo[2][4], vh4[2][4];
    if constexpr (NDB == 2) {
        const LAS unsigned char* vb = vt + ((lane >> 4) & 1) * 32 + (lane & 3) * 8 + (4 * hi + ((lane & 15) >> 2)) * 64;
#pragma unroll
        for (int dd = 0; dd < 2; ++dd)
#pragma unroll
            for (int ks = 0; ks < 4; ++ks) {
                vlo[dd][ks] = __builtin_bit_cast(s16x4, __builtin_amdgcn_ds_read_tr16_b64_v4i16((LAS v4i16_t*)(vb + dd * VDB + ks * 1024)));
                vh4[dd][ks] = __builtin_bit_cast(s16x4, __builtin_amdgcn_ds_read_tr16_b64_v4i16((LAS v4i16_t*)(vb + dd * VDB + ks * 1024 + 512))); }
        __builtin_amdgcn_sched_barrier(0);
    }
    const float rm = swapmax(rowmax32(p0, p1) + ladj);
    float mloc = mhat - off;
    if (__any(rm > mloc + THR)) {
        const float mnew = fmaxf(mloc, rm);
        const float f = __builtin_amdgcn_exp2f(mloc - mnew);
        lsum *= f; mloc = mnew; mhat = mnew + off;
        if (hi == 0) wsf[r32] = f;
        asm volatile("s_waitcnt lgkmcnt(0)" ::: "memory");
#pragma unroll
        for (int g = 0; g < 4; ++g) { const f32x4 fv = *(const LAS f32x4*)(wsf + 8 * g + 4 * hi);
#pragma unroll
            for (int d0 = 0; d0 < NDB; ++d0) { o[d0][4 * g] *= fv.x; o[d0][4 * g + 1] *= fv.y; o[d0][4 * g + 2] *= fv.z; o[d0][4 * g + 3] *= fv.w; } }
    }
    float sacc = 0.f;
    const float ml = mloc - ladj;
#pragma unroll
    for (int r = 0; r < 16; ++r) { p0[r] = __builtin_amdgcn_exp2f(p0[r] - ml); p1[r] = __builtin_amdgcn_exp2f(p1[r] - ml); sacc += p0[r] + p1[r]; }
    lsum += sacc;
    bf16x8 pa[4];
    { v4u w;
      w.x = cvtpk(p0[0], p0[1]); w.y = cvtpk(p0[2], p0[3]); w.z = cvtpk(p0[4], p0[5]); w.w = cvtpk(p0[6], p0[7]); pa[0] = __builtin_bit_cast(bf16x8, w);
      w.x = cvtpk(p0[8], p0[9]); w.y = cvtpk(p0[10], p0[11]); w.z = cvtpk(p0[12], p0[13]); w.w = cvtpk(p0[14], p0[15]); pa[1] = __builtin_bit_cast(bf16x8, w);
      w.x = cvtpk(p1[0], p1[1]); w.y = cvtpk(p1[2], p1[3]); w.z = cvtpk(p1[4], p1[5]); w.w = cvtpk(p1[6], p1[7]); pa[2] = __builtin_bit_cast(bf16x8, w);
      w.x = cvtpk(p1[8], p1[9]); w.y = cvtpk(p1[10], p1[11]); w.z = cvtpk(p1[12], p1[13]); w.w = cvtpk(p1[14], p1[15]); pa[3] = __builtin_bit_cast(bf16x8, w); }
    if constexpr (NDB == 2) {
#pragma unroll
        for (int ks = 0; ks < 4; ++ks)
#pragma unroll
            for (int dd = 0; dd < 2; ++dd) {
                const bf16x8 B = (bf16x8){vlo[dd][ks][0], vlo[dd][ks][1], vlo[dd][ks][2], vlo[dd][ks][3], vh4[dd][ks][0], vh4[dd][ks][1], vh4[dd][ks][2], vh4[dd][ks][3]};
                o[dd] = __builtin_amdgcn_mfma_f32_32x32x16_bf16(pa[ks], B, o[dd], 0, 0, 0); }
    } else pv_step<NDB>(o, vt, lane, pa);
}
template <int NDB> __device__ __forceinline__ void finish_rows(float lsum, f32x16 (&o)[NDB], LAS float* wsf, int lane, float rowscale) {
    const int r32 = lane & 31, hi = lane >> 5;
    const float l = swapsum(lsum);
    if (hi == 0) wsf[32 + r32] = rowscale / fmaxf(l, 1e-30f);
    asm volatile("s_waitcnt lgkmcnt(0)" ::: "memory");
#pragma unroll
    for (int g = 0; g < 4; ++g) { const f32x4 fv = *(const LAS f32x4*)(wsf + 32 + 8 * g + 4 * hi);
#pragma unroll
        for (int d0 = 0; d0 < NDB; ++d0) { o[d0][4 * g] *= fv.x; o[d0][4 * g + 1] *= fv.y; o[d0][4 * g + 2] *= fv.z; o[d0][4 * g + 3] *= fv.w; } }
}
__device__ __forceinline__ void store_rows64(const f32x16 (&o)[2], LAS bf16* stg, bf16* gdst, int pitch, int lane) {
    const int d = lane & 31, hi = lane >> 5;
#pragma unroll
    for (int r = 0; r < 16; ++r) { const int row = crow(r, hi); stg[row * 64 + d] = (bf16)f2bf(o[0][r]); stg[row * 64 + 32 + d] = (bf16)f2bf(o[1][r]); }
    asm volatile("s_waitcnt lgkmcnt(0)" ::: "memory");
#pragma unroll
    for (int i = 0; i < 4; ++i) { const int row = i * 8 + (lane >> 3), ch = lane & 7; *(v4u*)(gdst + (size_t)row * pitch + ch * 8) = *(const LAS v4u*)(stg + row * 64 + ch * 8); }
    asm volatile("s_waitcnt lgkmcnt(0)" ::: "memory");
}


template <int NDB, int NK, bool FOX> struct RunCfg {
    LAS unsigned char* lds; int KOFF, VOFF, COFF;
    const bf16* Kg0; const bf16* Kg1; const bf16* Vg; int pitch;
    const float* cg; const LAS float* pre;
    int ksel;
    float slope2; int qw0; int low; bool slc; unsigned long long mysel;
};
template <int NK, int NVH> struct Stage2 { v4u k[NK]; v4u v[NVH]; float ck; };

template <int NDB, int NK, bool FOX> __device__ __forceinline__ void st_issue_k(Stage2<NK, NDB / 2>& st, const RunCfg<NDB, NK, FOX>& R, int j, int tid) {
    const int row = tid >> 3, c = tid & 7;
    st.k[0] = *(const v4u*)(R.Kg0 + (size_t)(64 * j + row) * R.pitch + c * 8);
    if constexpr (NK == 2) st.k[1] = *(const v4u*)(R.Kg1 + (size_t)(64 * j + row) * R.pitch + c * 8);
    if constexpr (FOX) { if (tid < 64) st.ck = (R.cg[(size_t)(64 * j + tid) * 16] + R.pre[j]) * LOG2E; }
}
template <int NDB, int NK, bool FOX> __device__ __forceinline__ void st_commit_k(const Stage2<NK, NDB / 2>& st, const RunCfg<NDB, NK, FOX>& R, int slot, int tid) {
    const int row = tid >> 3, c = tid & 7;
#pragma unroll
    for (int i = 0; i < NK; ++i) *(LAS v4u*)(R.lds + R.KOFF + (slot * NK + i) * KT + c * KCH + row * 16) = st.k[i];
    if constexpr (FOX) { if (tid < 64) ((LAS float*)(R.lds + R.COFF))[slot * 64 + tid] = st.ck; }
}
template <int NDB, int NK, bool FOX> __device__ __forceinline__ void st_issue_v(Stage2<NK, NDB / 2>& st, const RunCfg<NDB, NK, FOX>& R, int j, int tid) {
    const int row = tid >> 3, c = tid & 7;
#pragma unroll
    for (int i = 0; i < NDB / 2; ++i) st.v[i] = *(const v4u*)(R.Vg + (size_t)(64 * j + row) * R.pitch + (c + 8 * i) * 8);
}
template <int NDB, int NK, bool FOX> __device__ __forceinline__ void st_commit_v(const Stage2<NK, NDB / 2>& st, const RunCfg<NDB, NK, FOX>& R, int slot, int tid) {
    const int row = tid >> 3, c = tid & 7;
#pragma unroll
    for (int i = 0; i < NDB / 2; ++i) { const int c16 = c + 8 * i; *(LAS v4u*)(R.lds + R.VOFF + slot * NDB * VDB + (c16 >> 2) * VDB + row * 64 + (c16 & 3) * 16) = st.v[i]; }
}
template <int NDB, int NK, bool FOX> __device__ __forceinline__ bool rt_part(const RunCfg<NDB, NK, FOX>& R, int j) {
    if (j > (R.qw0 >> 6)) return false;
    if (R.slc) return __any(((R.mysel >> j) & 1ull) != 0ull) != 0;
    return true;
}
template <int NDB, int NK, bool FOX> __device__ __forceinline__ void rt_qk(f32x16& p0, f32x16& p1, const RunCfg<NDB, NK, FOX>& R, int j, int slot, float mhat, const bf16x8 (&qr)[4], int lane) {
    const int hi = lane >> 5;
    const LAS unsigned char* kb = R.lds + R.KOFF + (slot * NK + R.ksel) * KT + hi * KCH + (lane & 31) * 16;
    bf16x8 kf[8];
#pragma unroll
    for (int d0 = 0; d0 < 4; ++d0) { kf[2 * d0] = *(const LAS bf16x8*)(kb + d0 * 2 * KCH); kf[2 * d0 + 1] = *(const LAS bf16x8*)(kb + d0 * 2 * KCH + 512); }
    typedef float f32x2 __attribute__((ext_vector_type(2)));
    if constexpr (FOX) {
        const LAS float* ck = (const LAS float*)(R.lds + R.COFF) + slot * 64; const f32x4 nm = (f32x4){-mhat, -mhat, -mhat, -mhat};
#pragma unroll
        for (int g = 0; g < 4; ++g) { const f32x4 c0 = nm - *(const LAS f32x4*)(ck + 8 * g + 4 * hi), c1 = nm - *(const LAS f32x4*)(ck + 32 + 8 * g + 4 * hi);
            p0[4 * g] = c0.x; p0[4 * g + 1] = c0.y; p0[4 * g + 2] = c0.z; p0[4 * g + 3] = c0.w;
            p1[4 * g] = c1.x; p1[4 * g + 1] = c1.y; p1[4 * g + 2] = c1.z; p1[4 * g + 3] = c1.w; }
    } else {
        const float base = R.slope2 * (float)(64 * j + 4 * hi - (R.qw0 + (lane & 31))) - mhat;
        const float s = R.slope2;
        const f32x2 k2 = (f32x2){2.f * s, 2.f * s}, k8 = (f32x2){8.f * s, 8.f * s}, k32 = (f32x2){32.f * s, 32.f * s};
        f32x2 a = (f32x2){base, base + s};
#pragma unroll
        for (int g = 0; g < 4; ++g) { const f32x2 b2 = a + k2, c = a + k32, d2 = b2 + k32;
            p0[4 * g] = a.x; p0[4 * g + 1] = a.y; p0[4 * g + 2] = b2.x; p0[4 * g + 3] = b2.y;
            p1[4 * g] = c.x; p1[4 * g + 1] = c.y; p1[4 * g + 2] = d2.x; p1[4 * g + 3] = d2.y;
            a = a + k8; }
    }
#pragma unroll
    for (int d0 = 0; d0 < 4; ++d0) {
        p0 = __builtin_amdgcn_mfma_f32_32x32x16_bf16(kf[2 * d0], qr[d0], p0, 0, 0, 0);
        p1 = __builtin_amdgcn_mfma_f32_32x32x16_bf16(kf[2 * d0 + 1], qr[d0], p1, 0, 0, 0);
    }
}
template <int NDB, int NK, bool FOX> __device__ __forceinline__ void rt_mask(f32x16& p0, f32x16& p1, const RunCfg<NDB, NK, FOX>& R, int j, int lane) {
    const int hi = lane >> 5, qrel = R.qw0 + (lane & 31) - 64 * j;
    if (j == (R.qw0 >> 6)) {
#pragma unroll
        for (int r = 0; r < 16; ++r) { const int kvl = crow(r, hi); if (kvl > qrel) p0[r] = FA_NEG_INF; if (kvl + 32 > qrel) p1[r] = FA_NEG_INF; }
    }
    if (j == R.low) {
#pragma unroll
        for (int r = 0; r < 16; ++r) { const int kvl = crow(r, hi); if (kvl <= qrel - 512) p0[r] = FA_NEG_INF; if (kvl + 32 <= qrel - 512) p1[r] = FA_NEG_INF; }
    }
    if (R.slc) {
        if (((R.mysel >> j) & 1ull) == 0ull) {
#pragma unroll
            for (int r = 0; r < 16; ++r) { p0[r] = FA_NEG_INF; p1[r] = FA_NEG_INF; }
        }
    }
}
template <int NDB> __device__ __forceinline__ void rt_softmax_pv(float& mhat, float& st, float& lsum, f32x16 (&o)[NDB], f32x16& s0, f32x16& s1, bool has_next, f32x16& n0, f32x16& n1,
                                                                 const LAS unsigned char* vt, LAS float* wsf, int lane) {
    const int r32 = lane & 31, hi = lane >> 5;
    const float rm = swapmax(rowmax32(s0, s1));
    const bool fresh = (st == 0.f), live = rm > FA_NEG_INF;
    const bool trig = (rm > THR) || (fresh && live);
    if (__any(trig)) {
        const float d = trig ? (fresh ? rm : fmaxf(rm, 0.f)) : 0.f;
        const float f = fresh ? 1.f : __builtin_amdgcn_exp2f(-d);
        mhat += d; lsum *= f; st = live ? 1.f : st;
#pragma unroll
        for (int r = 0; r < 16; ++r) { s0[r] -= d; s1[r] -= d; }
        if (has_next) {
#pragma unroll
            for (int r = 0; r < 16; ++r) { n0[r] -= d; n1[r] -= d; }
        }
        if (hi == 0) wsf[r32] = f;
        asm volatile("s_waitcnt lgkmcnt(0)" ::: "memory");
#pragma unroll
        for (int g = 0; g < 4; ++g) { const f32x4 fv = *(const LAS f32x4*)(wsf + 8 * g + 4 * hi);
#pragma unroll
            for (int d0 = 0; d0 < NDB; ++d0) { o[d0][4 * g] *= fv.x; o[d0][4 * g + 1] *= fv.y; o[d0][4 * g + 2] *= fv.z; o[d0][4 * g + 3] *= fv.w; } }
    }
    typedef float f32x2 __attribute__((ext_vector_type(2)));
    f32x2 sa = (f32x2){0.f, 0.f}, sb = (f32x2){0.f, 0.f};
#pragma unroll
    for (int r = 0; r < 16; r += 2) { s0[r] = __builtin_amdgcn_exp2f(s0[r]); s0[r + 1] = __builtin_amdgcn_exp2f(s0[r + 1]); s1[r] = __builtin_amdgcn_exp2f(s1[r]); s1[r + 1] = __builtin_amdgcn_exp2f(s1[r + 1]);
        sa = sa + (f32x2){s0[r], s0[r + 1]}; sb = sb + (f32x2){s1[r], s1[r + 1]}; }
    sa = sa + sb;
    lsum += sa.x + sa.y;
    bf16x8 pa[4];
    { v4u w;
      w.x = cvtpk(s0[0], s0[1]); w.y = cvtpk(s0[2], s0[3]); w.z = cvtpk(s0[4], s0[5]); w.w = cvtpk(s0[6], s0[7]); pa[0] = __builtin_bit_cast(bf16x8, w);
      w.x = cvtpk(s0[8], s0[9]); w.y = cvtpk(s0[10], s0[11]); w.z = cvtpk(s0[12], s0[13]); w.w = cvtpk(s0[14], s0[15]); pa[1] = __builtin_bit_cast(bf16x8, w);
      w.x = cvtpk(s1[0], s1[1]); w.y = cvtpk(s1[2], s1[3]); w.z = cvtpk(s1[4], s1[5]); w.w = cvtpk(s1[6], s1[7]); pa[2] = __builtin_bit_cast(bf16x8, w);
      w.x = cvtpk(s1[8], s1[9]); w.y = cvtpk(s1[10], s1[11]); w.z = cvtpk(s1[12], s1[13]); w.w = cvtpk(s1[14], s1[15]); pa[3] = __builtin_bit_cast(bf16x8, w); }
    pv_step<NDB>(o, vt, lane, pa);
}
struct RunState { int j0, j1, j2; unsigned long long rem; int ks0, ks1, ks2, vs0; bool c0; };
__device__ __forceinline__ int rs_pop(unsigned long long& rem) { if (!rem) return -1; const int j = __builtin_ctzll(rem); rem &= rem - 1; return j; }
template <int NDB, int NK, bool FOX> __device__ __forceinline__ bool rt_step(RunState& T, Stage2<NK, NDB / 2>& stg, const RunCfg<NDB, NK, FOX>& R, int tid,
        const bf16x8 (&qr)[4], float& mhat, float& st, float& lsum, f32x16 (&o)[NDB], f32x16& c0, f32x16& c1, f32x16& n0, f32x16& n1, LAS float* wsf) {
    const int lane = tid & 63;
    const bool pn = (T.j1 >= 0) && rt_part(R, T.j1);
    if (pn) rt_qk(n0, n1, R, T.j1, T.ks1, mhat, qr, lane);
    if (T.c0) { rt_mask(c0, c1, R, T.j0, lane);
        rt_softmax_pv<NDB>(mhat, st, lsum, o, c0, c1, pn, n0, n1, R.lds + R.VOFF + T.vs0 * NDB * VDB, wsf, lane); }
    if (T.j1 < 0) { FA_SYNC(); return false; }
    if (T.j2 >= 0) st_commit_k(stg, R, T.ks2, tid);
    st_commit_v(stg, R, T.vs0 ^ 1, tid);
    const int j3 = rs_pop(T.rem);
    if (j3 >= 0) st_issue_k(stg, R, j3, tid);
    if (T.j2 >= 0) st_issue_v(stg, R, T.j2, tid);
    FA_SYNC();
    T.j0 = T.j1; T.j1 = T.j2; T.j2 = j3; const int s = T.ks0; T.ks0 = T.ks1; T.ks1 = T.ks2; T.ks2 = s; T.vs0 ^= 1; T.c0 = pn;
    return true;
}
template <int NDB, int NK, bool FOX> __device__ __forceinline__ void run_tiles(const RunCfg<NDB, NK, FOX>& R, int tid, unsigned long long tiles,
        const bf16x8 (&qr)[4], float& mhat, float& st, float& lsum, f32x16 (&o)[NDB], LAS float* wsf) {
    const int lane = tid & 63;
    Stage2<NK, NDB / 2> stg; stg.ck = 0.f;
    RunState T; T.rem = tiles; T.ks0 = 0; T.ks1 = 1; T.ks2 = 2; T.vs0 = 0;
    T.j0 = rs_pop(T.rem);
    st_issue_k(stg, R, T.j0, tid); st_issue_v(stg, R, T.j0, tid);
    st_commit_k(stg, R, 0, tid); st_commit_v(stg, R, 0, tid);
    T.j1 = rs_pop(T.rem);
    if (T.j1 >= 0) { st_issue_k(stg, R, T.j1, tid); st_commit_k(stg, R, 1, tid); st_issue_v(stg, R, T.j1, tid); }
    T.j2 = rs_pop(T.rem);
    if (T.j2 >= 0) st_issue_k(stg, R, T.j2, tid);
    FA_SYNC();
    f32x16 a0, a1, b0, b1;
    T.c0 = rt_part(R, T.j0);
    if (T.c0) rt_qk(a0, a1, R, T.j0, 0, mhat, qr, lane);
    for (;;) {
        if (!rt_step(T, stg, R, tid, qr, mhat, st, lsum, o, a0, a1, b0, b1, wsf)) break;
        if (!rt_step(T, stg, R, tid, qr, mhat, st, lsum, o, b0, b1, a0, a1, wsf)) break;
    }
}

struct CvtRide { TItem t; int it, hi, step; bool full; const float* wg; const float* wu; const float* wd; unsigned char* ws; LAS float* scr; };
__device__ __forceinline__ TItem ride_decode(const CvtRide& Cv, int r) {
    constexpr int IT_MOE = 16 * 32; unsigned char* ws = Cv.ws; TItem t;
    const int le = r / (3 * IT_MOE); r -= le * 3 * IT_MOE; const int which = r / IT_MOE; r -= which * IT_MOE; const int kb = r / 32, nb = r % 32, n0 = 32 * nb;
    t.k0 = 64 * kb; t.n0 = n0;
    if (which < 2) { t.W = (which == 0 ? Cv.wg : Cv.wu) + (size_t)le * D * FF; t.ld = FF; t.K = D; t.WT = WSP(bf16, WS_WGUT) + (size_t)le * 2048 * 1024; t.drow0 = (n0 >> 7) * 256 + which * 128 + (n0 & 127); }
    else { t.W = Cv.wd + (size_t)le * FF * D; t.ld = D; t.K = FF; t.WT = WSP(bf16, WS_WDT) + (size_t)le * 1024 * 1024; t.drow0 = n0; }
    return t;
}
__device__ __forceinline__ void ride_emit(const TItem& t, const LAS float* scr, int lane) {
    const int n = lane & 31, ch = lane >> 5;
#pragma unroll
    for (int jj = 0; jj < 4; ++jj) { const int c = 2 * jj + ch;
        float s[8];
#pragma unroll
        for (int q = 0; q < 8; ++q) s[q] = scr[(8 * c + q) * 32 + n];
        v4u o; o.x = pg8::cvt_pk_bf16(s[0], s[1]); o.y = pg8::cvt_pk_bf16(s[2], s[3]); o.z = pg8::cvt_pk_bf16(s[4], s[5]); o.w = pg8::cvt_pk_bf16(s[6], s[7]);
        *(v4u*)(t.WT + (size_t)(t.drow0 + n) * t.K + t.k0 + 8 * c) = o; }
    asm volatile("s_waitcnt lgkmcnt(0)" ::: "memory");
}
__device__ __forceinline__ void ride_finish(CvtRide& Cv, int lane) {
    if (Cv.full) { asm volatile("s_waitcnt vmcnt(0)" ::: "memory"); ride_emit(Cv.t, Cv.scr, lane); Cv.full = false; }
}
__device__ __forceinline__ void ride_finish3(CvtRide& Cv, int lane) {
    if (Cv.full) { asm volatile("s_waitcnt vmcnt(3)" ::: "memory"); ride_emit(Cv.t, Cv.scr, lane); Cv.full = false; }
}
__device__ __forceinline__ void ride_finish2(CvtRide& Cv, int lane) {
    if (Cv.full) { asm volatile("s_waitcnt vmcnt(2)" ::: "memory"); ride_emit(Cv.t, Cv.scr, lane); Cv.full = false; }
}
__device__ __forceinline__ void ride_start(CvtRide& Cv, int lane) {
    if (!Cv.full && Cv.it < Cv.hi) {
        Cv.t = ride_decode(Cv, Cv.it); Cv.it += Cv.step; Cv.full = true;
        const __amdgpu_buffer_rsrc_t rs = __builtin_amdgcn_make_buffer_rsrc((void*)(Cv.t.W + (size_t)Cv.t.k0 * Cv.t.ld + Cv.t.n0), (short)0, 64 * Cv.t.ld * 4, 0x00020000);
        int ln = lane; asm volatile("" : "+v"(ln));
        const int voff = ((ln >> 3) * Cv.t.ld + (ln & 7) * 4) * 4;
#pragma unroll
        for (int i = 0; i < 8; ++i) __builtin_amdgcn_raw_ptr_buffer_load_lds(rs, (LAS void*)(Cv.scr + i * 256), 16, voff, i * 8 * Cv.t.ld * 4, 0, 0);
    }
}
constexpr int FX_KB = 0, FX_VB = 2 * KT, FX_CK = FX_VB + 2 * 2 * VDB, FX_WSF = FX_CK + 512, FX_OST = FX_WSF + 8 * 256, FX_PRE = FX_OST + 8 * 4096, FX_FLG = FX_PRE + 256, FX_END = FX_FLG + 128;
constexpr float PRUNE = 40.f;
__device__ __forceinline__ void fox_unit(LAS unsigned char* lds, int tid_in, int b, int h, int qt, const bf16* QKV, const float* CUM, const float* CHTOT, bf16* AO, float knmax, CvtRide& Cv) {
    int tid = tid_in; asm volatile("" : "+v"(tid));
    const int lane = tid & 63, wid = __builtin_amdgcn_readfirstlane(tid >> 6), r32 = lane & 31, hi = lane >> 5;
    const int q0 = qt * 256, qw0 = q0 + wid * 32, NT = 4 * (qt + 1), dg = qw0 >> 6;
    const bf16* Kg = QKV + (size_t)(b * S) * QP + 1024 + h * 64;
    const bf16* Vg = QKV + (size_t)(b * S) * QP + 2048 + h * 64;
    const float* cg = CUM + (size_t)(b * S) * 16 + h;
    LAS float* wsf = (LAS float*)(lds + FX_WSF) + wid * 64;
    LAS float* pre = (LAS float*)(lds + FX_PRE);
    LAS int* flg = (LAS int*)(lds + FX_FLG);
    if (wid == 0) {
        const float val = (lane < NT) ? CHTOT[(size_t)(b * 64 + lane) * 16 + h] : 0.f; float inc = val;
#pragma unroll
        for (int o = 1; o < 64; o <<= 1) { const float u = shl_(inc, lane - o); if (lane >= o) inc += u; }
        pre[lane] = inc - val;
    }
    bf16x8 qr[4]; load_q(qr, QKV + (size_t)(b * S + qw0 + r32) * QP + h * 64, hi);
    float ub;
    { float s2 = 0.f;
#pragma unroll
      for (int d0 = 0; d0 < 4; ++d0) { const v4u u = __builtin_bit_cast(v4u, qr[d0]);
          const float a0 = bf2f(u.x & 0xffffu), a1 = bf2f(u.x >> 16), a2 = bf2f(u.y & 0xffffu), a3 = bf2f(u.y >> 16), a4 = bf2f(u.z & 0xffffu), a5 = bf2f(u.z >> 16), a6 = bf2f(u.w & 0xffffu), a7 = bf2f(u.w >> 16);
          s2 += (a0 * a0 + a1 * a1) + (a2 * a2 + a3 * a3) + (a4 * a4 + a5 * a5) + (a6 * a6 + a7 * a7); }
      ub = sqrtf(swapsum(s2)) * knmax * 1.01f + 0.01f; }
    float mhat = NEGBIG, lsum = 0.f; f32x16 o[2];
#pragma unroll
    for (int i = 0; i < 16; ++i) { o[0][i] = 0.f; o[1][i] = 0.f; }
    FA_SYNC();
    Stage<1, 1> stA, stB; float ckA = 0.f, ckB = 0.f;
    const int ck_t = tid & 63;
#define FX_ISSUE(ST, CK, jj) do { const int j_ = (jj); tile_issue<1, 1>(ST, Kg + (size_t)(64 * j_) * QP, Kg, QP, Vg + (size_t)(64 * j_) * QP, QP, tid); \
        CK = (cg[(size_t)(64 * j_ + ck_t) * 16] + pre[j_]) * LOG2E; } while (0)
    FX_ISSUE(stA, ckA, NT - 1);
    tile_commit<1, 1>(stA, lds + FX_KB, lds + FX_VB, tid); if (tid < 64) ((LAS float*)(lds + FX_CK))[tid] = ckA;
    FX_ISSUE(stA, ckA, NT - 2);
    FX_ISSUE(stB, ckB, NT - 3);
    FA_SYNC();
    bool mine = true;
    int i = 0;
#define FX_STEP(ST, CK) { \
        const int j = NT - 1 - i, kv0 = j * 64, bsel = i & 1; \
        if (j == dg || (j < dg && mine)) { \
            const LAS unsigned char* kt = lds + FX_KB + bsel * KT; const LAS unsigned char* vt = lds + FX_VB + bsel * 2 * VDB; \
            const LAS float* ck = (const LAS float*)(lds + FX_CK) + bsel * 64; \
            f32x16 p0, p1; qk_tile(p0, p1, qr, kt, lane); \
            _Pragma("unroll") \
            for (int g = 0; g < 4; ++g) { const f32x4 c0 = *(const LAS f32x4*)(ck + 8 * g + 4 * hi), c1 = *(const LAS f32x4*)(ck + 32 + 8 * g + 4 * hi); \
                p0[4 * g] -= c0.x; p0[4 * g + 1] -= c0.y; p0[4 * g + 2] -= c0.z; p0[4 * g + 3] -= c0.w; \
                p1[4 * g] -= c1.x; p1[4 * g + 1] -= c1.y; p1[4 * g + 2] -= c1.z; p1[4 * g + 3] -= c1.w; } \
            if (j == dg) {                \
                const int qrel = qw0 + r32 - kv0; \
                _Pragma("unroll") \
                for (int r = 0; r < 16; ++r) { const int kvl = crow(r, hi); if (kvl > qrel) p0[r] = FA_NEG_INF; if (kvl + 32 > qrel) p1[r] = FA_NEG_INF; } \
            } \
            softmax_pv<2>(mhat, lsum, o, p0, p1, 0.f, 0.f, vt, wsf, lane); \
        } \
        if (j == 0) { FA_SYNC(); break; } \
          \
        const int jn = j - 1; \
        if (jn < dg) mine = mine && (__any((ub - pre[jn + 1] * LOG2E) - mhat > -PRUNE) != 0);        \
        if (lane == 0) flg[(i & 1) * 8 + wid] = (jn >= dg || mine) ? 1 : 0; \
        tile_commit<1, 1>(ST, lds + FX_KB + (bsel ^ 1) * KT, lds + FX_VB + (bsel ^ 1) * 2 * VDB, tid); if (tid < 64) ((LAS float*)(lds + FX_CK))[(bsel ^ 1) * 64 + tid] = CK; \
        if (i % 3 == 2) { if (j >= 2) ride_finish3(Cv, lane); else ride_finish(Cv, lane); }        \
        if (j >= 3) FX_ISSUE(ST, CK, j - 3); \
        if (i % 3 == 0) ride_start(Cv, lane);                 \
        FA_SYNC(); \
        { const LAS int* f = flg + (i & 1) * 8; const int any = (f[0] | f[1]) | (f[2] | f[3]) | (f[4] | f[5]) | (f[6] | f[7]); \
          if (__builtin_amdgcn_readfirstlane(any) == 0) break; } \
        ++i; }
    for (;;) { FX_STEP(stA, ckA) FX_STEP(stB, ckB) }
#undef FX_STEP
#undef FX_ISSUE
    finish_rows<2>(lsum, o, wsf, lane, 1.f);
    store_rows64(o, (LAS bf16*)(lds + FX_OST) + wid * 2048, AO + (size_t)(b * S + qw0) * D + h * 64, D, lane);
}

__device__ __forceinline__ float alibi_mod(f32x16& p0, f32x16& p1, float slope2, int qrel, bool causal, bool lower, bool flagged, bool flag, int hi) {
#pragma unroll
    for (int r = 0; r < 16; ++r) { const int c = (r & 3) + 8 * (r >> 2); p0[r] = __builtin_fmaf(slope2, (float)c, p0[r]); p1[r] = __builtin_fmaf(slope2, (float)(c + 32), p1[r]); }
    if (causal) {
#pragma unroll
        for (int r = 0; r < 16; ++r) { const int kvl = crow(r, hi); if (kvl > qrel) p0[r] = FA_NEG_INF; if (kvl + 32 > qrel) p1[r] = FA_NEG_INF; }
    }
    if (lower) {
#pragma unroll
        for (int r = 0; r < 16; ++r) { const int kvl = crow(r, hi); if (kvl <= qrel - 512) p0[r] = FA_NEG_INF; if (kvl + 32 <= qrel - 512) p1[r] = FA_NEG_INF; }
    }
    if (flagged) {
        if (!flag) {
#pragma unroll
            for (int r = 0; r < 16; ++r) { p0[r] = FA_NEG_INF; p1[r] = FA_NEG_INF; }
        }
    }
    return slope2 * (float)(-qrel);
}

constexpr int DF_KB = 0, DF_VB = 4 * KT, DF_WSF = DF_VB + 2 * 4 * VDB, DF_X = DF_WSF + 8 * 256, DF_XW = 32 * 132 * 4, DF_FLG = DF_X + 4 * DF_XW, DF_UB = DF_FLG + 64, DF_END = DF_UB + 1024;
__device__ __forceinline__ void diff_unit(LAS unsigned char* lds, int tid_in, int b, int h, int qt, const bf16* QKV, bf16* AO, float lam, int lpost, const float* subg, const unsigned* KN2) {
    int tid = tid_in; asm volatile("" : "+v"(tid));
    const int lane = tid & 63, wid = __builtin_amdgcn_readfirstlane(tid >> 6), r32 = lane & 31, hi = lane >> 5;
    const int cs = wid >> 2, q0 = qt * 128, qw0 = q0 + (wid & 3) * 32, NT = 2 * (qt + 1), dg = qw0 >> 6;
    const bf16* K0 = QKV + (size_t)(b * S) * QP + C_AK + h * 128;
    const bf16* Vg = QKV + (size_t)(b * S) * QP + C_AV + h * 128;
    const float slope2 = exp2f(-2.f * (float)(h + 1)) * LOG2E;
    LAS float* wsf = (LAS float*)(lds + DF_WSF) + wid * 64;
    LAS int* flg = (LAS int*)(lds + DF_FLG);
    bf16x8 qr[4]; load_q(qr, QKV + (size_t)(b * S + qw0 + r32) * QP + C_AQ + h * 128 + cs * 64, hi);
    float ub;
    { float s2 = 0.f;
#pragma unroll
      for (int d0 = 0; d0 < 4; ++d0) { const v4u u = __builtin_bit_cast(v4u, qr[d0]);
          const float a0 = bf2f(u.x & 0xffffu), a1 = bf2f(u.x >> 16), a2 = bf2f(u.y & 0xffffu), a3 = bf2f(u.y >> 16), a4 = bf2f(u.z & 0xffffu), a5 = bf2f(u.z >> 16), a6 = bf2f(u.w & 0xffffu), a7 = bf2f(u.w >> 16);
          s2 += (a0 * a0 + a1 * a1) + (a2 * a2 + a3 * a3) + (a4 * a4 + a5 * a5) + (a6 * a6 + a7 * a7); }
      const unsigned* kg = KN2 + b * 96 + 16 + 4 * h + 2 * cs;
      ub = sqrtf(swapsum(s2)) * sqrtf(__uint_as_float(kg[0]) + __uint_as_float(kg[1])) * 1.01f + 0.01f; }
    LAS float* ubs = (LAS float*)(lds + DF_UB) + wid * 32 + r32;
    *ubs = ub;
    float mhat = NEGBIG, lsum = 0.f; f32x16 o[4];
#pragma unroll
    for (int i = 0; i < 16; ++i) { o[0][i] = 0.f; o[1][i] = 0.f; o[2][i] = 0.f; o[3][i] = 0.f; }
    Stage<2, 2> st;
    { const size_t ro = (size_t)(64 * (NT - 1)) * QP; tile_issue<2, 2>(st, K0 + ro, K0 + ro + 64, QP, Vg + ro, QP, tid); }
    tile_commit<2, 2>(st, lds + DF_KB, lds + DF_VB, tid);
    { const size_t ro = (size_t)(64 * (NT - 2)) * QP; tile_issue<2, 2>(st, K0 + ro, K0 + ro + 64, QP, Vg + ro, QP, tid); }
    FA_SYNC();
    bool mine = true;
    for (int i = 0;; ++i) {
        const int j = NT - 1 - i, kv0 = j * 64, bsel = i & 1;
        if (j == dg || (j < dg && mine)) {
            const LAS unsigned char* kt = lds + DF_KB + (bsel * 2 + cs) * KT; const LAS unsigned char* vt = lds + DF_VB + bsel * 4 * VDB;
            f32x16 p0, p1; qk_tile(p0, p1, qr, kt, lane);
            const float off = alibi_mod(p0, p1, slope2, qw0 + r32 - kv0, j == dg, false, false, true, hi);
            softmax_pv<4>(mhat, lsum, o, p0, p1, off, slope2 * (float)(4 * hi), vt, wsf, lane);
        }
        if (j == 0) { FA_SYNC(); break; }
        const int jn = j - 1;
        if (jn < dg) mine = mine && (__any((*ubs + slope2 * (float)(64 * jn + 63 - (qw0 + r32))) - mhat > -PRUNE) != 0);
        if (lane == 0) flg[(i & 1) * 8 + wid] = (jn >= dg || mine) ? 1 : 0;
        tile_commit<2, 2>(st, lds + DF_KB + (bsel ^ 1) * 2 * KT, lds + DF_VB + (bsel ^ 1) * 4 * VDB, tid);
        if (j >= 2) { const size_t ro = (size_t)(64 * (j - 2)) * QP; tile_issue<2, 2>(st, K0 + ro, K0 + ro + 64, QP, Vg + ro, QP, tid); }
        FA_SYNC();
        { const LAS int* f = flg + (i & 1) * 8; const int any = (f[0] | f[1]) | (f[2] | f[3]) | (f[4] | f[5]) | (f[6] | f[7]);
          if (__builtin_amdgcn_readfirstlane(any) == 0) break; }
    }
    finish_rows<4>(lsum, o, wsf, lane, 1.f);
    LAS float* X = (LAS float*)(lds + DF_X + (wid & 3) * DF_XW);
    if (cs == 1) {
#pragma unroll
        for (int r = 0; r < 16; ++r)
#pragma unroll
            for (int d0 = 0; d0 < 4; ++d0) X[crow(r, hi) * 132 + d0 * 32 + r32] = o[d0][r];
    }
    FA_SYNC();
    if (cs == 0) {
#pragma unroll
        for (int r = 0; r < 16; ++r)
#pragma unroll
            for (int d0 = 0; d0 < 4; ++d0) { LAS float* xp = X + crow(r, hi) * 132 + d0 * 32 + r32; *xp = o[d0][r] - lam * *xp; }
        asm volatile("s_waitcnt lgkmcnt(0)" ::: "memory");
        const int row = lane >> 1, half = lane & 1;
        f32x4 v[16]; float ss = 0.f;
#pragma unroll
        for (int i = 0; i < 16; ++i) { v[i] = *(const LAS f32x4*)(X + row * 132 + half * 64 + 4 * i); ss += (v[i].x * v[i].x + v[i].y * v[i].y) + (v[i].z * v[i].z + v[i].w * v[i].w); }
        ss += shx<1>(ss);
        int lp_ = lpost; asm volatile("" : "+s"(lp_));
        const float post = (lp_ == 0) ? 0.8f : (lp_ == 1) ? 0.64449093f : (lp_ == 2) ? 0.52928698f : 0.44394179f;
        const float rs = rsqrtf(ss * (1.f / 128.f) + EPS) * post;
        bf16* dst = AO + (size_t)(b * S + qw0 + row) * D + h * 128 + half * 64;
#pragma unroll
        for (int i = 0; i < 8; ++i) { const f32x4 g0 = *(const f32x4*)(subg + half * 64 + 8 * i), g1 = *(const f32x4*)(subg + half * 64 + 8 * i + 4);
            v4u w; w.x = cvtpk(v[2 * i].x * rs * g0.x, v[2 * i].y * rs * g0.y); w.y = cvtpk(v[2 * i].z * rs * g0.z, v[2 * i].w * rs * g0.w);
            w.z = cvtpk(v[2 * i + 1].x * rs * g1.x, v[2 * i + 1].y * rs * g1.y); w.w = cvtpk(v[2 * i + 1].z * rs * g1.z, v[2 * i + 1].w * rs * g1.w);
            *(v4u*)(dst + 8 * i) = w; }
    }
    FA_SYNC();
}

constexpr int NS_KB = 0, NS_VB = 4 * KT, NS_WSF = NS_VB + 4 * 2 * VDB, NS_IMP = NS_WSF + 8 * 256, NS_SEL = NS_IMP + 65536, NS_UNI = NS_SEL + 512, NS_END = NS_UNI + 64;
__device__ __forceinline__ void nsa_branch(LAS unsigned char* lds, int tid, const bool SLC, unsigned long long tiles, const bf16* Kg, const bf16* Vg, int cur, int qw0, float slope2,
                                           unsigned long long mysel, const bf16x8 (&qr)[4], float& mhat, float& lsum, f32x16 (&o)[2], LAS float* wsf, CvtRide& Cv) {
    const int lane = tid & 63, r32 = lane & 31, hi = lane >> 5;
    Stage<1, 1> stA, stB;
    unsigned long long rem = tiles;
    int jc = __builtin_ctzll(rem); rem &= rem - 1;
    tile_issue<1, 1>(stA, Kg + (size_t)(64 * jc) * QP, Kg, QP, Vg + (size_t)(64 * jc) * QP, QP, tid);
    tile_commit<1, 1>(stA, lds + NS_KB, lds + NS_VB, tid);
    int j1 = -1; if (rem) { j1 = __builtin_ctzll(rem); rem &= rem - 1; tile_issue<1, 1>(stA, Kg + (size_t)(64 * j1) * QP, Kg, QP, Vg + (size_t)(64 * j1) * QP, QP, tid); }
    int j2 = -1; if (rem) { j2 = __builtin_ctzll(rem); rem &= rem - 1; tile_issue<1, 1>(stB, Kg + (size_t)(64 * j2) * QP, Kg, QP, Vg + (size_t)(64 * j2) * QP, QP, tid); }
    FA_SYNC();
    int bsel = 0, nride = 0;
#define NSB_STEP(SA) { \
        const bool flag = SLC ? (((mysel >> jc) & 1ull) != 0ull) : true; \
        if (__any(flag)) { \
            const LAS unsigned char* kt = lds + NS_KB + bsel * KT; const LAS unsigned char* vt = lds + NS_VB + bsel * 2 * VDB; \
            f32x16 p0, p1; qk_tile(p0, p1, qr, kt, lane); \
            const float off = alibi_mod(p0, p1, slope2, qw0 + r32 - 64 * jc, jc == cur, (!SLC) && (jc == cur - 8), SLC, flag, hi); \
            softmax_pv<2>(mhat, lsum, o, p0, p1, off, slope2 * (float)(4 * hi), vt, wsf, lane); \
        } \
        if (j1 < 0) { ride_finish(Cv, lane); FA_SYNC(); break; }        \
        tile_commit<1, 1>(SA, lds + NS_KB + (bsel ^ 1) * KT, lds + NS_VB + (bsel ^ 1) * 2 * VDB, tid); \
        ++nride; if (nride == 3) { if (j2 >= 0) ride_finish2(Cv, lane); else ride_finish(Cv, lane); nride = 0; }        \
        int j3 = -1; if (rem) { j3 = __builtin_ctzll(rem); rem &= rem - 1; tile_issue<1, 1>(SA, Kg + (size_t)(64 * j3) * QP, Kg, QP, Vg + (size_t)(64 * j3) * QP, QP, tid); } \
        if (nride == 1) ride_start(Cv, lane); \
        FA_SYNC(); \
        jc = j1; j1 = j2; j2 = j3; bsel ^= 1; }
    for (;;) { NSB_STEP(stA) NSB_STEP(stB) }
#undef NSB_STEP
}
__device__ __forceinline__ void nsa_unit(LAS unsigned char* lds, int tid_in, int b, int g, int qt, const bf16* QKV, const bf16* KC, const bf16* VC, const float* GL, bf16* AO, CvtRide& Cv) {
    int tid = tid_in; asm volatile("" : "+v"(tid));
    const int lane = tid & 63, wid = __builtin_amdgcn_readfirstlane(tid >> 6), r32 = lane & 31, hi = lane >> 5;
    const int hg = wid & 3, psub = wid >> 2, cur = qt, q0 = qt * 64, qw0 = q0 + psub * 32, head = g * 4 + hg;
    const int qpos = qw0 + r32, trow = b * S + qpos;
    const float slope2 = exp2f(-(float)(head + 1)) * LOG2E;
    LAS float* wsf = (LAS float*)(lds + NS_WSF) + wid * 64;
    bf16x8 qr[4]; load_q(qr, QKV + (size_t)trow * QP + C_BQ + head * 64, hi);
    const float g_cmp = sigmoidf_(GL[(size_t)trow * 32 + head * 3 + 0]), g_slc = sigmoidf_(GL[(size_t)trow * 32 + head * 3 + 1]), g_win = sigmoidf_(GL[(size_t)trow * 32 + head * 3 + 2]);
    f32x16 outa[2];
    const int nmax = (q0 + 32) >> 4, ntc = (nmax >> 6) + 1;
    { Stage<1, 1> st;
#pragma unroll 1
      for (int tt = 0; tt < ntc; ++tt) {
          const bf16* kc = KC + ((size_t)(b * 256 + 64 * tt) * 2 + g) * 64; const bf16* vc = VC + ((size_t)(b * 256 + 64 * tt) * 2 + g) * 64;
          tile_issue<1, 1>(st, kc, kc, 128, vc, 128, tid);
          tile_commit<1, 1>(st, lds + NS_KB + tt * KT, lds + NS_VB + tt * 2 * VDB, tid);
      } }
    FA_SYNC();
    {
        float m = FA_NEG_INF, l = 0.f;
#pragma unroll 1
        for (int tt = 0; tt < ntc; ++tt) {
            f32x16 p0, p1; qk_tile(p0, p1, qr, lds + NS_KB + tt * KT, lane);
            float rm = FA_NEG_INF;
            const int dbase = qpos - 31 - 16 * (64 * tt + 4 * hi);
#pragma unroll
            for (int r = 0; r < 16; ++r) { const int d0 = dbase - 16 * ((r & 3) + 8 * (r >> 2)), d1 = d0 - 16 * 32;
                p0[r] = (d0 >= 0) ? p0[r] - slope2 * (float)d0 : FA_NEG_INF; p1[r] = (d1 >= 0) ? p1[r] - slope2 * (float)d1 : FA_NEG_INF;
                rm = fmaxf(rm, fmaxf(p0[r], p1[r])); }
            rm = swapmax(rm);
            const float mn = fmaxf(m, rm);
            if (mn > FA_NEG_INF) {
                float sa = 0.f;
#pragma unroll
                for (int r = 0; r < 16; ++r) sa += __builtin_amdgcn_exp2f(p0[r] - mn) + __builtin_amdgcn_exp2f(p1[r] - mn);
                l = l * __builtin_amdgcn_exp2f(m - mn) + sa; m = mn;
            }
        }
        l = swapsum(l);
        const float inv = (l > 0.f) ? 1.f / l : 0.f;
        const float mref = (m > FA_NEG_INF) ? m : 0.f;
        f32x16 oc[2];
#pragma unroll
        for (int i = 0; i < 16; ++i) { oc[0][i] = 0.f; oc[1][i] = 0.f; }
        LAS float* imp = (LAS float*)(lds + NS_IMP) + (hg * 64 + psub * 32 + r32) * 64;
        float carry = 0.f;
#pragma unroll 1
        for (int tt = 0; tt < ntc; ++tt) {
            f32x16 p0, p1; qk_tile(p0, p1, qr, lds + NS_KB + tt * KT, lane);
            const int dbase = qpos - 31 - 16 * (64 * tt + 4 * hi);
#pragma unroll
            for (int r = 0; r < 16; ++r) { const int d0 = dbase - 16 * ((r & 3) + 8 * (r >> 2)), d1 = d0 - 16 * 32;
                p0[r] = (d0 >= 0) ? __builtin_amdgcn_exp2f(p0[r] - slope2 * (float)d0 - mref) * inv : 0.f;
                p1[r] = (d1 >= 0) ? __builtin_amdgcn_exp2f(p1[r] - slope2 * (float)d1 - mref) * inv : 0.f; }
#pragma unroll
            for (int h2 = 0; h2 < 2; ++h2)
#pragma unroll
                for (int mm = 0; mm < 4; ++mm) {
                    const f32x16& pp = h2 ? p1 : p0;
                    const float G = (pp[4 * mm] + pp[4 * mm + 1]) + (pp[4 * mm + 2] + pp[4 * mm + 3]), L = pp[4 * mm + 3];
                    auto rr = __builtin_amdgcn_permlane32_swap(__float_as_uint(L), __float_as_uint(L), false, false);
                    const float Lo = __uint_as_float(hi ? rr[0] : rr[1]);
                    const float val = G + (hi ? Lo : carry);
                    carry = Lo;
                    imp[16 * tt + 8 * h2 + 2 * mm + hi] = val;
                }
            bf16x8 pa[4];
            { v4u w;
              w.x = cvtpk(p0[0], p0[1]); w.y = cvtpk(p0[2], p0[3]); w.z = cvtpk(p0[4], p0[5]); w.w = cvtpk(p0[6], p0[7]); pa[0] = __builtin_bit_cast(bf16x8, w);
              w.x = cvtpk(p0[8], p0[9]); w.y = cvtpk(p0[10], p0[11]); w.z = cvtpk(p0[12], p0[13]); w.w = cvtpk(p0[14], p0[15]); pa[1] = __builtin_bit_cast(bf16x8, w);
              w.x = cvtpk(p1[0], p1[1]); w.y = cvtpk(p1[2], p1[3]); w.z = cvtpk(p1[4], p1[5]); w.w = cvtpk(p1[6], p1[7]); pa[2] = __builtin_bit_cast(bf16x8, w);
              w.x = cvtpk(p1[8], p1[9]); w.y = cvtpk(p1[10], p1[11]); w.z = cvtpk(p1[12], p1[13]); w.w = cvtpk(p1[14], p1[15]); pa[3] = __builtin_bit_cast(bf16x8, w); }
            pv_step<2>(oc, lds + NS_VB + tt * 2 * VDB, lane, pa);
        }
        if (hi == 0) wsf[32 + r32] = g_cmp;
        asm volatile("s_waitcnt lgkmcnt(0)" ::: "memory");
#pragma unroll
        for (int gq = 0; gq < 4; ++gq) { const f32x4 fv = *(const LAS f32x4*)(wsf + 32 + 8 * gq + 4 * hi);
#pragma unroll
            for (int d0 = 0; d0 < 2; ++d0) { outa[d0][4 * gq] = oc[d0][4 * gq] * fv.x; outa[d0][4 * gq + 1] = oc[d0][4 * gq + 1] * fv.y; outa[d0][4 * gq + 2] = oc[d0][4 * gq + 2] * fv.z; outa[d0][4 * gq + 3] = oc[d0][4 * gq + 3] * fv.w; } }
    }
    FA_SYNC();
    {
        const LAS float* impb = (const LAS float*)(lds + NS_IMP);
        unsigned long long uni = 0ull;
#pragma unroll 1
        for (int pp = 0; pp < 8; ++pp) {
            const int pos = wid * 8 + pp;
            const bool avail = lane <= cur, forced = (lane == 0) || (lane == cur) || (lane == cur - 1);
            float iv = 0.f;
            if (avail && lane < 16 * ntc) iv = ((impb[(0 * 64 + pos) * 64 + lane] + impb[(1 * 64 + pos) * 64 + lane]) + impb[(2 * 64 + pos) * 64 + lane]) + impb[(3 * 64 + pos) * 64 + lane];
            const float score = avail ? iv + (forced ? 1e4f : 0.f) : NEGBIG;
            int rank = 0;
            for (int j = 0; j <= cur; ++j) { const float sj = __uint_as_float(__builtin_amdgcn_readlane(__float_as_uint(score), j)); rank += (sj > score || (sj == score && j < lane)) ? 1 : 0; }
            const unsigned long long sel = __ballot(avail && rank < 16);
            if (lane == 0) ((LAS unsigned long long*)(lds + NS_SEL))[pos] = sel;
            uni |= sel;
        }
        if (lane == 0) ((LAS unsigned long long*)(lds + NS_UNI))[wid] = uni;
    }
    FA_SYNC();
    const unsigned long long mysel = ((const LAS unsigned long long*)(lds + NS_SEL))[psub * 32 + r32];
    unsigned long long uni = 0ull;
#pragma unroll
    for (int w = 0; w < 8; ++w) uni |= ((const LAS unsigned long long*)(lds + NS_UNI))[w];
    uni = __builtin_amdgcn_readfirstlane((unsigned)uni) | ((unsigned long long)__builtin_amdgcn_readfirstlane((unsigned)(uni >> 32)) << 32);
    const bf16* base = QKV + (size_t)(b * S) * QP + g * 64;
#pragma unroll 1
    for (int br = 0; br < 2; ++br) {
        const bool slc = (br == 0);
        float mhat = NEGBIG, lsum = 0.f; f32x16 o[2];
#pragma unroll
        for (int i = 0; i < 16; ++i) { o[0][i] = 0.f; o[1][i] = 0.f; }
        const int lo = cur > 8 ? cur - 8 : 0;
        const unsigned long long wt = ((cur == 63) ? ~0ull : ((1ull << (cur + 1)) - 1ull)) & ~((1ull << lo) - 1ull);
#if ATTN_V2
        nsa_branch2(lds, tid, slc, slc ? uni : wt, base + (slc ? C_KS : C_KW), base + (slc ? C_VS : C_VW), cur, qw0, slope2, mysel, qr, lsum, o, wsf);
#else
        nsa_branch(lds, tid, slc, slc ? uni : wt, base + (slc ? C_KS : C_KW), base + (slc ? C_VS : C_VW), cur, qw0, slope2, mysel, qr, mhat, lsum, o, wsf, Cv);
#endif
        finish_rows<2>(lsum, o, wsf, lane, slc ? g_slc : g_win);
#pragma unroll
        for (int i = 0; i < 16; ++i) { outa[0][i] += o[0][i]; outa[1][i] += o[1][i]; }
    }
    store_rows64(outa, (LAS bf16*)(lds + NS_IMP) + wid * 2048, AO + (size_t)(b * S + qw0) * D + 512 + head * 64, D, lane);
    FA_SYNC();
}

constexpr int F2_K = 0, F2_V = 3 * KT, F2_C = F2_V + 2 * 2 * VDB, F2_WSF = F2_C + 768, F2_OST = F2_WSF + 8 * 256, F2_PRE = F2_OST + 8 * 4096, F2_END = F2_PRE + 256;
__device__ __forceinline__ void fox_unit2(LAS unsigned char* lds, int tid_in, int b, int h, int qt, const bf16* QKV, const float* CUM, const float* CHTOT, bf16* AO) {
    int tid = tid_in; asm volatile("" : "+v"(tid));
    const int lane = tid & 63, wid = __builtin_amdgcn_readfirstlane(tid >> 6), r32 = lane & 31, hi = lane >> 5;
    const int q0 = qt * 256, qw0 = q0 + wid * 32, NT = 4 * (qt + 1);
    LAS float* wsf = (LAS float*)(lds + F2_WSF) + wid * 64;
    LAS float* pre = (LAS float*)(lds + F2_PRE);
    if (wid == 0) {
        const float val = (lane < NT) ? CHTOT[(size_t)(b * 64 + lane) * 16 + h] : 0.f; float inc = val;
#pragma unroll
        for (int o = 1; o < 64; o <<= 1) { const float u = shl_(inc, lane - o); if (lane >= o) inc += u; }
        pre[lane] = inc - val;
    }
    bf16x8 qr[4]; load_q(qr, QKV + (size_t)(b * S + qw0 + r32) * QP + h * 64, hi);
    float mhat = 0.f, st = 0.f, lsum = 0.f; f32x16 o[2];
#pragma unroll
    for (int i = 0; i < 16; ++i) { o[0][i] = 0.f; o[1][i] = 0.f; }
    FA_SYNC();
    RunCfg<2, 1, true> R;
    R.lds = lds; R.KOFF = F2_K; R.VOFF = F2_V; R.COFF = F2_C;
    R.Kg0 = QKV + (size_t)(b * S) * QP + 1024 + h * 64; R.Kg1 = R.Kg0; R.Vg = QKV + (size_t)(b * S) * QP + 2048 + h * 64; R.pitch = QP;
    R.cg = CUM + (size_t)(b * S) * 16 + h; R.pre = pre; R.ksel = 0; R.slope2 = 0.f; R.qw0 = qw0; R.low = -1; R.slc = false; R.mysel = 0ull;
    run_tiles<2, 1, true>(R, tid, (NT == 64) ? ~0ull : ((1ull << NT) - 1ull), qr, mhat, st, lsum, o, wsf);
    finish_rows<2>(lsum, o, wsf, lane, 1.f);
    store_rows64(o, (LAS bf16*)(lds + F2_OST) + wid * 2048, AO + (size_t)(b * S + qw0) * D + h * 64, D, lane);
}

constexpr int D2_K = 0, D2_V = 3 * 2 * KT, D2_WSF = D2_V + 2 * 4 * VDB, D2_END = D2_WSF + 8 * 256, D2_X = 0;
__device__ __forceinline__ void diff_unit2(LAS unsigned char* lds, int tid_in, int b, int h, int qt, const bf16* QKV, bf16* AO, float lam, float post, const float* subg) {
    int tid = tid_in; asm volatile("" : "+v"(tid));
    const int lane = tid & 63, wid = __builtin_amdgcn_readfirstlane(tid >> 6), r32 = lane & 31, hi = lane >> 5;
    const int cs = wid >> 2, q0 = qt * 128, qw0 = q0 + (wid & 3) * 32, NT = 2 * (qt + 1);
    LAS float* wsf = (LAS float*)(lds + D2_WSF) + wid * 64;
    bf16x8 qr[4]; load_q(qr, QKV + (size_t)(b * S + qw0 + r32) * QP + C_AQ + h * 128 + cs * 64, hi);
    float mhat = 0.f, st = 0.f, lsum = 0.f; f32x16 o[4];
#pragma unroll
    for (int i = 0; i < 16; ++i) { o[0][i] = 0.f; o[1][i] = 0.f; o[2][i] = 0.f; o[3][i] = 0.f; }
    RunCfg<4, 2, false> R;
    R.lds = lds; R.KOFF = D2_K; R.VOFF = D2_V; R.COFF = 0;
    R.Kg0 = QKV + (size_t)(b * S) * QP + C_AK + h * 128; R.Kg1 = R.Kg0 + 64; R.Vg = QKV + (size_t)(b * S) * QP + C_AV + h * 128; R.pitch = QP;
    R.cg = nullptr; R.pre = nullptr; R.ksel = cs; R.slope2 = exp2f(-2.f * (float)(h + 1)) * LOG2E; R.qw0 = qw0; R.low = -1; R.slc = false; R.mysel = 0ull;
    run_tiles<4, 2, false>(R, tid, (NT == 64) ? ~0ull : ((1ull << NT) - 1ull), qr, mhat, st, lsum, o, wsf);
    finish_rows<4>(lsum, o, wsf, lane, 1.f);
    LAS float* X = (LAS float*)(lds + D2_X + (wid & 3) * DF_XW);
    if (cs == 1) {
#pragma unroll
        for (int r = 0; r < 16; ++r)
#pragma unroll
            for (int d0 = 0; d0 < 4; ++d0) X[crow(r, hi) * 132 + d0 * 32 + r32] = o[d0][r];
    }
    FA_SYNC();
    if (cs == 0) {
#pragma unroll
        for (int r = 0; r < 16; ++r)
#pragma unroll
            for (int d0 = 0; d0 < 4; ++d0) { LAS float* xp = X + crow(r, hi) * 132 + d0 * 32 + r32; *xp = o[d0][r] - lam * *xp; }
        asm volatile("s_waitcnt lgkmcnt(0)" ::: "memory");
        const int row = lane >> 1, half = lane & 1;
        f32x4 v[16]; float ss = 0.f;
#pragma unroll
        for (int i = 0; i < 16; ++i) { v[i] = *(const LAS f32x4*)(X + row * 132 + half * 64 + 4 * i); ss += (v[i].x * v[i].x + v[i].y * v[i].y) + (v[i].z * v[i].z + v[i].w * v[i].w); }
        ss += shx<1>(ss);
        const float rs = rsqrtf(ss * (1.f / 128.f) + EPS) * post;
        bf16* dst = AO + (size_t)(b * S + qw0 + row) * D + h * 128 + half * 64;
#pragma unroll
        for (int i = 0; i < 8; ++i) { const f32x4 g0 = *(const f32x4*)(subg + half * 64 + 8 * i), g1 = *(const f32x4*)(subg + half * 64 + 8 * i + 4);
            v4u w; w.x = cvtpk(v[2 * i].x * rs * g0.x, v[2 * i].y * rs * g0.y); w.y = cvtpk(v[2 * i].z * rs * g0.z, v[2 * i].w * rs * g0.w);
            w.z = cvtpk(v[2 * i + 1].x * rs * g1.x, v[2 * i + 1].y * rs * g1.y); w.w = cvtpk(v[2 * i + 1].z * rs * g1.z, v[2 * i + 1].w * rs * g1.w);
            *(v4u*)(dst + 8 * i) = w; }
    }
    FA_SYNC();
}
__device__ __forceinline__ void nsa_branch2(LAS unsigned char* lds, int tid, const bool SLC, unsigned long long tiles, const bf16* Kg, const bf16* Vg, int cur, int qw0, float slope2,
                                            unsigned long long mysel, const bf16x8 (&qr)[4], float& lsum, f32x16 (&o)[2], LAS float* wsf) {
    RunCfg<2, 1, false> R;
    R.lds = lds; R.KOFF = NS_KB; R.VOFF = NS_VB; R.COFF = 0;
    R.Kg0 = Kg; R.Kg1 = Kg; R.Vg = Vg; R.pitch = QP; R.cg = nullptr; R.pre = nullptr; R.ksel = 0; R.slope2 = slope2; R.qw0 = qw0;
    R.low = (!SLC && cur >= 8) ? cur - 8 : -1; R.slc = SLC; R.mysel = mysel;
    float mhat = 0.f, st = 0.f;
    run_tiles<2, 1, false>(R, tid, tiles, qr, mhat, st, lsum, o, wsf);
}

__device__ __forceinline__ void even_attn_phase(const Ctx& C0, int l) {
    PHASE_PROLOG(C0);
    const bf16* QKV = WSP(bf16, WS_QKV); bf16* AO = WSP(bf16, WS_AO);
    const int e = l >> 1;
    const float lam_init = 0.8f - 0.6f * __expf(-0.3f * (float)l);
    float lam;
    { const float* lp = INP(I_DLAM) + e * 256; int tl0 = C.tid; asm volatile("" : "+v"(tl0)); const int ln0 = tl0 & 63; const float a1 = wave_sum(lp[ln0] * lp[64 + ln0]), a2 = wave_sum(lp[128 + ln0] * lp[192 + ln0]);
      lam = __uint_as_float(__builtin_amdgcn_readfirstlane(__float_as_uint(__expf(a1) - __expf(a2) + lam_init))); }
    CvtRide Cv; Cv.wg = INP(I_WG); Cv.wu = INP(I_WU); Cv.wd = INP(I_WD); Cv.ws = ws; Cv.scr = (LAS float*)(C.lds + NS_IMP) + C.wave * 2048; Cv.full = false; Cv.step = C.NGW;
    Cv.it = l * CVT_MOE_L + C.gw; Cv.hi = (l + 1) * CVT_MOE_L;
    const unsigned* KN2 = WSP(unsigned, WS_CTL) + CW_KNP + l * 384;
    for (int vc = blockIdx.x; vc < 256; vc += gridDim.x) {
        { const int bh = vc >> 4, s = vc & 15, b = bh >> 2, h = bh & 3;
#pragma unroll 1
          for (int i = 0; i < 2; ++i) diff_unit(C.lds, C.tid, b, i ? 3 - h : h, i ? 31 - s : s, QKV, AO, lam, l, INP(I_DSUB) + e * 128, KN2); }
        { const int bg = vc >> 5, s = vc & 31;
#pragma unroll 1
          for (int i = 0; i < 2; ++i) nsa_unit(C.lds, C.tid, bg >> 1, bg & 1, i == 0 ? s : 63 - s, QKV, WSP(bf16, WS_KCMP), WSP(bf16, WS_VCMP), WSP(float, WS_GL), AO, Cv); }
    }
    { int tl = C.tid; asm volatile("" : "+v"(tl)); const int ln2 = tl & 63;
      while (Cv.full || Cv.it < Cv.hi) { ride_finish(Cv, ln2); ride_start(Cv, ln2); } }
}
__device__ __forceinline__ void fox_phase(const Ctx& C0, int l) {
    PHASE_PROLOG(C0);
    const bf16* QKV = WSP(bf16, WS_QKV); const float* CUM = WSP(float, WS_CUMF); const float* CHTOT = WSP(float, WS_CHTOT); bf16* AO = WSP(bf16, WS_AO);
    CvtRide Cv; Cv.wg = INP(I_WG); Cv.wu = INP(I_WU); Cv.wd = INP(I_WD); Cv.ws = ws; Cv.scr = (LAS float*)(C.lds + FX_END) + C.wave * 2048; Cv.full = false; Cv.step = C.NGW;
    Cv.it = l * CVT_MOE_L + C.gw; Cv.hi = (l + 1) * CVT_MOE_L;
    unsigned* qword = WSP(unsigned, WS_CTL) + CW_FQ + (l >> 1) * 64; const unsigned* KN = WSP(unsigned, WS_CTL) + CW_KNP + l * 384;
    LAS int* qslot = (LAS int*)(C.lds + LDS_BYTES - 64);
    if (C.tid == 0) qslot[0] = (int)__hip_atomic_fetch_add(qword, 1u, __ATOMIC_RELAXED, __HIP_MEMORY_SCOPE_AGENT);
    FA_SYNC();
    int idx = __builtin_amdgcn_readfirstlane(qslot[0]), par = 0;
    while (idx < 1024) {
        par ^= 1;
        if (C.tid == 0) qslot[par] = (int)__hip_atomic_fetch_add(qword, 1u, __ATOMIC_RELAXED, __HIP_MEMORY_SCOPE_AGENT);
        const int bh = idx & 63, qt = 15 - (idx >> 6);
        const unsigned* kg = KN + (bh >> 4) * 96 + 32 + 2 * (bh & 15);
        const float knmax = sqrtf(__uint_as_float(kg[0]) + __uint_as_float(kg[1]));
        fox_unit(C.lds, C.tid, bh >> 4, bh & 15, qt, QKV, CUM, CHTOT, AO, knmax, Cv);
        FA_SYNC();
        idx = __builtin_amdgcn_readfirstlane(qslot[par]);
    }
    while (Cv.full || Cv.it < Cv.hi) { ride_finish(Cv, C.lane); ride_start(Cv, C.lane); }
}
}

#ifndef USE_MFMA_FOX
#define USE_MFMA_FOX 1
#endif
#ifndef ATTN_V2
#define ATTN_V2 1
#endif
#ifndef USE_MFMA_EVEN
#define USE_MFMA_EVEN 1
#endif
__device__ __forceinline__ void p_attn(const Ctx& C, int l) {
    if ((l & 1) == 0) {
#if USE_MFMA_EVEN
        fa::even_attn_phase(C, l);
        return;
#endif
        const int nd = NB * 4 * S, nn = NB * 2 * S;
        for (int item = C.gw; item < nd + nn; item += C.NGW) {
            if (item < nd) attn_diff_row(C, l, item); else attn_nsa_row(C, l, item - nd);
        }
    } else {
#if USE_MFMA_FOX
        fa::fox_phase(C, l);
#else
        for (int item = C.gw; item < NB * 16 * S; item += C.NGW) attn_fox_row(C, item);
#endif
    }
}


__device__ __forceinline__ void p_knorm_diff(const Ctx& C0, int l) {
    PHASE_PROLOG(C0);
    const bf16* QKV = WSP(bf16, WS_QKV); unsigned* KN = WSP(unsigned, WS_CTL) + CW_KN2 + (l >> 1) * 64;
    LAS float* red = (LAS float*)(C.lds + 81920);
    for (int item = blockIdx.x; item < 256; item += gridDim.x) {
        const int bhc = item >> 3, q = item & 7, b = bhc >> 3, hc = bhc & 7;
        const bf16* Kb = QKV + (size_t)(b * S + q * 512 + C.tid) * QP + C_AK + hc * 64; float s2 = 0.f;
#pragma unroll
        for (int c = 0; c < 8; ++c) { const v4u u = *(const v4u*)(Kb + c * 8);
            const float a0 = bf2f(u.x & 0xffffu), a1 = bf2f(u.x >> 16), a2 = bf2f(u.y & 0xffffu), a3 = bf2f(u.y >> 16), a4 = bf2f(u.z & 0xffffu), a5 = bf2f(u.z >> 16), a6 = bf2f(u.w & 0xffffu), a7 = bf2f(u.w >> 16);
            s2 += (a0 * a0 + a1 * a1) + (a2 * a2 + a3 * a3) + (a4 * a4 + a5 * a5) + (a6 * a6 + a7 * a7); }
        const float m2 = wave_max(s2);
        __syncthreads();
        if (C.lane == 0) red[C.wave] = m2;
        __syncthreads();
        if (C.tid == 0) { const float m = fmaxf(fmaxf(fmaxf(red[0], red[1]), fmaxf(red[2], red[3])), fmaxf(fmaxf(red[4], red[5]), fmaxf(red[6], red[7])));
            __hip_atomic_fetch_max(KN + bhc, __float_as_uint(m), __ATOMIC_RELAXED, __HIP_MEMORY_SCOPE_AGENT); }
    }
}

__device__ __forceinline__ void p_knorm(const Ctx& C0, int l) {
    PHASE_PROLOG(C0);
    const bf16* QKV = WSP(bf16, WS_QKV); unsigned* KN = WSP(unsigned, WS_CTL) + CW_KN + (l >> 1) * 64;
    LAS float* red = (LAS float*)C.lds;
    for (int item = blockIdx.x; item < 256; item += gridDim.x) {
        const int bh = item >> 2, q = item & 3;
        const bf16* Kb = QKV + (size_t)((bh >> 4) * S + q * 1024) * QP + 1024 + (bh & 15) * 64; float m2 = 0.f;
#pragma unroll
        for (int kk = 0; kk < 2; ++kk) { const int k = C.tid + kk * NTHR; float s2 = 0.f;
#pragma unroll
            for (int c = 0; c < 8; ++c) { const v4u u = *(const v4u*)(Kb + (size_t)k * QP + c * 8);
                const float a0 = bf2f(u.x & 0xffffu), a1 = bf2f(u.x >> 16), a2 = bf2f(u.y & 0xffffu), a3 = bf2f(u.y >> 16), a4 = bf2f(u.z & 0xffffu), a5 = bf2f(u.z >> 16), a6 = bf2f(u.w & 0xffffu), a7 = bf2f(u.w >> 16);
                s2 += (a0 * a0 + a1 * a1) + (a2 * a2 + a3 * a3) + (a4 * a4 + a5 * a5) + (a6 * a6 + a7 * a7); }
            m2 = fmaxf(m2, s2); }
        m2 = wave_max(m2);
        __syncthreads();
        if (C.lane == 0) red[C.wave] = m2;
        __syncthreads();
        if (C.tid == 0) { const float m = fmaxf(fmaxf(fmaxf(red[0], red[1]), fmaxf(red[2], red[3])), fmaxf(fmaxf(red[4], red[5]), fmaxf(red[6], red[7])));
            __hip_atomic_fetch_max(KN + bh, __float_as_uint(m), __ATOMIC_RELAXED, __HIP_MEMORY_SCOPE_AGENT); }
    }
}
__device__ __forceinline__ void p_norm2(const Ctx& C0, int l, int dup = 0) {
    PHASE_PROLOG(C0);
    unsigned char* wsw = ws + (dup ? DUMMY_OFF : (size_t)0);
    const bf16* xcur = WSP(bf16, WS_XCUR); const float* mod = WSP(float, WS_MOD);
    bf16* H = (bf16*)(wsw + WS_H);
    const float* rwt = WSP(float, WS_RWT) + (size_t)l * 32 * 1024;
    int* tope = (int*)(wsw + WS_TOPE); float* topg = (float*)(wsw + WS_TOPG); int* slot = (int*)(wsw + WS_SLOT);
    unsigned* cnt = (unsigned*)(wsw + WS_CTL) + CW_CNT + l * 32;
    LAS float* wl = (LAS float*)C.lds;
    for (int i = C.tid; i < 32 * 256; i += NTHR) *(LAS f32x4*)(wl + 4 * i) = *(const f32x4*)(rwt + 4 * i);
    LAS unsigned* lcnt = (LAS unsigned*)(C.lds + 131072);
    LAS unsigned* lbase = lcnt + 32;
    LAS int* le = (LAS int*)(lbase + 32);
    LAS int* ls = le + 256;
    LAS float* lg = (LAS float*)(ls + 256);
    int* etok = WSP(int, WS_ETOK); float* egate = WSP(float, WS_EGATE);
    const float* p_nfg = INP(I_NFG); const float* p_rb = INP(I_RB);
    for (int chunk = blockIdx.x; chunk < T / 64; chunk += gridDim.x) {
        if (C.tid < 32) lcnt[C.tid] = 0u;
        __syncthreads();
        const int b = (chunk * 64) / S;
        const float* mrow = mod + ((size_t)l * 4 + b) * 6144;
#pragma unroll 1
        for (int pr = 0; pr < 2; ++pr) {
            const int ri0 = C.wave * 8 + pr * 4, t0 = chunk * 64 + ri0;
            int ln = C.lane; asm volatile("" : "+v"(ln));
            f32x4 v[4][4]; float ss[4];
#pragma unroll
            for (int rr = 0; rr < 4; ++rr) { float a = 0.f;
#pragma unroll
                for (int j = 0; j < 4; ++j) { const v2u u = *(const v2u*)(xcur + (size_t)(t0 + rr) * D + 4 * (ln + 64 * j));
                    v[rr][j] = (f32x4){bf2f(u.x & 0xffffu), bf2f(u.x >> 16), bf2f(u.y & 0xffffu), bf2f(u.y >> 16)}; a += (v[rr][j].x * v[rr][j].x + v[rr][j].y * v[rr][j].y) + (v[rr][j].z * v[rr][j].z + v[rr][j].w * v[rr][j].w); }
                ss[rr] = a; }
            float rinv[4];
#pragma unroll
            for (int rr = 0; rr < 4; ++rr) rinv[rr] = rsqrtf(wave_sum(ss[rr]) * (1.f / D) + EPS);
            f32x4 h[4][4];
#pragma unroll
            for (int j = 0; j < 4; ++j) { const int i0 = 4 * (ln + 64 * j);
                const f32x4 g = *(const f32x4*)(p_nfg + l * D + i0), sh = *(const f32x4*)(mrow + 3 * 1024 + i0), scl = *(const f32x4*)(mrow + 4 * 1024 + i0);
                const f32x4 gs = g * (scl + 1.f);
#pragma unroll
                for (int rr = 0; rr < 4; ++rr) { h[rr][j] = v[rr][j] * rinv[rr] * gs + sh;
                    v2u o; o.x = pk2(h[rr][j].x, h[rr][j].y); o.y = pk2(h[rr][j].z, h[rr][j].w);
                    *(v2u*)(H + (size_t)(t0 + rr) * D + i0) = o; } }
            float res[4];
            router_dots4(h, wl, C.lane, res);
            const float rb = p_rb[l * NE + (C.lane >> 1)];
#pragma unroll
            for (int rr = 0; rr < 4; ++rr) {
                float mine = res[rr] + rb;
                float tv[4]; int te[4];
#pragma unroll
                for (int k = 0; k < 4; ++k) {
                    const float mx = wave_max(mine);
                    const unsigned long long bm = __ballot(mine == mx);
                    const int idx = __builtin_ctzll(bm) >> 1;
                    tv[k] = mx; te[k] = idx;
                    if ((C.lane >> 1) == idx) mine = NEGBIG * 2.f;
                }
                const float e1 = __expf(tv[1] - tv[0]), e2 = __expf(tv[2] - tv[0]), e3 = __expf(tv[3] - tv[0]);
                const float inv = 1.f / (1.f + e1 + e2 + e3);
                if (C.lane < 4) {
                    const int k = C.lane, ri = ri0 + rr, t = t0 + rr;
                    const int ek = (k == 0) ? te[0] : (k == 1) ? te[1] : (k == 2) ? te[2] : te[3];
                    const float gk = ((k == 0) ? 1.f : (k == 1) ? e1 : (k == 2) ? e2 : e3) * inv;
                    tope[t * 4 + k] = ek; topg[t * 4 + k] = gk;
                    le[ri * 4 + k] = ek; ls[ri * 4 + k] = (int)atomicAdd((unsigned*)(lcnt + ek), 1u); lg[ri * 4 + k] = gk;
                }
            }
        }
        __syncthreads();
        int tt = C.tid; asm volatile("" : "+v"(tt));
        if (tt < 32) lbase[tt] = atomicAdd(cnt + tt, lcnt[tt]);
        __syncthreads();
        if (tt < 256) { const int e = le[tt], s = (int)lbase[e] + ls[tt]; slot[(size_t)chunk * 256 + tt] = s;
            if (!dup) { etok[e * 16384 + s] = chunk * 64 + (tt >> 2); egate[e * 16384 + s] = lg[tt]; } }
        __syncthreads();
    }
}

__device__ __forceinline__ void p_gather(const Ctx& C0, int l) {
    PHASE_PROLOG(C0);
    const bf16* H = WSP(bf16, WS_H); bf16* XG = WSP(bf16, WS_XG);
    const int* tope = WSP(int, WS_TOPE); const float* topg = WSP(float, WS_TOPG); const int* slot = WSP(int, WS_SLOT);
    int* rpos = WSP(int, WS_RPOS); float* rgate = WSP(float, WS_RGATE);
    const unsigned* cnt = WSP(unsigned, WS_CTL) + CW_CNT + l * 32;
    int pad = 0; if (C.lane < 32) pad = ((int)cnt[C.lane] + 255) & ~255;
    int inc = pad;
#pragma unroll
    for (int o = 1; o < 32; o <<= 1) { const int u = shl_(inc, C.lane - o); if (C.lane >= o) inc += u; }
    const int pstart = inc - pad;
    for (int t = C.gw; t < T; t += C.NGW) {
        const v4u h0 = *(const v4u*)(H + (size_t)t * D + 8 * C.lane), h1 = *(const v4u*)(H + (size_t)t * D + 512 + 8 * C.lane);
#pragma unroll
        for (int k = 0; k < 4; ++k) {
            const int e = tope[t * 4 + k]; const int row = shl_(pstart, e) + slot[t * 4 + k];
            *(v4u*)(XG + (size_t)row * D + 8 * C.lane) = h0; *(v4u*)(XG + (size_t)row * D + 512 + 8 * C.lane) = h1;
            if (C.lane == 0) { rpos[t * 4 + k] = row; rgate[row] = topg[t * 4 + k]; }
        }
    }
}


#ifndef USE_MFMA_GEMM
#define USE_MFMA_GEMM 1
#endif
#ifndef DUP_MASK
#define DUP_MASK 0
#endif
#define REP(k) _Pragma("unroll 1") for (int rep_ = 0; rep_ < 1 + ((DUP_MASK >> (k)) & 1); ++rep_)
__device__ __forceinline__ bool ph_in(int lo, int hi, int k) { asm volatile("" : "+s"(lo), "+s"(hi)); return lo <= k && k < hi; }
__global__ void __launch_bounds__(NTHR, 2) mega(Args args) {
    extern __shared__ __attribute__((aligned(16))) unsigned char lds_raw[];
    Ctx C0;
    C0.in = args.in; C0.out = args.out; C0.ws = args.ws; C0.lds = (LAS unsigned char*)lds_raw;
    C0.tid = threadIdx.x; C0.lane = C0.tid & 63; C0.wave = __builtin_amdgcn_readfirstlane(C0.tid >> 6);
    C0.gw = blockIdx.x * NWAVES + C0.wave; C0.NGW = gridDim.x * NWAVES;
    const int lo = args.ph_lo, hi = args.ph_hi;
    volatile LAS unsigned* barst = (volatile LAS unsigned*)(C0.lds + LDS_BYTES - 16);
    if (C0.tid < 4) barst[C0.tid] = 0u;
    if (C0.tid < 26) ((LAS unsigned long long*)(C0.lds + LDS_BYTES - 256))[C0.tid] = (unsigned long long)args.in[C0.tid];
    __syncthreads();
    XcdBarrier bar; bar.bar = (unsigned*)(args.ws + WS_CTL) + CW_BAR; bar.x = 0; bar.st = barst;
    const bool multi = (hi - lo) > 1;
    if (multi) bar = xcd_barrier_post((unsigned*)(args.ws + WS_CTL) + CW_BAR, barst);
#define IN(k) (ph_in(lo, hi, (k)))
#define SEAM(k) do { if (IN(k) && IN((k) + 1)) xcd_barrier(bar); } while (0)

    if (IN(0)) { REP(11) p_prologue(C0);
#if USE_MFMA_GEMM
        REP(0) p_convert(C0);
#endif
    }
    SEAM(0);
    for (int l = 0; l < DEPTH; ++l) {
        const int pb = 1 + l * 9;
        const bool even = (l & 1) == 0; const int e = l >> 1;
        if (IN(pb + 0)) { REP(8) p_norm1(C0, l, rep_); }
        SEAM(pb + 0);
        if (IN(pb + 1)) REP(1) {
            PHASE_PROLOG(C0);
#if USE_MFMA_GEMM
            pg8::Gemm g{WSP(bf16, WS_H), WSP(bf16, WS_WINT) + (size_t)l * 3072 * 1024, D};
            pg8::StaticOrder So; So.init(T, even ? 2816 : 3072, (int)gridDim.x, (int)blockIdx.x);
            pg8::EpiQKV E{WSP(bf16, WS_QKV), QP, WSP(unsigned, WS_CTL) + CW_KNP + l * 384, even ? 2 : 4, even ? 4 : 8};
            pg8::gemm_phase<pg8::EpiQKV, pg8::StaticOrder, true, true>(C.lds, C.tid, g, So, E);
#else
            const float* W = even ? INP(I_EWIN) + (size_t)e * D * EVEN_IN : INP(I_OWIN) + (size_t)e * D * ODD_IN;
            const int ldw = even ? EVEN_IN : ODD_IN, NT = even ? 22 : 24;
            bf16* QKV = WSP(bf16, WS_QKV);
            auto tf = [&](int, int, const float*& W0, const float*& W1) { W0 = W; W1 = W; return true; };
            auto epi = [&](int row, int col, const float* a0, const float*) {
                v2u o; o.x = pk2(a0[0], a0[1]); o.y = pk2(a0[2], a0[3]); *(v2u*)(QKV + (size_t)row * QP + col) = o; };
            simple_gemm<1>(C, WSP(bf16, WS_H), D, T / 64, NT, D, ldw, tf, epi);
#endif
        }
        SEAM(pb + 1);
        if (even) {
            if (IN(pb + 2)) REP(2) { p_cmp_mfma(C0, l); }
            SEAM(pb + 2);
        }
        if (IN(pb + 3)) { const int nrep_ = 1 + ((DUP_MASK >> (even ? 3 : 4)) & 1);
            _Pragma("unroll 1") for (int rep_ = 0; rep_ < nrep_; ++rep_) p_attn(C0, l); }
        SEAM(pb + 3);
        if (IN(pb + 4)) REP(10) {
            PHASE_PROLOG(C0);
#if USE_MFMA_GEMM
            pg8::Gemm g{WSP(bf16, WS_AO), WSP(bf16, WS_WOUTT) + (size_t)l * 1024 * 1024, D};
            pg8::StaticOrder So; So.init(T, D, (int)gridDim.x, (int)blockIdx.x);
            pg8::EpiOut E{(l == 0) ? INP(I_X) : (const float*)nullptr, WSP(bf16, WS_XCUR), (bf16*)(ws + (rep_ ? DUMMY_OFF : (size_t)0) + WS_XCUR), WSP(float, WS_MOD) + (size_t)l * 4 * 6144 + 2 * 1024};
            pg8::gemm_phase<pg8::EpiOut, pg8::StaticOrder, true, true>(C.lds, C.tid, g, So, E);
#else
            const float* W = even ? INP(I_EWOUT) + (size_t)e * D * D : INP(I_OWOUT) + (size_t)e * D * D;
            const float* xprev = (l == 0) ? INP(I_X) : WSP(float, WS_XCUR);
            float* xcur = WSP(float, WS_XCUR); const float* mod = WSP(float, WS_MOD);
            auto tf = [&](int, int, const float*& W0, const float*& W1) { W0 = W; W1 = W; return true; };
            auto epi = [&](int row, int col, const float* a0, const float*) {
                const int b = row / S; const f32x4 g1 = *(const f32x4*)(mod + ((size_t)l * 4 + b) * 6144 + 2 * 1024 + col);
                const f32x4 xp = *(const f32x4*)(xprev + (size_t)row * D + col);
                f32x4 o; o.x = xp.x + g1.x * a0[0]; o.y = xp.y + g1.y * a0[1]; o.z = xp.z + g1.z * a0[2]; o.w = xp.w + g1.w * a0[3];
                *(f32x4*)(xcur + (size_t)row * D + col) = o; };
            simple_gemm<1>(C, WSP(bf16, WS_AO), D, T / 64, 8, D, D, tf, epi);
#endif
        }
        SEAM(pb + 4);
        if (IN(pb + 5)) { REP(9) p_norm2(C0, l, rep_); }
        SEAM(pb + 5);
        if (IN(pb + 7)) REP(6) {
            PHASE_PROLOG(C0);
#if USE_MFMA_GEMM
            LAS int* tp = (LAS int*)(C.lds + 131072);
            moe_tile_prefix(WSP(unsigned, WS_CTL) + CW_CNT + l * 32, tp, C.tid);
            pg8::Gemm g{WSP(bf16, WS_H), WSP(bf16, WS_WGUT) + (size_t)l * 32 * 2048 * 1024, D};
            pg8::MoeOrder So{tp, 8, (int)gridDim.x, (int)blockIdx.x, WSP(int, WS_ETOK)};
            pg8::EpiMoe1 E{WSP(bf16, WS_ACT), INP(I_BG) + (size_t)l * NE * FF, INP(I_BU) + (size_t)l * NE * FF, nullptr};
            pg8::gemm_phase<pg8::EpiMoe1, pg8::MoeOrder, true, true, true>(C.lds, C.tid, g, So, E);
#else
            const unsigned* cnt = WSP(unsigned, WS_CTL) + CW_CNT + l * 32;
            bf16* ACT = WSP(bf16, WS_ACT);
            const float* WG = INP(I_WG) + (size_t)l * NE * D * FF; const float* WU = INP(I_WU) + (size_t)l * NE * D * FF;
            const float* BG = INP(I_BG) + (size_t)l * NE * FF;    const float* BU = INP(I_BU) + (size_t)l * NE * FF;
            int ecur = 0;
            auto tf = [&](int mt, int, const float*& W0, const float*& W1) { const int ex = expert_of_row(cnt, mt * 64); if (ex < 0) return false;
                ecur = ex; W0 = WG + (size_t)ex * D * FF; W1 = WU + (size_t)ex * D * FF; return true; };
            auto epi = [&](int row, int col, const float* a0, const float* a1) {
                const f32x4 bg = *(const f32x4*)(BG + ecur * FF + col), bu = *(const f32x4*)(BU + ecur * FF + col);
                float o[4];
#pragma unroll
                for (int j = 0; j < 4; ++j) { const float hg = fminf(a0[j] + bg[j], 7.f), hu = fminf(fmaxf(a1[j] + bu[j], -7.f), 7.f);
                    o[j] = hg * sigmoidf_(1.702f * hg) * (hu + 1.f); }
                v2u w; w.x = pk2(o[0], o[1]); w.y = pk2(o[2], o[3]); *(v2u*)(ACT + (size_t)row * FF + col) = w; };
            simple_gemm<2>(C, WSP(bf16, WS_XG), D, PMAX / 64, 8, D, FF, tf, epi);
#endif
        }
        SEAM(pb + 7);
        if (IN(pb + 8)) REP(7) {
            PHASE_PROLOG(C0);
#if USE_MFMA_GEMM
            LAS int* tp = (LAS int*)(C.lds + 131072);
            moe_tile_prefix(WSP(unsigned, WS_CTL) + CW_CNT + l * 32, tp, C.tid);
            pg8::Gemm g{WSP(bf16, WS_ACT), WSP(bf16, WS_WDT) + (size_t)l * 32 * 1024 * 1024, FF};
            pg8::MoeOrder So{tp, 4, (int)gridDim.x, (int)blockIdx.x, WSP(int, WS_ETOK)};
            pg8::EpiMoe2 E{WSP(bf16, WS_Y), INP(I_BD) + (size_t)l * NE * D, WSP(float, WS_EGATE), tp, nullptr};
            pg8::gemm_phase<pg8::EpiMoe2, pg8::MoeOrder, true, true>(C.lds, C.tid, g, So, E);
#else
            const unsigned* cnt = WSP(unsigned, WS_CTL) + CW_CNT + l * 32;
            bf16* Y = WSP(bf16, WS_Y); const float* rgate = WSP(float, WS_RGATE);
            const float* WD = INP(I_WD) + (size_t)l * NE * FF * D; const float* BD = INP(I_BD) + (size_t)l * NE * D;
            int ecur = 0;
            auto tf = [&](int mt, int, const float*& W0, const float*& W1) { const int ex = expert_of_row(cnt, mt * 64); if (ex < 0) return false;
                ecur = ex; W0 = WD + (size_t)ex * FF * D; W1 = W0; return true; };
            auto epi = [&](int row, int col, const float* a0, const float*) {
                const f32x4 bd = *(const f32x4*)(BD + ecur * D + col); const float gt = rgate[row];
                v2u w; w.x = pk2((a0[0] + bd.x) * gt, (a0[1] + bd.y) * gt); w.y = pk2((a0[2] + bd.z) * gt, (a0[3] + bd.w) * gt);
                *(v2u*)(Y + (size_t)row * D + col) = w; };
            simple_gemm<1>(C, WSP(bf16, WS_ACT), FF, PMAX / 64, 8, FF, D, tf, epi);
#endif
        }
        SEAM(pb + 8);
    }
    if (IN(37)) { p_norm1(C0, 4); }
#undef IN
#undef SEAM
}

constexpr int NPHASE = 38;
#ifndef MK_PER_PHASE
#define MK_PER_PHASE 0
#endif

extern "C" void kernel_launch(void* const* d_in, const int* in_sizes, int n_in, void* d_out, int out_size, void* d_ws, size_t ws_size, hipStream_t stream) {
    static int grid = 0;
    if (grid == 0) {
        if (n_in != 26 || ws_size < WS_END) { fprintf(stderr, "kernel_launch: unexpected n_in %d / ws %zu\n", n_in, ws_size); grid = -1; return; }
        int dev = 0, cus = 0, per_cu = 0;
        hipGetDevice(&dev); hipDeviceGetAttribute(&cus, hipDeviceAttributeMultiprocessorCount, dev);
        hipFuncSetAttribute((const void*)mega, hipFuncAttributeMaxDynamicSharedMemorySize, LDS_BYTES);
        hipOccupancyMaxActiveBlocksPerMultiprocessor(&per_cu, (const void*)mega, NTHR, LDS_BYTES);
        (void)hipGetLastError();
        grid = cus > 0 ? cus : 256;
    }
    if (grid < 0) return;
    hipMemsetAsync((char*)d_ws + WS_CTL, 0, CTL_ZERO_BYTES, stream);
    Args a{};
    for (int i = 0; i < 26; ++i) a.in[i] = (const float*)d_in[i];
    a.out = (float*)d_out; a.ws = (unsigned char*)d_ws;
#if MK_PER_PHASE
    for (int ph = 0; ph < NPHASE; ++ph) {
        a.ph_lo = ph; a.ph_hi = ph + 1;
        hipLaunchKernelGGL(mega, dim3(grid), dim3(NTHR), LDS_BYTES, stream, a);
    }
#else
    a.ph_lo = 0; a.ph_hi = NPHASE;
    hipLaunchKernelGGL(mega, dim3(grid), dim3(NTHR), LDS_BYTES, stream, a);
#endif
}
```

```cpp
#include <hip/hip_runtime.h>
#include <stdint.h>
#include <stdio.h>

#define LAS __attribute__((address_space(3)))
#define CAS_ __attribute__((address_space(4)))
#define GAS_ __attribute__((address_space(1)))
typedef unsigned short bf16;
typedef unsigned v4u __attribute__((ext_vector_type(4)));
typedef unsigned v2u __attribute__((ext_vector_type(2)));
typedef float f32x4 __attribute__((ext_vector_type(4)));

constexpr int NB = 4, S = 4096, D = 1024, T = NB * S, DEPTH = 4;
constexpr int EVEN_IN = 2840, ODD_IN = 3088, QP = 3072;
constexpr int NE = 32, TOPK = 4, FF = 1024;
constexpr int PMAX = T * TOPK + NE * 256;
constexpr float EPS = 1e-6f, NEGBIG = -1e30f;
constexpr int C_AQ = 0, C_AK = 512, C_AV = 1024, C_BQ = 1536, C_KC = 2048, C_VC = 2176, C_KS = 2304, C_VS = 2432, C_KW = 2560, C_VW = 2688, C_BG = 2816;
constexpr int NCMP = 255;

constexpr size_t MiB = 1u << 20;
constexpr size_t WS_CTL = 0, CTL_ZERO_BYTES = 1 * MiB;
constexpr size_t WS_MOD = 1 * MiB;
constexpr size_t WS_KCMP = 2 * MiB;
constexpr size_t WS_VCMP = 2 * MiB + 512 * 1024;
constexpr size_t WS_WXT = 3 * MiB;
constexpr size_t WS_RWT = 3 * MiB + 512 * 1024;
constexpr size_t WS_GL = 4 * MiB;
constexpr size_t WS_TOPE = 6 * MiB;
constexpr size_t WS_TOPG = 6 * MiB + 256 * 1024;
constexpr size_t WS_SLOT = 6 * MiB + 512 * 1024;
constexpr size_t WS_RPOS = 6 * MiB + 768 * 1024;
constexpr size_t WS_RGATE = 7 * MiB;
constexpr size_t WS_CUM = 7 * MiB + 512 * 1024;
constexpr size_t WS_XCUR = 8 * MiB;
constexpr size_t WS_H = 72 * MiB;
constexpr size_t WS_QKV = 104 * MiB;
constexpr size_t WS_AO = 200 * MiB;
constexpr size_t WS_XG = 232 * MiB;
constexpr size_t WS_ACT = 376 * MiB;
constexpr size_t WS_Y = 520 * MiB;
constexpr size_t WS_CUMF = 664 * MiB;
constexpr size_t WS_WINT = 666 * MiB;
constexpr size_t WS_WOUTT = 690 * MiB;
constexpr size_t WS_WGUT = 698 * MiB;
constexpr size_t WS_WDT = 1210 * MiB;
constexpr size_t WS_W1T = 1466 * MiB;
constexpr size_t WS_POSB = 1468 * MiB;
constexpr size_t WS_CHTOT = 1468 * MiB + 65536;
constexpr size_t WS_ETOK = 1470 * MiB;
constexpr size_t WS_EGATE = 1472 * MiB;
constexpr size_t WS_END = 1474 * MiB;
constexpr size_t DUMMY_OFF = 1480 * MiB;
constexpr int CW_BAR = 4096;
constexpr int CW_CNT = 1024;
constexpr int CW_FQ = 2048;
constexpr int CW_EQ = 2560;
constexpr int CW_KN2 = 3584;
constexpr int CW_KNP = 8192;
constexpr int CW_KN = 3072;

constexpr int LDS_BYTES = 147456;
constexpr int NWAVES = 8, NTHR = 512;

__device__ __forceinline__ float bf2f(unsigned v) { return __uint_as_float(v << 16); }
__device__ __forceinline__ unsigned f2bf(float f) { unsigned u = __float_as_uint(f); return (u + 0x7fffu + ((u >> 16) & 1u)) >> 16; }
__device__ __forceinline__ unsigned pk2(float lo, float hi) { return f2bf(lo) | (f2bf(hi) << 16); }
template <int M> __device__ __forceinline__ float shx(float v) {
    if constexpr (M == 32) { const unsigned u = __float_as_uint(v); auto rr = __builtin_amdgcn_permlane32_swap(u, u, false, false); return __uint_as_float(rr[0] ^ rr[1] ^ u); }
    else return __int_as_float(__builtin_amdgcn_ds_swizzle(__float_as_int(v), 0x1F | (M << 10)));
}
__device__ __forceinline__ float shl_(float v, int src_lane) { return __int_as_float(__builtin_amdgcn_ds_bpermute(src_lane << 2, __float_as_int(v))); }
__device__ __forceinline__ int shl_(int v, int src_lane) { return __builtin_amdgcn_ds_bpermute(src_lane << 2, v); }
__device__ __forceinline__ float wave_sum(float v) { v += shx<1>(v); v += shx<2>(v); v += shx<4>(v); v += shx<8>(v); v += shx<16>(v); v += shx<32>(v); return v; }
__device__ __forceinline__ float wave_max(float v) { v = fmaxf(v, shx<1>(v)); v = fmaxf(v, shx<2>(v)); v = fmaxf(v, shx<4>(v)); v = fmaxf(v, shx<8>(v)); v = fmaxf(v, shx<16>(v)); v = fmaxf(v, shx<32>(v)); return v; }
__device__ __forceinline__ float sigmoidf_(float x) { return 1.f / (1.f + __expf(-x)); }
__device__ __forceinline__ float alibi8(int h) { return exp2f(-(float)(h + 1)); }
__device__ __forceinline__ float alibi4(int h) { return exp2f(-2.f * (float)(h + 1)); }

#define XB_TMO      128
#define XB_XCNT(j)  (256  + 64 * (j))
#define XB_XSUB(j)  (1280 + 64 * (j))
#define XB_XGEN(j)  (2304 + 64 * (j))
#define XB_TOP      3328
#define XB_TOPGEN   3392
#define XCD_BAR_WORDS 3456
#define XB_SPIN_CAP (1u << 24)
__device__ __forceinline__ unsigned xb_ld(unsigned* p)              { return __hip_atomic_load(p, __ATOMIC_RELAXED, __HIP_MEMORY_SCOPE_AGENT); }
__device__ __forceinline__ unsigned xb_add(unsigned* p, unsigned v) { return __hip_atomic_fetch_add(p, v, __ATOMIC_RELAXED, __HIP_MEMORY_SCOPE_AGENT); }
__device__ __forceinline__ unsigned xb_xcc_id() { return (unsigned)__builtin_amdgcn_s_getreg((3 << 11) | 20) & 0xFu; }
#define XB_SPIN(cond, bar) do { unsigned _sp = 0; while (cond) { __builtin_amdgcn_s_sleep(1); \
    if ((++_sp & 255u) == 0u) { if (xb_ld(&(bar)[XB_TMO])) break; if (_sp > XB_SPIN_CAP) { atomicAdd(&(bar)[XB_TMO], 1u); break; } } } } while (0)
struct XcdBarrier { unsigned* bar; unsigned x; volatile LAS unsigned* st; };
__device__ __forceinline__ XcdBarrier xcd_barrier_post(unsigned* bar, volatile LAS unsigned* st) {
    XcdBarrier b; b.bar = bar; b.x = xb_xcc_id(); b.st = st;
    if (threadIdx.x == 0) (void)xb_add(&bar[XB_XCNT(b.x)], 1u);
    return b;
}
__device__ __forceinline__ void xcd_barrier_complete(unsigned* bar, unsigned x, unsigned& nloc, unsigned& nx) {
    const unsigned G = gridDim.x * gridDim.y * gridDim.z;
    unsigned sum, cnt, mine, sp = 0u;
    for (;;) {
        sum = 0u; cnt = 0u; mine = 0u;
#pragma unroll
        for (unsigned j = 0; j < 16; ++j) { const unsigned c = xb_ld(&bar[XB_XCNT(j)]); sum += c; cnt += (c > 0u) ? 1u : 0u; mine = (j == x) ? c : mine; }
        if (sum == G) break;
        __builtin_amdgcn_s_sleep(1);
        if ((++sp & 255u) == 0u) { if (xb_ld(&bar[XB_TMO])) break; if (sp > XB_SPIN_CAP) { atomicAdd(&bar[XB_TMO], 1u); break; } }
    }
    nloc = mine > 0u ? mine : 1u; nx = cnt > 0u ? cnt : 1u;
}
__device__ __forceinline__ void xcd_barrier(const XcdBarrier& b) {
    asm volatile("s_waitcnt vmcnt(0)" ::: "memory");
    __syncthreads();
    if (threadIdx.x == 0) {
        unsigned* bar = b.bar; asm volatile("" : "+s"(bar));
        __builtin_amdgcn_s_waitcnt(0);
        unsigned nloc = b.st[0], nx = b.st[1];
        if (nloc == 0u) { xcd_barrier_complete(bar, b.x, nloc, nx); b.st[0] = nloc; b.st[1] = nx; }
        const unsigned old = xb_add(&bar[XB_XSUB(b.x)], 1u);
        const unsigned gen = old / nloc;
        if (old + 1u == (gen + 1u) * nloc) {
            __builtin_amdgcn_fence(__ATOMIC_RELEASE, "agent");
            asm volatile("s_waitcnt vmcnt(0)" ::: "memory");
            const unsigned og = xb_add(&bar[XB_TOP], 1u);
            const unsigned tg = og / nx;
            if (og + 1u == (tg + 1u) * nx) xb_add(&bar[XB_TOPGEN], 1u);
            else XB_SPIN(xb_ld(&bar[XB_TOPGEN]) == tg, bar);
            __builtin_amdgcn_fence(__ATOMIC_ACQUIRE, "agent");
            xb_add(&bar[XB_XGEN(b.x)], 1u);
            asm volatile("s_waitcnt vmcnt(0)" ::: "memory");
        } else {
            XB_SPIN(xb_ld(&bar[XB_XGEN(b.x)]) == gen, bar);
            __builtin_amdgcn_fence(__ATOMIC_ACQUIRE, "agent");
            asm volatile("s_waitcnt vmcnt(0)" ::: "memory");
        }
    }
    __syncthreads();
}

struct Args { const float* in[26]; float* out; unsigned char* ws; int ph_lo, ph_hi; };
enum { I_X = 0, I_C, I_ADAW, I_ADAB, I_NMG, I_NFG, I_EWIN, I_EWOUT, I_DLAM, I_DSUB, I_CPOS, I_CW1, I_CW2, I_GATEB, I_OWIN, I_OWOUT, I_FOXB,
       I_RW, I_RB, I_WG, I_BG, I_WU, I_BU, I_WD, I_BD, I_FINALG };

struct Ctx {
    const float* const* in; float* out; unsigned char* ws; LAS unsigned char* lds;
    int tid, lane, wave, gw, NGW;
};
#define PHASE_PROLOG(C0) Ctx C = (C0); { GAS_ unsigned char* wsg_ = (GAS_ unsigned char*)C.ws; asm volatile("" : "+s"(wsg_), "+s"(C.wave)); C.ws = (unsigned char*)wsg_; } { unsigned z_ = 0u; asm volatile("" : "+s"(z_)); C.lane = (int)__builtin_amdgcn_mbcnt_hi(~0u, __builtin_amdgcn_mbcnt_lo(~0u, z_)); } C.tid = C.wave * 64 + C.lane; asm volatile("" : "+v"(C.tid)); C.gw = blockIdx.x * NWAVES + C.wave; \
    unsigned char* ws = C.ws; CAS_ const unsigned char* in_ = (CAS_ const unsigned char*)__builtin_amdgcn_kernarg_segment_ptr(); asm volatile("" : "+s"(in_)); (void)ws; (void)in_
#define WSP(T_, off) ((T_*)(ws + (off)))
#define INP(i) ((const float*)(GAS_ const float*)*(CAS_ const unsigned long long*)(in_ + 8 * (i)))

__device__ __forceinline__ void p_prologue(const Ctx& C0) {
    PHASE_PROLOG(C0);
    LAS float* sc = (LAS float*)C.lds;
    LAS float* red = sc + 4096;
    for (int i = C.tid; i < 4096; i += NTHR) { const float v = INP(I_C)[i]; sc[i] = v * sigmoidf_(v); }
    __syncthreads();
    float* mod = WSP(float, WS_MOD);
    for (int item = blockIdx.x; item < 4 * 48; item += gridDim.x) {
        const int l = item / 48, n0 = (item % 48) * 128, cg = C.tid & 31, kgp = C.tid >> 5;
        const float* w = INP(I_ADAW) + (size_t)l * D * 6144 + n0 + 4 * cg;
        f32x4 acc[4];
#pragma unroll
        for (int b = 0; b < 4; ++b) acc[b] = (f32x4){0.f, 0.f, 0.f, 0.f};
#pragma unroll 1
        for (int k0 = kgp * 64; k0 < kgp * 64 + 64; k0 += 16) {
            f32x4 wv[16];
#pragma unroll
            for (int i = 0; i < 16; ++i) wv[i] = *(const f32x4*)(w + (size_t)(k0 + i) * 6144);
#pragma unroll
            for (int i = 0; i < 16; ++i)
#pragma unroll
                for (int b = 0; b < 4; ++b) acc[b] = acc[b] + wv[i] * sc[b * 1024 + k0 + i];
        }
#pragma unroll
        for (int b = 0; b < 4; ++b) *(LAS f32x4*)(red + (kgp * 4 + b) * 128 + 4 * cg) = acc[b];
        __syncthreads();
        { const int b = C.tid >> 7, col = C.tid & 127; float s = INP(I_ADAB)[l * 6144 + n0 + col];
#pragma unroll
          for (int q = 0; q < 16; ++q) s += red[(q * 4 + b) * 128 + col];
          mod[((size_t)l * 4 + b) * 6144 + n0 + col] = s; }
        __syncthreads();
    }
    float* wxt = WSP(float, WS_WXT); float* rwt = WSP(float, WS_RWT);
    const float* p_ewin = INP(I_EWIN); const float* p_owin = INP(I_OWIN); const float* p_rw = INP(I_RW);
    const int gt = blockIdx.x * NTHR + C.tid, NGT = gridDim.x * NTHR;
    for (int i = gt; i < 4 * 32 * 1024; i += NGT) {
        const int l = i >> 15, j = (i >> 10) & 31, k = i & 1023;
        const bool even = (l & 1) == 0; const int e = l >> 1;
        float v = 0.f;
        if (even) { if (j < 24) v = p_ewin[((size_t)e * D + k) * EVEN_IN + C_BG + j]; }
        else      { if (j < 16) v = p_owin[((size_t)e * D + k) * ODD_IN + 3072 + j]; }
        wxt[i] = v;
        rwt[i] = p_rw[((size_t)l * D + k) * NE + j];
    }
    __syncthreads();
    for (int item = blockIdx.x; item < 4; item += gridDim.x) {
        const float* pos = INP(I_CPOS) + (size_t)item * 2048; const float* w1 = INP(I_CW1) + (size_t)item * 2048 * 128;
        const int j = C.tid & 127, part = C.tid >> 7; float s = 0.f;
#pragma unroll 1
        for (int i0 = part * 512; i0 < part * 512 + 512; i0 += 16) { float wv[16];
#pragma unroll
            for (int i = 0; i < 16; ++i) wv[i] = w1[(size_t)(i0 + i) * 128 + j];
#pragma unroll
            for (int i = 0; i < 16; ++i) s += pos[i0 + i] * wv[i]; }
        red[part * 128 + j] = s;
        __syncthreads();
        if (C.tid < 128) WSP(float, WS_POSB)[item * 128 + C.tid] = (red[C.tid] + red[128 + C.tid]) + (red[256 + C.tid] + red[384 + C.tid]);
        __syncthreads();
    }
}

__device__ __forceinline__ void moe_tile_prefix(const unsigned* cnt, LAS int* tp, int tid) {
    if (tid < 64) {
        int tl = 0; if (tid < 32) tl = ((int)cnt[tid] + 255) >> 8;
        int inc = tl;
#pragma unroll
        for (int o = 1; o < 32; o <<= 1) { const int u = shl_(inc, tid - o); if (tid >= o) inc += u; }
        if (tid < 32) { tp[tid + 1] = inc; tp[64 + tid] = (int)cnt[tid]; }
        if (tid == 0) tp[0] = 0;
    }
    __syncthreads();
}


template <int N, int MASK> struct TreeStage {
    template <int NV> static __device__ __forceinline__ void run(float (&v)[NV], int lane) {
        const bool up = (lane & MASK) != 0;
#pragma unroll
        for (int i = 0; i < N / 2; ++i) { const float a = v[i], b = v[i + N / 2]; const float send = up ? a : b, keep = up ? b : a; v[i] = keep + shx<MASK>(send); }
        TreeStage<N / 2, MASK / 2>::run(v, lane);
    }
};
template <int MASK> struct TreeStage<1, MASK> { template <int NV> static __device__ __forceinline__ void run(float (&)[NV], int) {} };
template <int NV> __device__ __forceinline__ float tree_reduce(float (&v)[NV], int lane) {
    TreeStage<NV, 32>::run(v, lane);
    float r = v[0];
    if (NV == 16) r += shx<2>(r);
    r += shx<1>(r);
    return r;
}

template <int NV> __device__ __forceinline__ void norm1_extras(const f32x4 (&h)[2][4], const LAS float* wl_in, int nx, int lane, float (&res)[2]) {
    const LAS float* wl = wl_in; asm volatile("" : "+v"(wl) : "v"(h[0][0].x), "v"(h[1][0].x), "v"(h[0][3].w), "v"(h[1][3].w));
    float v0[NV], v1[NV];
#pragma unroll
    for (int c = 0; c < NV; ++c) {
        float p0 = 0.f, p1 = 0.f;
        if (c < nx) {
            typedef float f32x2_ __attribute__((ext_vector_type(2)));
            f32x2_ a0 = {0.f, 0.f}, a1 = {0.f, 0.f};
#pragma unroll
            for (int j = 0; j < 4; ++j) { const f32x4 w = *(const LAS f32x4*)(wl + c * 1024 + 4 * (lane + 64 * j));
                a0 = __builtin_elementwise_fma(h[0][j].xy, w.xy, a0); a0 = __builtin_elementwise_fma(h[0][j].zw, w.zw, a0);
                a1 = __builtin_elementwise_fma(h[1][j].xy, w.xy, a1); a1 = __builtin_elementwise_fma(h[1][j].zw, w.zw, a1); }
            p0 = a0.x + a0.y; p1 = a1.x + a1.y;
        }
        asm volatile("" : "+v"(p0), "+v"(p1));
        v0[c] = p0; v1[c] = p1;
    }
    res[0] = tree_reduce<NV>(v0, lane); res[1] = tree_reduce<NV>(v1, lane);
}
__device__ __forceinline__ void router_dots4(const f32x4 (&h)[4][4], const LAS float* wl_in, int lane, float (&res)[4]) {
    typedef float f32x2_ __attribute__((ext_vector_type(2)));
    const LAS float* wl = wl_in; asm volatile("" : "+v"(wl) : "v"(h[0][0].x), "v"(h[1][0].x), "v"(h[2][3].w), "v"(h[3][3].w));
    float v[4][16];
    const bool up = (lane & 32) != 0;
#pragma unroll
    for (int c = 0; c < 32; ++c) {
        f32x2_ a[4];
#pragma unroll
        for (int r = 0; r < 4; ++r) a[r] = (f32x2_){0.f, 0.f};
#pragma unroll
        for (int j = 0; j < 4; ++j) { const f32x4 w = *(const LAS f32x4*)(wl + c * 1024 + 4 * (lane + 64 * j));
#pragma unroll
            for (int r = 0; r < 4; ++r) { a[r] = __builtin_elementwise_fma(h[r][j].xy, w.xy, a[r]); a[r] = __builtin_elementwise_fma(h[r][j].zw, w.zw, a[r]); } }
        float p[4];
#pragma unroll
        for (int r = 0; r < 4; ++r) p[r] = a[r].x + a[r].y;
        asm volatile("" : "+v"(p[0]), "+v"(p[1]), "+v"(p[2]), "+v"(p[3]));
#pragma unroll
        for (int r = 0; r < 4; ++r) {
            if (c < 16) v[r][c] = p[r];
            else { const float lo = v[r][c - 16], hi = p[r]; const float send = up ? lo : hi, keep = up ? hi : lo; v[r][c - 16] = keep + shx<32>(send); }
        }
    }
#pragma unroll
    for (int r = 0; r < 4; ++r) { TreeStage<16, 16>::run(v[r], lane); float t = v[r][0]; t += shx<1>(t); res[r] = t; }
}
__device__ __forceinline__ void p_norm1(const Ctx& C0, int l, int dup = 0) {
    PHASE_PROLOG(C0);
    unsigned char* wsw = ws + (dup ? DUMMY_OFF : (size_t)0);
    const bf16* xcur = WSP(bf16, WS_XCUR); const float* mod = WSP(float, WS_MOD);
    const bf16* Y = WSP(bf16, WS_Y); const int* tope = WSP(int, WS_TOPE); const int* slot = WSP(int, WS_SLOT);
    v2u xn[2][4]; int ten[2][4], sln[2][4];
#define N1_FETCH(tn) do { _Pragma("unroll") for (int rr = 0; rr < 2; ++rr) { \
        _Pragma("unroll") for (int j = 0; j < 4; ++j) xn[rr][j] = *(const v2u*)(xcur + (size_t)((tn) + rr) * D + 4 * (C.lane + 64 * j)); \
        _Pragma("unroll") for (int k = 0; k < 4; ++k) { ten[rr][k] = tope[((tn) + rr) * 4 + k]; sln[rr][k] = slot[((tn) + rr) * 4 + k]; } } } while (0)
    if (l > 0 && (int)blockIdx.x < T / 64) N1_FETCH((int)blockIdx.x * 64 + C.wave * 8);
    LAS int* tpl = (LAS int*)(C.lds + 102400);
    if (l > 0) moe_tile_prefix(WSP(unsigned, WS_CTL) + CW_CNT + (l - 1) * 32, tpl, C.tid);
    const float* wxt = WSP(float, WS_WXT) + (size_t)(l & 3) * 32 * 1024;
    const bool even = (l & 1) == 0;
    LAS float* wl = (LAS float*)C.lds;
    LAS float* lsgl = (LAS float*)(C.lds + 98304);
    const int nx = even ? 24 : 16;
    const float* p_x = INP(I_X); const float* p_fg = INP(I_FINALG); const float* p_nmg = INP(I_NMG); const float* p_gb = INP(I_GATEB); const float* p_fb = INP(I_FOXB);
    if (l < 4) {
        for (int i = C.tid; i < nx * 256; i += NTHR) *(LAS f32x4*)(wl + 4 * i) = *(const f32x4*)(wxt + 4 * i);
        __syncthreads(); }
    for (int chunk = blockIdx.x; chunk < T / 64; chunk += gridDim.x) {
        const int b = (chunk * 64) / S;
        const float* mrow = mod + ((size_t)(l & 3) * 4 + b) * 6144;
        if (l > 0 && chunk != (int)blockIdx.x) N1_FETCH(chunk * 64 + C.wave * 8);
#pragma unroll 1
        for (int pr = 0; pr < 4; ++pr) {
            const int t0 = chunk * 64 + C.wave * 8 + pr * 2;
            f32x4 v[2][4];
#pragma unroll
            for (int rr = 0; rr < 2; ++rr)
#pragma unroll
                for (int j = 0; j < 4; ++j) {
                    if (l == 0) v[rr][j] = *(const f32x4*)(p_x + (size_t)(t0 + rr) * D + 4 * (C.lane + 64 * j));
                    else { const v2u u = xn[rr][j];
                        v[rr][j] = (f32x4){bf2f(u.x & 0xffffu), bf2f(u.x >> 16), bf2f(u.y & 0xffffu), bf2f(u.y >> 16)}; } }
            if (l > 0) {
                const float* g2 = mod + ((size_t)(l - 1) * 4 + b) * 6144 + 5 * 1024;
                int rp[2][4];
#pragma unroll
                for (int rr = 0; rr < 2; ++rr)
#pragma unroll
                    for (int k = 0; k < 4; ++k) rp[rr][k] = 256 * tpl[ten[rr][k]] + sln[rr][k];
                if (pr < 3) N1_FETCH(t0 + 2);
                f32x4 s[2][4];
#pragma unroll
                for (int rr = 0; rr < 2; ++rr)
#pragma unroll
                    for (int j = 0; j < 4; ++j) s[rr][j] = (f32x4){0.f, 0.f, 0.f, 0.f};
#pragma unroll
                for (int rr = 0; rr < 2; ++rr)
#pragma unroll
                    for (int k = 0; k < 4; ++k)
#pragma unroll
                        for (int j = 0; j < 4; ++j) { const v2u u = *(const v2u*)(Y + (size_t)rp[rr][k] * D + 4 * (C.lane + 64 * j));
                            s[rr][j].x += bf2f(u.x & 0xffffu); s[rr][j].y += bf2f(u.x >> 16); s[rr][j].z += bf2f(u.y & 0xffffu); s[rr][j].w += bf2f(u.y >> 16); }
#pragma unroll
                for (int j = 0; j < 4; ++j) { const f32x4 g = *(const f32x4*)(g2 + 4 * (C.lane + 64 * j));
#pragma unroll
                    for (int rr = 0; rr < 2; ++rr) { v[rr][j] = v[rr][j] + g * s[rr][j];
                        if (l < 4) { v2u o; o.x = pk2(v[rr][j].x, v[rr][j].y); o.y = pk2(v[rr][j].z, v[rr][j].w);
                            *(v2u*)((bf16*)(wsw + WS_XCUR) + (size_t)(t0 + rr) * D + 4 * (C.lane + 64 * j)) = o; } } }
            }
            float ss[2];
#pragma unroll
            for (int rr = 0; rr < 2; ++rr) { float a = 0.f;
#pragma unroll
                for (int j = 0; j < 4; ++j) a += (v[rr][j].x * v[rr][j].x + v[rr][j].y * v[rr][j].y) + (v[rr][j].z * v[rr][j].z + v[rr][j].w * v[rr][j].w);
                ss[rr] = a; }
            ss[0] = wave_sum(ss[0]); ss[1] = wave_sum(ss[1]);
            const float r0 = rsqrtf(ss[0] * (1.f / D) + EPS), r1 = rsqrtf(ss[1] * (1.f / D) + EPS);
            if (l == 4) {
#pragma unroll
                for (int j = 0; j < 4; ++j) { const f32x4 g = *(const f32x4*)(p_fg + 4 * (C.lane + 64 * j));
                    float* ob = dup ? (float*)(wsw + WS_XCUR) : C.out;
                    *(f32x4*)(ob + (size_t)t0 * D + 4 * (C.lane + 64 * j)) = v[0][j] * r0 * g;
                    *(f32x4*)(ob + (size_t)(t0 + 1) * D + 4 * (C.lane + 64 * j)) = v[1][j] * r1 * g; }
                continue;
            }
            f32x4 h[2][4];
#pragma unroll
            for (int j = 0; j < 4; ++j) { const int i0 = 4 * (C.lane + 64 * j);
                const f32x4 g = *(const f32x4*)(p_nmg + l * D + i0), sh = *(const f32x4*)(mrow + i0), scl = *(const f32x4*)(mrow + 1024 + i0);
                const f32x4 gs = g * (scl + 1.f);
                h[0][j] = v[0][j] * r0 * gs + sh; h[1][j] = v[1][j] * r1 * gs + sh;
#pragma unroll
                for (int rr = 0; rr < 2; ++rr) { v2u o; o.x = pk2(h[rr][j].x, h[rr][j].y); o.y = pk2(h[rr][j].z, h[rr][j].w);
                    *(v2u*)((bf16*)(wsw + WS_H) + (size_t)(t0 + rr) * D + i0) = o; } }
            float res[2];
            if (even) {
                norm1_extras<32>(h, wl, 24, C.lane, res);
                const int c = C.lane >> 1;
                if ((C.lane & 1) == 0 && c < 24) { const float gb = p_gb[(l >> 1) * 24 + c];
                    ((float*)(wsw + WS_GL))[(size_t)t0 * 32 + c] = res[0] + gb; ((float*)(wsw + WS_GL))[(size_t)(t0 + 1) * 32 + c] = res[1] + gb; }
            } else {
                norm1_extras<16>(h, wl, 16, C.lane, res);
                const int c = C.lane >> 2;
                if ((C.lane & 3) == 0) { const float fb = p_fb[(l >> 1) * 16 + c];
#pragma unroll
                    for (int rr = 0; rr < 2; ++rr) { const float z = res[rr] + fb; lsgl[(C.wave * 8 + pr * 2 + rr) * 16 + c] = fminf(z, 0.f) - log1pf(__expf(-fabsf(z))); } }
            }
        }
#undef N1_FETCH
        if (l < 4 && !even) {
            __syncthreads();
            if (C.tid < 16 && !dup) { float run = 0.f; float* cum = WSP(float, WS_CUMF);
                for (int i = 0; i < 64; ++i) { run += lsgl[i * 16 + C.tid]; cum[(size_t)(chunk * 64 + i) * 16 + C.tid] = run; }
                WSP(float, WS_CHTOT)[chunk * 16 + C.tid] = run; }
            __syncthreads();
        }
    }
}

template <int NW, class TileFn, class Epi>
__device__ __forceinline__ void simple_gemm(Ctx& C, const bf16* Abase, int lda, int MT, int NT, int K, int ldw, const TileFn& tf, const Epi& epi) {
    LAS float* As = (LAS float*)C.lds;
    LAS float* Ws = As + 64 * 17;
    const int ty = C.tid >> 5, tx = C.tid & 31;
    for (int tile = blockIdx.x; tile < MT * NT; tile += gridDim.x) {
        const int mt = tile / NT, nt = tile % NT;
        const float* W0 = nullptr; const float* W1 = nullptr;
        if (!tf(mt, nt, W0, W1)) continue;
        float acc[NW][4][4];
#pragma unroll
        for (int w = 0; w < NW; ++w)
#pragma unroll
            for (int i = 0; i < 4; ++i)
#pragma unroll
                for (int j = 0; j < 4; ++j) acc[w][i][j] = 0.f;
        for (int k0 = 0; k0 < K; k0 += 16) {
            __syncthreads();
            { const int r = C.tid >> 3, kk = (C.tid & 7) * 2;
              const unsigned u = *(const unsigned*)(Abase + (size_t)(mt * 64 + r) * lda + k0 + kk);
              As[r * 17 + kk] = bf2f(u & 0xffffu); As[r * 17 + kk + 1] = bf2f(u >> 16); }
#pragma unroll
            for (int w = 0; w < NW; ++w) { const float* Wp = w == 0 ? W0 : W1;
                const int kk = C.tid >> 5, c4 = (C.tid & 31) * 4;
                *(LAS f32x4*)(Ws + (w * 16 + kk) * 128 + c4) = *(const f32x4*)(Wp + (size_t)(k0 + kk) * ldw + nt * 128 + c4); }
            __syncthreads();
#pragma unroll
            for (int kk = 0; kk < 16; ++kk) {
                float a[4];
#pragma unroll
                for (int i = 0; i < 4; ++i) a[i] = As[(ty * 4 + i) * 17 + kk];
#pragma unroll
                for (int w = 0; w < NW; ++w) { const f32x4 wv = *(const LAS f32x4*)(Ws + (w * 16 + kk) * 128 + tx * 4);
#pragma unroll
                    for (int i = 0; i < 4; ++i) { acc[w][i][0] += a[i] * wv.x; acc[w][i][1] += a[i] * wv.y; acc[w][i][2] += a[i] * wv.z; acc[w][i][3] += a[i] * wv.w; } }
            }
        }
#pragma unroll
        for (int i = 0; i < 4; ++i) epi(mt * 64 + ty * 4 + i, nt * 128 + tx * 4, acc[0][i], acc[NW - 1][i]);
    }
    __syncthreads();
}

__device__ __forceinline__ int expert_of_row(const unsigned* cnt, int r0) {
    int start = 0;
    for (int e = 0; e < NE; ++e) { const int pad = ((int)cnt[e] + 255) & ~255; if (r0 < start + pad) return e; start += pad; }
    return -1;
}


namespace pg8 {
typedef short bf16x8 __attribute__((ext_vector_type(8)));
typedef unsigned u32x4 __attribute__((ext_vector_type(4)));
constexpr int BM = 256, BK = 64, HALF = 128, HTB = HALF * BK * 2, STAGE_BYTES = 8 * HTB, NXCD = 8, WGM = 8;
__device__ __forceinline__ int lds_byte(int r, int c) { const int st = (r >> 4) * 2 + (c >> 5), rr = r & 15, cc = c & 31, ob = rr * 64 + cc * 2; return st * 1024 + (ob ^ (((ob >> 9) & 1) << 5)); }
__device__ __forceinline__ void stage_rc(int b, int& R, int& C) { const int st = b / 1024, sb = b % 1024, swz = sb ^ (((sb >> 9) & 1) << 5); R = (st >> 1) * 16 + swz / 64; C = (st & 1) * 32 + (swz % 64) / 2; }
__device__ __forceinline__ int perm32(int rho) { const int n = rho >> 4, i = rho & 15; return 8 * (i >> 2) + 4 * n + (i & 3); }
struct Unit { int pm, pn, pb; };
struct Gemm { const bf16* A; const bf16* Bt; int K; };
struct StaticOrder {
    int nM, nN, nwg, G, c;
    __device__ void init(int M, int N, int G_, int c_) { nM = M / BM; nN = N / BM; nwg = nM * nN; G = G_; c = c_; }
    __device__ bool next(int i, Unit& u) const {
        const long L = (long)i * G + c; if (L >= nwg) return false;
        int wgid = (int)L; { const int q = nwg / NXCD, r = nwg % NXCD, xcd = wgid % NXCD, off = wgid / NXCD; wgid = (xcd < r ? xcd * (q + 1) : r * (q + 1) + (xcd - r) * q) + off; }
        const int nig = WGM * nN, gid = wgid / nig, fm = gid * WGM, gsz = (nM - fm) < WGM ? (nM - fm) : WGM;
        u.pm = fm + ((wgid % nig) % gsz); u.pn = (wgid % nig) / gsz; u.pb = u.pn; return true;
    }
    __device__ __forceinline__ const int* a_ptr(const Unit&, int) const { return nullptr; }
};
struct MoeOrder {
    const LAS int* tp; int NPN, G, c; const int* etok;
    __device__ bool next(int i, Unit& u) const {
        const int L = i * G + c; const int pm = L / NPN; if (pm >= __builtin_amdgcn_readfirstlane(tp[32])) return false;
        int e = 0;
        for (int k = 1; k < 32; ++k) e += (pm >= tp[k]) ? 1 : 0;
        e = __builtin_amdgcn_readfirstlane(e);
        u.pm = pm; u.pn = L - pm * NPN; u.pb = e * NPN + u.pn; return true;
    }
    __device__ __forceinline__ const int* a_ptr(const Unit& u, int row) const {
        const int e = u.pb / NPN; int s = (u.pm - tp[e]) * 256 + row; const int ce = tp[64 + e] - 1; s = s < ce ? s : ce;
        return etok + e * 16384 + s;
    }
};
__device__ __forceinline__ unsigned cvt_pk_bf16(float lo, float hi) { unsigned r; asm volatile("v_cvt_pk_bf16_f32 %0, %1, %2" : "=v"(r) : "v"(lo), "v"(hi)); return r; }

template <class Epi, class Sched, bool ALIGN_EPI, bool SP2, bool GATHER = false>
__device__ __forceinline__ void gemm_phase(LAS unsigned char* lds, const int tid, const Gemm g, const Sched& S, const Epi& E_in) {
    Epi E = E_in;
    const int wid = __builtin_amdgcn_readfirstlane(tid >> 6), lane = tid & 63, wr = wid >> 2, wc = wid & 3, fr = lane & 15, fq = lane >> 4;
    const int K = g.K, nt = K / BK;
    unsigned voffA[2], voffB[2];
#pragma unroll
    for (int i = 0; i < 2; ++i) { int R, C; stage_rc(tid * 16 + i * 8192, R, C); const int Rb = Epi::PERM ? ((R & ~31) + perm32(R & 31)) : R;
        voffA[i] = (unsigned)(R * K + C) * 2u; voffB[i] = (unsigned)(Rb * K + C) * 2u; }
    const size_t kstep = (size_t)(BK * 2);
    const size_t hstep = (size_t)HALF * K * 2;
    const size_t tstep = 2 * hstep;
    const unsigned ldsw = (unsigned)wid * 1024u;
    const int aoff = lds_byte(wr * 64 + fr, fq * 8), boff = lds_byte(wc * 32 + fr, fq * 8);
#define PG8_SA(b, h) (((b) * 2 + (h)) * HTB)
#define PG8_SB(b, h) ((4 + (b) * 2 + (h)) * HTB)
#define PG8_STAGE(bufoff, gbase, voff) do { _Pragma("unroll") for (int _i = 0; _i < 2; ++_i) \
        __builtin_amdgcn_global_load_lds((const unsigned*)((const char*)(gbase) + (voff)[_i]), (LAS unsigned*)(lds + (bufoff) + ldsw + _i * 8192), 16, 0, 0); } while (0)
#define PG8_STAGE2(bufoff, gbase, o0, o1) do { \
        __builtin_amdgcn_global_load_lds((const unsigned*)((const char*)(gbase) + (o0)), (LAS unsigned*)(lds + (bufoff) + ldsw), 16, 0, 0); \
        __builtin_amdgcn_global_load_lds((const unsigned*)((const char*)(gbase) + (o1)), (LAS unsigned*)(lds + (bufoff) + ldsw + 8192), 16, 0, 0); } while (0)
#define PG8_LDA(dst, b, h) do { _Pragma("unroll") for (int m = 0; m < 4; ++m) _Pragma("unroll") for (int k = 0; k < 2; ++k) dst[m][k] = *(const LAS bf16x8*)(lds + PG8_SA(b, h) + aoff + m * 2048 + k * 1024); } while (0)
#define PG8_LDB(dst, b, h) do { _Pragma("unroll") for (int n = 0; n < 2; ++n) _Pragma("unroll") for (int k = 0; k < 2; ++k) dst[n][k] = *(const LAS bf16x8*)(lds + PG8_SB(b, h) + boff + n * 2048 + k * 1024); } while (0)
#define PG8_MMA(ai, bj, At, Bt) do { __builtin_amdgcn_s_setprio(1); _Pragma("unroll") for (int m = 0; m < 4; ++m) _Pragma("unroll") for (int n = 0; n < 2; ++n) _Pragma("unroll") for (int k = 0; k < 2; ++k) \
        acc[ai][bj][m][n] = __builtin_amdgcn_mfma_f32_16x16x32_bf16(Bt[n][k], At[m][k], acc[ai][bj][m][n], 0, 0, 0); __builtin_amdgcn_s_setprio(0); } while (0)
#define PG8_WAIT_V(n) asm volatile("s_waitcnt vmcnt(" #n ")" ::: "memory")
#define PG8_WAIT_L(n) asm volatile("s_waitcnt lgkmcnt(" #n ")" ::: "memory")
#define PG8_BAR __builtin_amdgcn_s_barrier()
#define PG8_SCHED __builtin_amdgcn_sched_barrier(0)
    Unit cur, nxt; int ui = 0;
    if (!S.next(0, cur)) return;
    f32x4 acc[2][2][4][2];
#pragma unroll
    for (int a = 0; a < 2; ++a)
#pragma unroll
        for (int b = 0; b < 2; ++b)
#pragma unroll
            for (int m = 0; m < 4; ++m)
#pragma unroll
                for (int n = 0; n < 2; ++n) acc[a][b][m][n] = (f32x4){0.f, 0.f, 0.f, 0.f};
    bf16x8 At[4][2], B0[2][2], B1[2][2];
    static_assert(!GATHER || SP2, "gathered A rows: SP2 loop only");
    const size_t ahs = GATHER ? (size_t)0 : hstep;
    constexpr int GOFF = STAGE_BYTES + 1024;
    unsigned vA[2][2], cc[2];
#pragma unroll
    for (int i = 0; i < 2; ++i) { int R, C; stage_rc(tid * 16 + i * 8192, R, C); cc[i] = (unsigned)(C * 2); vA[0][i] = voffA[i]; vA[1][i] = voffA[i]; }
    if constexpr (GATHER) {
#pragma unroll
        for (int h = 0; h < 2; ++h)
#pragma unroll
            for (int i = 0; i < 2; ++i) { int R, C; stage_rc(tid * 16 + i * 8192, R, C); vA[h][i] = (unsigned)(*S.a_ptr(cur, h * HALF + R)) * 2048u + cc[i]; }
    }
    const char* cA = (const char*)g.A + (GATHER ? (size_t)0 : (size_t)cur.pm * tstep); const char* cB = (const char*)g.Bt + (size_t)cur.pb * tstep;
    if constexpr (SP2) {
        PG8_STAGE(PG8_SB(0, 0), cB, voffB); PG8_STAGE(PG8_SB(0, 1), cB + hstep, voffB); PG8_STAGE2(PG8_SA(0, 0), cA, vA[0][0], vA[0][1]); PG8_STAGE2(PG8_SA(0, 1), cA + ahs, vA[1][0], vA[1][1]);
        if (wr == 1) PG8_BAR;
        PG8_WAIT_V(2); PG8_BAR;
        PG8_STAGE(PG8_SB(1, 0), cB + kstep, voffB); PG8_STAGE2(PG8_SA(1, 0), cA + kstep, vA[0][0], vA[0][1]); PG8_STAGE(PG8_SB(1, 1), cB + hstep + kstep, voffB);
        PG8_WAIT_V(6); PG8_BAR;
    } else {
        PG8_STAGE(PG8_SB(0, 0), cB, voffB); PG8_STAGE(PG8_SA(0, 0), cA, voffA); PG8_STAGE(PG8_SB(0, 1), cB + hstep, voffB); PG8_STAGE(PG8_SA(0, 1), cA + hstep, voffA);
        if (wr == 1) PG8_BAR;
        PG8_WAIT_V(4); PG8_BAR;
        PG8_STAGE(PG8_SB(1, 0), cB + kstep, voffB); PG8_STAGE(PG8_SA(1, 0), cA + kstep, voffA); PG8_STAGE(PG8_SB(1, 1), cB + hstep + kstep, voffB);
        PG8_WAIT_V(6); PG8_BAR;
    }
    for (;;) {
        const bool has_next = S.next(ui + 1, nxt);
        E.prefetch(lds, cur, ui, wid, lane);
        const char* nA = GATHER ? (const char*)g.A : (has_next ? (const char*)g.A + (size_t)nxt.pm * tstep : cA); const char* nB = has_next ? (const char*)g.Bt + (size_t)nxt.pb * tstep : cB;
        if constexpr (GATHER) {
            if (has_next) {
#pragma unroll
                for (int h = 0; h < 2; ++h)
#pragma unroll
                    for (int i = 0; i < 2; ++i) { int R, C; stage_rc(tid * 16 + i * 8192, R, C);
                        __builtin_amdgcn_global_load_lds((const unsigned*)S.a_ptr(nxt, h * HALF + R), (LAS unsigned*)(lds + GOFF + (h * 2 + i) * 2048 + wid * 256), 4, 0, 0); }
            }
        }
        for (int t = 0; t < nt; t += 2) {
            const bool last = (t == nt - 2);
            const char* a1 = cA + (size_t)(t + 1) * kstep;
            const char* a2 = last ? nA : cA + (size_t)(t + 2) * kstep; const char* b2 = last ? nB : cB + (size_t)(t + 2) * kstep;
            const char* a3 = a2 + kstep; const char* b3 = b2 + kstep;
            if constexpr (SP2) {
            PG8_LDB(B0, 0, 0); PG8_LDB(B1, 0, 1); PG8_SCHED; PG8_LDA(At, 0, 0); PG8_STAGE2(PG8_SA(1, 1), a1 + ahs, vA[1][0], vA[1][1]);
            if constexpr (GATHER) { if (last && has_next) {
#pragma unroll
                for (int h = 0; h < 2; ++h)
#pragma unroll
                    for (int i = 0; i < 2; ++i) vA[h][i] = *(const LAS unsigned*)(lds + GOFF + (h * 2 + i) * 2048 + tid * 4) * 2048u + cc[i]; } }
            PG8_WAIT_V(8); PG8_WAIT_L(0); PG8_BAR; PG8_MMA(0, 0, At, B0); PG8_MMA(0, 1, At, B1); PG8_BAR; PG8_SCHED;
            PG8_LDA(At, 0, 1); PG8_STAGE(PG8_SB(0, 0), b2, voffB); PG8_STAGE(PG8_SB(0, 1), b2 + hstep, voffB); PG8_STAGE2(PG8_SA(0, 0), a2, vA[0][0], vA[0][1]);
            PG8_WAIT_V(8); PG8_WAIT_L(0); PG8_BAR; PG8_MMA(1, 0, At, B0); PG8_MMA(1, 1, At, B1); PG8_BAR; PG8_SCHED;
            PG8_LDB(B0, 1, 0); PG8_LDB(B1, 1, 1); PG8_SCHED; PG8_LDA(At, 1, 0); PG8_STAGE2(PG8_SA(0, 1), a2 + ahs, vA[1][0], vA[1][1]);
            PG8_WAIT_V(8); PG8_WAIT_L(0); PG8_BAR; PG8_MMA(0, 0, At, B0); PG8_MMA(0, 1, At, B1); PG8_BAR; PG8_SCHED;
            PG8_LDA(At, 1, 1); PG8_STAGE(PG8_SB(1, 0), b3, voffB); PG8_STAGE(PG8_SB(1, 1), b3 + hstep, voffB); PG8_STAGE2(PG8_SA(1, 0), a3, vA[0][0], vA[0][1]);
            PG8_WAIT_V(8); PG8_WAIT_L(0); PG8_BAR; PG8_MMA(1, 0, At, B0); PG8_MMA(1, 1, At, B1); PG8_BAR; PG8_SCHED;
            } else {
            PG8_LDB(B0, 0, 0); PG8_SCHED; PG8_LDA(At, 0, 0); PG8_STAGE(PG8_SA(1, 1), a1 + hstep, voffA);
            PG8_WAIT_L(8); PG8_BAR; PG8_WAIT_L(0); PG8_MMA(0, 0, At, B0); PG8_BAR; PG8_SCHED;
            PG8_LDB(B1, 0, 1); PG8_STAGE(PG8_SB(0, 0), b2, voffB);
            PG8_BAR; PG8_WAIT_L(0); PG8_MMA(0, 1, At, B1); PG8_BAR;
            PG8_LDA(At, 0, 1); PG8_STAGE(PG8_SA(0, 0), a2, voffA);
            PG8_BAR; PG8_WAIT_L(0); PG8_MMA(1, 0, At, B0); PG8_BAR; PG8_SCHED;
            PG8_STAGE(PG8_SB(0, 1), b2 + hstep, voffB);
            PG8_WAIT_V(6); PG8_BAR; PG8_MMA(1, 1, At, B1); PG8_BAR;
            PG8_LDB(B0, 1, 0); PG8_SCHED; PG8_LDA(At, 1, 0); PG8_STAGE(PG8_SA(0, 1), a2 + hstep, voffA);
            PG8_WAIT_L(8); PG8_BAR; PG8_WAIT_L(0); PG8_MMA(0, 0, At, B0); PG8_BAR; PG8_SCHED;
            PG8_LDB(B1, 1, 1); PG8_STAGE(PG8_SB(1, 0), b3, voffB);
            PG8_BAR; PG8_WAIT_L(0); PG8_MMA(0, 1, At, B1); PG8_BAR;
            PG8_LDA(At, 1, 1); PG8_STAGE(PG8_SA(1, 0), a3, voffA);
            PG8_BAR; PG8_WAIT_L(0); PG8_MMA(1, 0, At, B0); PG8_BAR; PG8_SCHED;
            PG8_STAGE(PG8_SB(1, 1), b3 + hstep, voffB);
            PG8_WAIT_V(6); PG8_BAR; PG8_MMA(1, 1, At, B1); PG8_BAR;
            }
        }
        if constexpr (ALIGN_EPI) { if (wr == 0) PG8_BAR; }
        E.bind(lds, ui);
        { int te = tid; asm volatile("" : "+v"(te));
          E(acc, cur, wr, wc, te & 15, (te & 63) >> 4); }
        if (!has_next) break;
#pragma unroll
        for (int a = 0; a < 2; ++a)
#pragma unroll
            for (int b = 0; b < 2; ++b)
#pragma unroll
                for (int m = 0; m < 4; ++m)
#pragma unroll
                    for (int n = 0; n < 2; ++n) acc[a][b][m][n] = (f32x4){0.f, 0.f, 0.f, 0.f};
        cur = nxt; cA = nA; cB = nB; ++ui;
        if constexpr (ALIGN_EPI) { if (wr == 1) PG8_BAR; }
    }
    PG8_WAIT_V(0);
    if constexpr (!ALIGN_EPI) { if (wr == 0) PG8_BAR; }
    PG8_BAR;
#undef PG8_SA
#undef PG8_SB
#undef PG8_STAGE
#undef PG8_LDA
#undef PG8_STAGE2
#undef PG8_LDB
#undef PG8_MMA
#undef PG8_WAIT_V
#undef PG8_WAIT_L
#undef PG8_BAR
#undef PG8_SCHED
}

struct EpiQKV {
    static constexpr bool PERM = true;
    __device__ __forceinline__ void prefetch(LAS unsigned char*, const Unit&, int, int, int) const {}
    __device__ __forceinline__ void bind(LAS unsigned char*, int) {}
    bf16* O; int ldc; unsigned* knp; int klo, khi;
    __device__ __forceinline__ void operator()(const f32x4 (&acc)[2][2][4][2], const Unit& u, int wr, int wc, int fr, int fq) const {
        const int row0 = u.pm * BM + wr * 64 + fr, col0 = u.pn * BM + wc * 32 + 8 * fq;
        if (u.pn >= klo && u.pn < khi) {
#pragma unroll
            for (int bj = 0; bj < 2; ++bj) { float mx = 0.f;
#pragma unroll
                for (int ai = 0; ai < 2; ++ai)
#pragma unroll
                    for (int m = 0; m < 4; ++m) { const f32x4 a = acc[ai][bj][m][0], c = acc[ai][bj][m][1];
                        float s2 = ((a[0] * a[0] + a[1] * a[1]) + (a[2] * a[2] + a[3] * a[3])) + ((c[0] * c[0] + c[1] * c[1]) + (c[2] * c[2] + c[3] * c[3]));
                        s2 += shx<16>(s2); s2 += shx<32>(s2); mx = fmaxf(mx, s2); }
                mx = fmaxf(mx, shx<1>(mx)); mx = fmaxf(mx, shx<2>(mx)); mx = fmaxf(mx, shx<4>(mx)); mx = fmaxf(mx, shx<8>(mx));
                if ((fr | fq) == 0) __hip_atomic_fetch_max(knp + (u.pm >> 4) * 96 + u.pn * 8 + bj * 4 + wc, __float_as_uint(mx), __ATOMIC_RELAXED, __HIP_MEMORY_SCOPE_AGENT); }
        }
#pragma unroll
        for (int ai = 0; ai < 2; ++ai)
#pragma unroll
            for (int m = 0; m < 4; ++m) { bf16* rowp = O + (size_t)(row0 + ai * HALF + m * 16) * ldc + col0;
#pragma unroll
                for (int bj = 0; bj < 2; ++bj) { const f32x4 v0 = acc[ai][bj][m][0], v1 = acc[ai][bj][m][1];
                    u32x4 w; w.x = cvt_pk_bf16(v0[0], v0[1]); w.y = cvt_pk_bf16(v0[2], v0[3]); w.z = cvt_pk_bf16(v1[0], v1[1]); w.w = cvt_pk_bf16(v1[2], v1[3]);
                    *(u32x4*)(rowp + bj * HALF) = w; } }
    }
};
struct EpiOut {
    static constexpr bool PERM = true;
    __device__ __forceinline__ void prefetch(LAS unsigned char*, const Unit&, int, int, int) const {}
    __device__ __forceinline__ void bind(LAS unsigned char*, int) {}
    const float* x32; const bf16* xprev; bf16* xout; const float* g1;
    __device__ __forceinline__ void operator()(const f32x4 (&acc)[2][2][4][2], const Unit& u, int wr, int wc, int fr, int fq) const {
        const int row0 = u.pm * BM + wr * 64 + fr, col0 = u.pn * BM + wc * 32 + 8 * fq;
        const float* gv = g1 + (size_t)(u.pm >> 4) * 6144 + col0;
        f32x4 gg[2][2];
#pragma unroll
        for (int bj = 0; bj < 2; ++bj)
#pragma unroll
            for (int n = 0; n < 2; ++n) gg[bj][n] = *(const f32x4*)(gv + bj * HALF + n * 4);
#pragma unroll
        for (int ai = 0; ai < 2; ++ai)
#pragma unroll
            for (int m = 0; m < 4; ++m) { const size_t ro = (size_t)(row0 + ai * HALF + m * 16) * 1024 + col0;
#pragma unroll
                for (int bj = 0; bj < 2; ++bj) { f32x4 p0, p1;
                    if (x32) { p0 = *(const f32x4*)(x32 + ro + bj * HALF); p1 = *(const f32x4*)(x32 + ro + bj * HALF + 4); }
                    else { const u32x4 q = *(const u32x4*)(xprev + ro + bj * HALF);
                        p0 = (f32x4){bf2f(q.x & 0xffffu), bf2f(q.x >> 16), bf2f(q.y & 0xffffu), bf2f(q.y >> 16)};
                        p1 = (f32x4){bf2f(q.z & 0xffffu), bf2f(q.z >> 16), bf2f(q.w & 0xffffu), bf2f(q.w >> 16)}; }
                    const f32x4 o0 = p0 + gg[bj][0] * acc[ai][bj][m][0], o1 = p1 + gg[bj][1] * acc[ai][bj][m][1];
                    u32x4 w; w.x = cvt_pk_bf16(o0[0], o0[1]); w.y = cvt_pk_bf16(o0[2], o0[3]); w.z = cvt_pk_bf16(o1[0], o1[1]); w.w = cvt_pk_bf16(o1[2], o1[3]);
                    *(u32x4*)(xout + ro + bj * HALF) = w; } }
    }
};
constexpr int EOFF = STAGE_BYTES + 1024 + 8192;
struct EpiMoe1 {
    static constexpr bool PERM = true;
    bf16* act; const float* bgate; const float* bup;
    const LAS float* eb;
    __device__ __forceinline__ void prefetch(LAS unsigned char* lds, const Unit& u, int ui, int wid, int lane) const {
        if (wid < 4) { const float* src = ((wid & 2) ? bup : bgate) + (u.pb >> 3) * 1024 + u.pn * HALF + (wid & 1) * 64 + lane;
            __builtin_amdgcn_global_load_lds((const unsigned*)src, (LAS unsigned*)(lds + EOFF + (ui & 1) * 2048 + wid * 256), 4, 0, 0); }
    }
    __device__ __forceinline__ void bind(LAS unsigned char* lds, int ui) { eb = (const LAS float*)(lds + EOFF + (ui & 1) * 2048); }
    __device__ __forceinline__ void operator()(const f32x4 (&acc)[2][2][4][2], const Unit& u, int wr, int wc, int fr, int fq) const {
        const int row0 = u.pm * BM + wr * 64 + fr, col0 = u.pn * HALF + wc * 32 + 8 * fq;
        f32x4 bg[2], bu[2];
#pragma unroll
        for (int n = 0; n < 2; ++n) { bg[n] = *(const LAS f32x4*)(eb + wc * 32 + 8 * fq + 4 * n); bu[n] = *(const LAS f32x4*)(eb + 128 + wc * 32 + 8 * fq + 4 * n); }
#pragma unroll
        for (int ai = 0; ai < 2; ++ai)
#pragma unroll
            for (int m = 0; m < 4; ++m) { float o[8];
#pragma unroll
                for (int n = 0; n < 2; ++n) {
                    const f32x4 ag = acc[ai][0][m][n] + bg[n], au = acc[ai][1][m][n] + bu[n];
                    f32x4 hg, hu;
#pragma unroll
                    for (int j = 0; j < 4; ++j) { hg[j] = fminf(ag[j], 7.f); hu[j] = fminf(fmaxf(au[j], -7.f), 7.f); }
                    const f32x4 t = hg * (-1.702f * 1.44269504f);
                    f32x4 e;
#pragma unroll
                    for (int j = 0; j < 4; ++j) e[j] = __builtin_amdgcn_exp2f(t[j]);
                    const f32x4 d = e + 1.f;
                    f32x4 r;
#pragma unroll
                    for (int j = 0; j < 4; ++j) r[j] = __builtin_amdgcn_rcpf(d[j]);
                    const f32x4 ov = (hg * r) * (hu + 1.f);
#pragma unroll
                    for (int j = 0; j < 4; ++j) o[n * 4 + j] = ov[j]; }
                u32x4 w; w.x = cvt_pk_bf16(o[0], o[1]); w.y = cvt_pk_bf16(o[2], o[3]); w.z = cvt_pk_bf16(o[4], o[5]); w.w = cvt_pk_bf16(o[6], o[7]);
                *(u32x4*)(act + (size_t)(row0 + ai * HALF + m * 16) * 1024 + col0) = w; }
    }
};
struct EpiMoe2 {
    static constexpr bool PERM = true;
    bf16* y; const float* bdown; const float* egate; const LAS int* tp;
    const LAS float* eb;
    __device__ __forceinline__ void prefetch(LAS unsigned char* lds, const Unit& u, int ui, int wid, int lane) const {
        const int e = u.pb >> 2;
        const float* src;
        if (wid < 4) src = bdown + e * 1024 + u.pn * BM + wid * 64 + lane;
        else { int s = (u.pm - tp[e]) * 256 + (wid - 4) * 64 + lane; const int ce = tp[64 + e] - 1; s = s < ce ? s : ce; src = egate + e * 16384 + s; }
        __builtin_amdgcn_global_load_lds((const unsigned*)src, (LAS unsigned*)(lds + EOFF + (ui & 1) * 2048 + wid * 256), 4, 0, 0);
    }
    __device__ __forceinline__ void bind(LAS unsigned char* lds, int ui) { eb = (const LAS float*)(lds + EOFF + (ui & 1) * 2048); }
    __device__ __forceinline__ void operator()(const f32x4 (&acc)[2][2][4][2], const Unit& u, int wr, int wc, int fr, int fq) const {
        const int row0 = u.pm * BM + wr * 64 + fr, col0 = u.pn * BM + wc * 32 + 8 * fq;
        f32x4 bd[2][2];
#pragma unroll
        for (int bj = 0; bj < 2; ++bj)
#pragma unroll
            for (int n = 0; n < 2; ++n) bd[bj][n] = *(const LAS f32x4*)(eb + wc * 32 + 8 * fq + bj * HALF + 4 * n);
#pragma unroll
        for (int ai = 0; ai < 2; ++ai)
#pragma unroll
            for (int m = 0; m < 4; ++m) { const int rl = wr * 64 + fr + ai * HALF + m * 16, row = u.pm * BM + rl; const float gt = eb[256 + rl];
#pragma unroll
                for (int bj = 0; bj < 2; ++bj) { const f32x4 v0 = (acc[ai][bj][m][0] + bd[bj][0]) * gt, v1 = (acc[ai][bj][m][1] + bd[bj][1]) * gt;
                    u32x4 w; w.x = cvt_pk_bf16(v0[0], v0[1]); w.y = cvt_pk_bf16(v0[2], v0[3]); w.z = cvt_pk_bf16(v1[0], v1[1]); w.w = cvt_pk_bf16(v1[2], v1[3]);
                    *(u32x4*)(y + (size_t)row * 1024 + col0 + bj * HALF) = w; } }
        (void)row0;
    }
};
}

struct TItem { const float* W; bf16* WT; int ld, K, drow0, k0, n0; };
__device__ __forceinline__ void ti_load(float (&v)[32], const TItem& t, int lane) {
#pragma unroll
    for (int i = 0; i < 32; ++i) v[i] = __builtin_nontemporal_load(t.W + (size_t)(t.k0 + 2 * i + (lane >> 5)) * t.ld + t.n0 + (lane & 31));
}
__device__ __forceinline__ void ti_emit(const TItem& t, const LAS float* scr, int lane) {
    const int c = lane & 7;
#pragma unroll
    for (int j = 0; j < 4; ++j) { const int n = (lane >> 3) + 8 * j;
        float s[8];
#pragma unroll
        for (int q = 0; q < 8; ++q) { const int kk = 8 * c + q; s[q] = scr[kk * 32 + ((n + kk) & 31)]; }
        v4u o; o.x = pk2(s[0], s[1]); o.y = pk2(s[2], s[3]); o.z = pk2(s[4], s[5]); o.w = pk2(s[6], s[7]);
        *(v4u*)(t.WT + (size_t)(t.drow0 + n) * t.K + t.k0 + 8 * c) = o; }
    asm volatile("s_waitcnt lgkmcnt(0)" ::: "memory");
}
__device__ __forceinline__ void ti_store(const float (&v)[32], const TItem& t, LAS float* scr, int lane) {
#pragma unroll
    for (int i = 0; i < 32; ++i) { const int kk = 2 * i + (lane >> 5); scr[kk * 32 + (((lane & 31) + kk) & 31)] = v[i]; }
    asm volatile("s_waitcnt lgkmcnt(0)" ::: "memory");
    ti_emit(t, scr, lane);
}
constexpr int CVT_SMALL = 4 * 32 * 4 + (2 * 16 * 88 + 2 * 16 * 96) + 4 * 16 * 32, CVT_MOE_L = 32 * 3 * 16 * 32;
struct CvtPtrs { const float *cw1, *ewin, *owin, *ewout, *owout, *wg, *wu, *wd; unsigned char* ws; };
__device__ __forceinline__ TItem cvt_decode(const CvtPtrs& P, int it) {
    constexpr int IT_IN_E = 16 * 88, IT_IN_O = 16 * 96, IT_OUT = 16 * 32, IT_MOE = 16 * 32;
    constexpr int N_IN = 2 * IT_IN_E + 2 * IT_IN_O, N_OUT = 4 * IT_OUT, N_W1 = 4 * 32 * 4;
    unsigned char* ws = P.ws;
    TItem t; int r = it;
    if (r < N_W1) { const int m = r >> 7, kb = (r & 127) >> 2, nb = r & 3;
        t.W = P.cw1 + (size_t)m * 2048 * 128; t.ld = 128; t.K = 2048; t.WT = WSP(bf16, WS_W1T) + (size_t)m * 128 * 2048; t.drow0 = 32 * nb; t.k0 = 64 * kb; t.n0 = 32 * nb; return t; }
    r -= N_W1;
    if (r < N_IN) {
        int l; bool even;
        if (r < 2 * IT_IN_E) { const int e = r / IT_IN_E; r -= e * IT_IN_E; l = 2 * e; even = true; }
        else { r -= 2 * IT_IN_E; const int e = r / IT_IN_O; r -= e * IT_IN_O; l = 2 * e + 1; even = false; }
        const int nblk = even ? 88 : 96, kb = r / nblk, nb = r % nblk;
        t.W = even ? P.ewin + (size_t)(l >> 1) * D * EVEN_IN : P.owin + (size_t)(l >> 1) * D * ODD_IN; t.ld = even ? EVEN_IN : ODD_IN; t.K = D;
        t.WT = WSP(bf16, WS_WINT) + (size_t)l * 3072 * 1024; t.drow0 = 32 * nb; t.k0 = 64 * kb; t.n0 = 32 * nb; return t;
    }
    r -= N_IN;
    if (r < N_OUT) {
        const int l = r / IT_OUT; r -= l * IT_OUT; const int kb = r / 32, nb = r % 32;
        t.W = (l & 1) ? P.owout + (size_t)(l >> 1) * D * D : P.ewout + (size_t)(l >> 1) * D * D; t.ld = D; t.K = D;
        t.WT = WSP(bf16, WS_WOUTT) + (size_t)l * 1024 * 1024; t.drow0 = 32 * nb; t.k0 = 64 * kb; t.n0 = 32 * nb; return t;
    }
    r -= N_OUT;
    { const int le = r / (3 * IT_MOE); r -= le * 3 * IT_MOE; const int which = r / IT_MOE; r -= which * IT_MOE; const int kb = r / 32, nb = r % 32, n0 = 32 * nb;
      t.k0 = 64 * kb; t.n0 = n0;
      if (which < 2) { t.W = (which == 0 ? P.wg : P.wu) + (size_t)le * D * FF; t.ld = FF; t.K = D; t.WT = WSP(bf16, WS_WGUT) + (size_t)le * 2048 * 1024; t.drow0 = (n0 >> 7) * 256 + which * 128 + (n0 & 127); }
      else { t.W = P.wd + (size_t)le * FF * D; t.ld = D; t.K = FF; t.WT = WSP(bf16, WS_WDT) + (size_t)le * 1024 * 1024; t.drow0 = n0; } }
    return t;
}
__device__ __forceinline__ void p_convert(const Ctx& C0) {
    PHASE_PROLOG(C0);
    LAS float* scr = (LAS float*)(C.lds + 32768) + C.wave * 2048;
    CvtPtrs P; P.cw1 = INP(I_CW1); P.ewin = INP(I_EWIN); P.owin = INP(I_OWIN); P.ewout = INP(I_EWOUT); P.owout = INP(I_OWOUT); P.wg = INP(I_WG); P.wu = INP(I_WU); P.wd = INP(I_WD); P.ws = ws;
    constexpr int NITEMS = CVT_SMALL;
    int it = C.gw;
    if (it >= NITEMS) return;
    float va[32], vb[32];
    TItem ta = cvt_decode(P, it), tb = ta;
    ti_load(va, ta, C.lane);
    for (;;) {
        int nx = it + C.NGW; bool hb = nx < NITEMS;
        if (hb) { tb = cvt_decode(P, nx); ti_load(vb, tb, C.lane); }
        ti_store(va, ta, scr, C.lane);
        if (!hb) break;
        it = nx; nx = it + C.NGW; const bool ha = nx < NITEMS;
        if (ha) { ta = cvt_decode(P, nx); ti_load(va, ta, C.lane); }
        ti_store(vb, tb, scr, C.lane);
        if (!ha) break;
        it = nx;
    }
}

__device__ __forceinline__ void p_cmp(const Ctx& C0, int l) {
    PHASE_PROLOG(C0); const int e = l >> 1;
    const bf16* QKV = WSP(bf16, WS_QKV);
    LAS float* in = (LAS float*)C.lds;
    LAS float* red = in + 2048;
    LAS float* hid = red + 512;
    LAS float* red2 = hid + 128;
    if (blockIdx.x == 0) { for (int i = C.tid; i < 2 * NB * 2 * 64; i += NTHR) { const int kv2 = i / (NB * 2 * 64), r = i % (NB * 2 * 64), bb = r / 128, gd = r % 128;
        WSP(bf16, kv2 ? WS_VCMP : WS_KCMP)[((size_t)(bb * 256 + 255) * 2) * 64 + gd] = 0; } }
    for (int item = blockIdx.x; item < NB * NCMP * 2 * 2; item += gridDim.x) {
        const int kv = item & 1, g = (item >> 1) & 1, n = (item >> 2) % NCMP, b = (item >> 2) / NCMP;
        const float* pos = INP(I_CPOS) + ((size_t)e * 2 + kv) * 32 * 64;
        const float* w1 = INP(I_CW1) + ((size_t)e * 2 + kv) * 2048 * 128;
        const float* w2 = INP(I_CW2) + ((size_t)e * 2 + kv) * 128 * 64;
        const int col = (kv ? C_VC : C_KC) + g * 64;
        for (int i = C.tid; i < 2048; i += NTHR) { const int ll = i >> 6, dd = i & 63;
            in[i] = bf2f(QKV[(size_t)(b * S + 16 * n + ll) * QP + col + dd]) + pos[ll * 64 + dd]; }
        __syncthreads();
        { const int j = C.tid & 127, part = C.tid >> 7; float s = 0.f;
          for (int i = part * 512; i < part * 512 + 512; ++i) s += in[i] * w1[(size_t)i * 128 + j];
          red[part * 128 + j] = s; }
        __syncthreads();
        if (C.tid < 128) { const float s = red[C.tid] + red[128 + C.tid] + red[256 + C.tid] + red[384 + C.tid]; hid[C.tid] = s * sigmoidf_(s); }
        __syncthreads();
        { const int d = C.tid & 63, part = C.tid >> 6; float s = 0.f;
          for (int j = part * 16; j < part * 16 + 16; ++j) s += hid[j] * w2[j * 64 + d];
          red2[part * 64 + d] = s; }
        __syncthreads();
        if (C.tid < 64) { float s = 0.f;
#pragma unroll
            for (int p = 0; p < 8; ++p) s += red2[p * 64 + C.tid];
            bf16* dst = WSP(bf16, kv ? WS_VCMP : WS_KCMP);
            dst[((size_t)(b * 256 + n) * 2 + g) * 64 + C.tid] = (bf16)f2bf(s); }
        __syncthreads();
    }
}

__device__ __forceinline__ void p_cmp_mfma(const Ctx& C0, int l) {
    PHASE_PROLOG(C0); const int e = l >> 1;
    typedef short bf16x8 __attribute__((ext_vector_type(8)));
    const bf16* QKV = WSP(bf16, WS_QKV);
    LAS float* red = (LAS float*)C.lds;
    LAS float* hid = red + 8 * 16 * 128;
    const float* p_cw2 = INP(I_CW2);
    const int r = C.lane & 15, kg = C.lane >> 4;
    for (int u = blockIdx.x; u < 256; u += gridDim.x) {
        const int kv = u & 1, g = (u >> 1) & 1, b = (u >> 2) & 3, n0 = (u >> 4) * 16;
        const bf16* w1t = WSP(bf16, WS_W1T) + (size_t)(e * 2 + kv) * 128 * 2048;
        const int col = (kv ? C_VC : C_KC) + g * 64;
        const int n = n0 + r; const bool nvalid = n < NCMP;
        f32x4 acc[8];
#pragma unroll
        for (int j = 0; j < 8; ++j) acc[j] = (f32x4){0.f, 0.f, 0.f, 0.f};
#pragma unroll 2
        for (int ks = 0; ks < 8; ++ks) {
            const int ltok = 4 * C.wave + (ks >> 1), dd = (ks & 1) * 32 + kg * 8;
            bf16x8 a = (bf16x8){0, 0, 0, 0, 0, 0, 0, 0};
            if (nvalid) a = *(const bf16x8*)(QKV + (size_t)(b * S + 16 * n + ltok) * QP + col + dd);
            const int k0 = ltok * 64 + dd;
#pragma unroll
            for (int j = 0; j < 8; ++j) { const bf16x8 bb = *(const bf16x8*)(w1t + (size_t)(j * 16 + r) * 2048 + k0);
                acc[j] = __builtin_amdgcn_mfma_f32_16x16x32_bf16(a, bb, acc[j], 0, 0, 0); }
        }
#pragma unroll
        for (int j = 0; j < 8; ++j)
#pragma unroll
            for (int i = 0; i < 4; ++i) red[(C.wave * 16 + 4 * kg + i) * 128 + j * 16 + r] = acc[j][i];
        __syncthreads();
        const float* posb = WSP(float, WS_POSB) + (e * 2 + kv) * 128;
        for (int idx = C.tid; idx < 2048; idx += NTHR) { float s = posb[idx & 127];
#pragma unroll
            for (int w = 0; w < 8; ++w) s += red[(w * 16 + (idx >> 7)) * 128 + (idx & 127)];
            hid[idx] = s * sigmoidf_(s); }
        __syncthreads();
        { const int row = C.tid >> 5, d2 = (C.tid & 31) * 2; const float* w2 = p_cw2 + (size_t)(e * 2 + kv) * 128 * 64;
          float s0 = 0.f, s1 = 0.f;
#pragma unroll 8
          for (int j = 0; j < 128; ++j) { const float h = hid[row * 128 + j]; const float2 w = *(const float2*)(w2 + j * 64 + d2); s0 += h * w.x; s1 += h * w.y; }
          const int nn = n0 + row;
          bf16* dst = WSP(bf16, kv ? WS_VCMP : WS_KCMP) + ((size_t)(b * 256 + nn) * 2 + g) * 64 + d2;
          *(unsigned*)dst = (nn < NCMP) ? pk2(s0, s1) : 0u; }
        __syncthreads();
    }
}
__device__ __forceinline__ void p_scan(const Ctx& C0) {
    PHASE_PROLOG(C0);
    const float* GL = WSP(float, WS_GL); float* CUM = WSP(float, WS_CUMF);
    for (int item = C.gw; item < NB * 16; item += C.NGW) {
        const int b = item >> 4, h = item & 15;
        float loc = 0.f;
        for (int i = 0; i < 64; ++i) loc += GL[(size_t)(b * S + C.lane * 64 + i) * 32 + h];
        float inc = loc;
#pragma unroll
        for (int o = 1; o < 64; o <<= 1) { const float u = shl_(inc, C.lane - o); if (C.lane >= o) inc += u; }
        float run = inc - loc;
        for (int i = 0; i < 64; ++i) { run += GL[(size_t)(b * S + C.lane * 64 + i) * 32 + h]; CUM[(size_t)(b * S + C.lane * 64 + i) * 16 + h] = run; }
    }
}

template <int NO> struct RowState { float m, l; float o[NO]; };
template <int NO> __device__ __forceinline__ void rs_init(RowState<NO>& st) { st.m = NEGBIG; st.l = 0.f;
#pragma unroll
    for (int i = 0; i < NO; ++i) st.o[i] = 0.f; }
__device__ __forceinline__ float dot64(const LAS float* q, const bf16* krow) {
    float s = 0.f;
#pragma unroll
    for (int c = 0; c < 8; ++c) { const v4u u = *(const v4u*)(krow + c * 8); const LAS float* qq = q + c * 8;
        s += qq[0] * bf2f(u.x & 0xffffu) + qq[1] * bf2f(u.x >> 16) + qq[2] * bf2f(u.y & 0xffffu) + qq[3] * bf2f(u.y >> 16)
           + qq[4] * bf2f(u.z & 0xffffu) + qq[5] * bf2f(u.z >> 16) + qq[6] * bf2f(u.w & 0xffffu) + qq[7] * bf2f(u.w >> 16); }
    return s;
}
template <int NO> __device__ __forceinline__ void attn_chunk(RowState<NO>& st, float s, bool valid, const bf16* vbase, int vpitch, int lane) {
    const float cm = wave_max(valid ? s : NEGBIG);
    const float mnew = fmaxf(st.m, cm);
    const float p = valid ? __expf(s - mnew) : 0.f;
    const float f = __expf(st.m - mnew);
    st.l = st.l * f + wave_sum(p);
#pragma unroll
    for (int i = 0; i < NO; ++i) st.o[i] *= f;
    const unsigned long long act = __ballot(p != 0.f);
    if (act) {
        for (int j = 0; j < 64; ++j) {
            const float pj = shl_(p, j);
            if (pj != 0.f) {
#pragma unroll
                for (int i = 0; i < NO; ++i) st.o[i] += pj * bf2f(vbase[(size_t)j * vpitch + lane + 64 * i]);
            }
        }
    }
    st.m = mnew;
}

__device__ __forceinline__ void attn_diff_row(const Ctx& C0, int l, int item) {
    PHASE_PROLOG(C0); const int e = l >> 1;
    const bf16* QKV = WSP(bf16, WS_QKV); bf16* AO = WSP(bf16, WS_AO);
    LAS float* ql = (LAS float*)C.lds + C.wave * 1024;
    const int s = item % S, h = (item / S) & 3, b = item / (4 * S);
    const int t = b * S + s;
    const float slope = alibi4(h);
    const float lam_init = 0.8f - 0.6f * __expf(-0.3f * (float)l);
    float lam;
    { const float* lp = INP(I_DLAM) + e * 256; int tl0 = C.tid; asm volatile("" : "+v"(tl0)); const int ln0 = tl0 & 63; const float a1 = wave_sum(lp[ln0] * lp[64 + ln0]), a2 = wave_sum(lp[128 + ln0] * lp[192 + ln0]);
      lam = __uint_as_float(__builtin_amdgcn_readfirstlane(__float_as_uint(__expf(a1) - __expf(a2) + lam_init))); }
    float res[2];
    res[0] = 0.f; res[1] = 0.f;
#pragma unroll
    for (int c = 0; c < 2; ++c) {
        ql[C.lane] = 0.125f * bf2f(QKV[(size_t)t * QP + C_AQ + h * 128 + c * 64 + C.lane]);
        RowState<2> st; rs_init(st);
        for (int k0 = 0; k0 <= s; k0 += 64) {
            const int kp = k0 + C.lane; const bool valid = kp <= s;
            float sc = NEGBIG;
            if (valid) sc = dot64(ql, QKV + (size_t)(b * S + kp) * QP + C_AK + h * 128 + c * 64) - slope * (float)(s - kp);
            attn_chunk<2>(st, sc, valid, QKV + (size_t)(b * S + k0) * QP + C_AV + h * 128, QP, C.lane);
        }
        const float inv = 1.f / st.l, w = (c == 0) ? 1.f : -lam;
        res[0] += w * st.o[0] * inv; res[1] += w * st.o[1] * inv;
    }
    const float ms = wave_sum(res[0] * res[0] + res[1] * res[1]) * (1.f / 128.f);
    const float r = rsqrtf(ms + EPS) * (1.f - lam_init);
    const float* sg = INP(I_DSUB) + e * 128;
    AO[(size_t)t * D + h * 128 + C.lane] = (bf16)f2bf(res[0] * r * sg[C.lane]);
    AO[(size_t)t * D + h * 128 + 64 + C.lane] = (bf16)f2bf(res[1] * r * sg[64 + C.lane]);
}

__device__ __forceinline__ void attn_nsa_row(const Ctx& C0, int l, int item) {
    PHASE_PROLOG(C0);
    const bf16* QKV = WSP(bf16, WS_QKV); bf16* AO = WSP(bf16, WS_AO);
    const bf16* KC = WSP(bf16, WS_KCMP); const bf16* VC = WSP(bf16, WS_VCMP); const float* GL = WSP(float, WS_GL);
    LAS float* ql = (LAS float*)C.lds + C.wave * 1024;
    LAS float* pl = ql + 256;
    LAS float* ps = pl + 256;
    const int s = item % S, g = (item / S) & 1, b = item / (2 * S);
    const int t = b * S + s, lane = C.lane;
#pragma unroll
    for (int hg = 0; hg < 4; ++hg) ql[hg * 64 + lane] = 0.125f * bf2f(QKV[(size_t)t * QP + C_BQ + (g * 4 + hg) * 64 + lane]);
#pragma unroll
    for (int i = 0; i < 4; ++i) ps[lane + 64 * i] = 0.f;
    float out[4];
#pragma unroll
    for (int hg = 0; hg < 4; ++hg) {
        const float slope = alibi8(g * 4 + hg);
        float sc[4]; bool vd[4]; float mx = NEGBIG;
#pragma unroll
        for (int i = 0; i < 4; ++i) { const int n = lane + 64 * i; vd[i] = (n < NCMP) && (16 * n + 31 <= s); sc[i] = NEGBIG;
            if (vd[i]) sc[i] = dot64(ql + hg * 64, KC + ((size_t)(b * 256 + n) * 2 + g) * 64) - slope * (float)(s - (16 * n + 31));
            mx = fmaxf(mx, sc[i]); }
        mx = wave_max(mx);
        float p[4], sum = 0.f;
#pragma unroll
        for (int i = 0; i < 4; ++i) { p[i] = vd[i] ? __expf(sc[i] - mx) : 0.f; sum += p[i]; }
        sum = wave_sum(sum);
        const float inv = 1.f / fmaxf(sum, 1e-30f);
#pragma unroll
        for (int i = 0; i < 4; ++i) { p[i] *= inv; pl[lane + 64 * i] = p[i]; ps[lane + 64 * i] += p[i]; }
        float o = 0.f;
        const int nmax = (s >= 31) ? ((s - 31) >> 4) : -1;
        for (int n = 0; n <= nmax && n < NCMP; ++n) o += pl[n] * bf2f(VC[((size_t)(b * 256 + n) * 2 + g) * 64 + lane]);
        out[hg] = sigmoidf_(GL[(size_t)t * 32 + (g * 4 + hg) * 3 + 0]) * o;
    }
    const int cur = s >> 6;
    float imp = 0.f;
#pragma unroll
    for (int d = -1; d <= 3; ++d) { const int n = 4 * lane + d; if (n >= 0 && n < NCMP) imp += ps[n]; }
    const bool avail = lane <= cur, forced = (lane == 0) || (lane == cur) || (lane == cur - 1);
    const float score = avail ? imp + (forced ? 1e4f : 0.f) : NEGBIG;
    int rank = 0;
    for (int j = 0; j < 64; ++j) { const float sj = shl_(score, j); rank += (sj > score || (sj == score && j < lane)) ? 1 : 0; }
    const unsigned long long sel = __ballot(avail && rank < 16);
#pragma unroll
    for (int hg = 0; hg < 4; ++hg) {
        const float slope = alibi8(g * 4 + hg);
        RowState<1> st; rs_init(st);
        for (int j = 0; j <= cur; ++j) {
            if (!((sel >> j) & 1ull)) continue;
            const int kp = 64 * j + lane; const bool valid = kp <= s;
            float sc = NEGBIG;
            if (valid) sc = dot64(ql + hg * 64, QKV + (size_t)(b * S + kp) * QP + C_KS + g * 64) - slope * (float)(s - kp);
            attn_chunk<1>(st, sc, valid, QKV + (size_t)(b * S + 64 * j) * QP + C_VS + g * 64, QP, lane);
        }
        out[hg] += sigmoidf_(GL[(size_t)t * 32 + (g * 4 + hg) * 3 + 1]) * st.o[0] / fmaxf(st.l, 1e-30f);
    }
#pragma unroll
    for (int hg = 0; hg < 4; ++hg) {
        const float slope = alibi8(g * 4 + hg);
        RowState<1> st; rs_init(st);
        const int lo = (s - 511 > 0) ? ((s - 511) >> 6) : 0;
        for (int j = lo; j <= cur; ++j) {
            const int kp = 64 * j + lane; const bool valid = (kp <= s) && (s - kp < 512);
            float sc = NEGBIG;
            if (valid) sc = dot64(ql + hg * 64, QKV + (size_t)(b * S + kp) * QP + C_KW + g * 64) - slope * (float)(s - kp);
            attn_chunk<1>(st, sc, valid, QKV + (size_t)(b * S + 64 * j) * QP + C_VW + g * 64, QP, lane);
        }
        out[hg] += sigmoidf_(GL[(size_t)t * 32 + (g * 4 + hg) * 3 + 2]) * st.o[0] / fmaxf(st.l, 1e-30f);
    }
#pragma unroll
    for (int hg = 0; hg < 4; ++hg) AO[(size_t)t * D + 512 + (g * 4 + hg) * 64 + lane] = (bf16)f2bf(out[hg]);
}

__device__ __forceinline__ void attn_fox_row(const Ctx& C0, int item) {
    PHASE_PROLOG(C0);
    const bf16* QKV = WSP(bf16, WS_QKV); bf16* AO = WSP(bf16, WS_AO); const float* CUM = WSP(float, WS_CUMF);
    LAS float* ql = (LAS float*)C.lds + C.wave * 1024;
    const int s = item % S, h = (item / S) & 15, b = item / (16 * S);
    const int t = b * S + s;
    ql[C.lane] = 0.125f * bf2f(QKV[(size_t)t * QP + h * 64 + C.lane]);
    const float cq = CUM[(size_t)t * 16 + h];
    RowState<1> st; rs_init(st);
    for (int k0 = 0; k0 <= s; k0 += 64) {
        const int kp = k0 + C.lane; const bool valid = kp <= s;
        float sc = NEGBIG;
        if (valid) sc = dot64(ql, QKV + (size_t)(b * S + kp) * QP + 1024 + h * 64) + (cq - CUM[(size_t)(b * S + kp) * 16 + h]);
        attn_chunk<1>(st, sc, valid, QKV + (size_t)(b * S + k0) * QP + 2048 + h * 64, QP, C.lane);
    }
    AO[(size_t)t * D + h * 64 + C.lane] = (bf16)f2bf(st.o[0] / st.l);
}


namespace fa {
typedef float f32x16 __attribute__((ext_vector_type(16)));
typedef short bf16x8 __attribute__((ext_vector_type(8)));
typedef short s16x4 __attribute__((ext_vector_type(4)));
constexpr int KCH = 1040, KT = 8 * KCH, VDB = 4160;
constexpr float LOG2E = 1.4426950408889634f, QSCALE = 0.125f * LOG2E, THR = 20.f;
#define FA_NEG_INF (-__builtin_inff())
__device__ __forceinline__ int crow(int r, int hi) { return (r & 3) + 8 * (r >> 2) + 4 * hi; }
__device__ __forceinline__ unsigned cvtpk(float lo, float hi) { unsigned r; asm("v_cvt_pk_bf16_f32 %0, %1, %2" : "=v"(r) : "v"(lo), "v"(hi)); return r; }
__device__ __forceinline__ float swapmax(float m) { auto rr = __builtin_amdgcn_permlane32_swap(__float_as_uint(m), __float_as_uint(m), false, false); return fmaxf(__uint_as_float(rr[0]), __uint_as_float(rr[1])); }
__device__ __forceinline__ float swapsum(float m) { auto rr = __builtin_amdgcn_permlane32_swap(__float_as_uint(m), __float_as_uint(m), false, false); return __uint_as_float(rr[0]) + __uint_as_float(rr[1]); }
#define FA_SYNC() asm volatile("s_waitcnt lgkmcnt(0)\n\ts_barrier" ::: "memory")

template <int NK, int NVH> struct Stage { v4u k[NK]; v4u v[NVH]; };
template <int NK, int NVH> __device__ __forceinline__ void tile_issue(Stage<NK, NVH>& st, const bf16* K0, const bf16* K1, int kpitch, const bf16* V, int vpitch, int tid) {
    const int row = tid >> 3, c = tid & 7;
    st.k[0] = *(const v4u*)(K0 + (size_t)row * kpitch + c * 8);
    if constexpr (NK == 2) st.k[1] = *(const v4u*)(K1 + (size_t)row * kpitch + c * 8);
#pragma unroll
    for (int i = 0; i < NVH; ++i) st.v[i] = *(const v4u*)(V + (size_t)row * vpitch + (c + 8 * i) * 8);
}
template <int NK, int NVH> __device__ __forceinline__ void tile_commit(const Stage<NK, NVH>& st, LAS unsigned char* kbuf, LAS unsigned char* vbuf, int tid) {
    const int row = tid >> 3, c = tid & 7;
#pragma unroll
    for (int i = 0; i < NK; ++i) *(LAS v4u*)(kbuf + i * KT + c * KCH + row * 16) = st.k[i];
#pragma unroll
    for (int i = 0; i < NVH; ++i) { const int c16 = c + 8 * i; *(LAS v4u*)(vbuf + (c16 >> 2) * VDB + row * 64 + (c16 & 3) * 16) = st.v[i]; }
}
__device__ __forceinline__ void load_q(bf16x8 (&qr)[4], const bf16* qrow, int hi) {
#pragma unroll
    for (int d0 = 0; d0 < 4; ++d0) { const v4u u = *(const v4u*)(qrow + d0 * 16 + hi * 8);
        v4u w;
        w.x = cvtpk(bf2f(u.x & 0xffffu) * QSCALE, bf2f(u.x >> 16) * QSCALE); w.y = cvtpk(bf2f(u.y & 0xffffu) * QSCALE, bf2f(u.y >> 16) * QSCALE);
        w.z = cvtpk(bf2f(u.z & 0xffffu) * QSCALE, bf2f(u.z >> 16) * QSCALE); w.w = cvtpk(bf2f(u.w & 0xffffu) * QSCALE, bf2f(u.w >> 16) * QSCALE);
        qr[d0] = __builtin_bit_cast(bf16x8, w); }
}
template <int NDB> __device__ __forceinline__ void pv_step(f32x16 (&o)[NDB], const LAS unsigned char* vt, int lane, const bf16x8 (&pa)[4]) {
    typedef short v4i16_t __attribute__((ext_vector_type(4)));
    const int hi = lane >> 5;
    const LAS unsigned char* vb = vt + ((lane >> 4) & 1) * 32 + (lane & 3) * 8 + (4 * hi + ((lane & 15) >> 2)) * 64;
#pragma unroll
    for (int dp = 0; dp < NDB; dp += 2) {
        s16x4 lo[2][4], h4[2][4];
#pragma unroll
        for (int dd = 0; dd < 2; ++dd)
#pragma unroll
            for (int ks = 0; ks < 4; ++ks) {
                lo[dd][ks] = __builtin_bit_cast(s16x4, __builtin_amdgcn_ds_read_tr16_b64_v4i16((LAS v4i16_t*)(vb + (dp + dd) * VDB + ks * 1024)));
                h4[dd][ks] = __builtin_bit_cast(s16x4, __builtin_amdgcn_ds_read_tr16_b64_v4i16((LAS v4i16_t*)(vb + (dp + dd) * VDB + ks * 1024 + 512))); }
        __builtin_amdgcn_sched_barrier(0);
#pragma unroll
        for (int ks = 0; ks < 4; ++ks)
#pragma unroll
            for (int dd = 0; dd < 2; ++dd) {
                const bf16x8 B = (bf16x8){lo[dd][ks][0], lo[dd][ks][1], lo[dd][ks][2], lo[dd][ks][3], h4[dd][ks][0], h4[dd][ks][1], h4[dd][ks][2], h4[dd][ks][3]};
                o[dp + dd] = __builtin_amdgcn_mfma_f32_32x32x16_bf16(pa[ks], B, o[dp + dd], 0, 0, 0); }
    }
}
__device__ __forceinline__ void qk_tile(f32x16& p0, f32x16& p1, const bf16x8 (&qr)[4], const LAS unsigned char* kt, int lane) {
    const LAS unsigned char* kb = kt + (lane >> 5) * KCH + (lane & 31) * 16;
    p0 = (f32x16){0.f, 0.f, 0.f, 0.f, 0.f, 0.f, 0.f, 0.f, 0.f, 0.f, 0.f, 0.f, 0.f, 0.f, 0.f, 0.f}; p1 = p0;
#pragma unroll
    for (int d0 = 0; d0 < 4; ++d0) {
        const bf16x8 b0 = *(const LAS bf16x8*)(kb + d0 * 2 * KCH), b1 = *(const LAS bf16x8*)(kb + d0 * 2 * KCH + 512);
        p0 = __builtin_amdgcn_mfma_f32_32x32x16_bf16(b0, qr[d0], p0, 0, 0, 0);
        p1 = __builtin_amdgcn_mfma_f32_32x32x16_bf16(b1, qr[d0], p1, 0, 0, 0);
    }
}
__device__ __forceinline__ float max3f(float a, float b, float c) { return __builtin_fmaxf(__builtin_fmaxf(a, b), c); }
__device__ __forceinline__ float rowmax32(const f32x16& p0, const f32x16& p1) {
    float a = max3f(p0[0], p0[1], p1[0]), b = max3f(p0[2], p0[3], p1[1]);
    a = max3f(a, p1[2], p1[3]);
#pragma unroll
    for (int r = 4; r < 16; r += 4) { a = max3f(a, p0[r], p0[r + 1]); b = max3f(b, p0[r + 2], p0[r + 3]); a = max3f(a, p1[r], p1[r + 1]); b = max3f(b, p1[r + 2], p1[r + 3]); }
    return __builtin_fmaxf(a, b);
}
template <int NDB> __device__ __forceinline__ void softmax_pv(float& mhat, float& lsum, f32x16 (&o)[NDB], f32x16& p0, f32x16& p1, float off, float ladj, const LAS unsigned char* vt, LAS float* wsf, int lane) {
    const int r32 = lane & 31, hi = lane >> 5;
    typedef short v4i16_t __attribute__((ext_vector_type(4)));
    s16x4 vlo[2][4], vh4[2][4];
    if constexpr (NDB == 2) {
        const LAS unsigned char* vb = vt + ((lane >> 4) & 1) * 32 + (lane & 3) * 8 + (4 * hi + ((lane & 15) >> 2)) * 64;
#pragma unroll
        for (int dd = 0; dd < 2; ++dd)
#pragma unroll
            for (int ks = 0; ks < 4; ++ks) {
                vlo[dd][ks] = __builtin_bit_cast(s16x4, __builtin_amdgcn_ds_read_tr16_b64_v4i16((LAS v4i16_t*)(vb + dd * VDB + ks * 1024)));
                vh4[dd][ks] = __builtin_bit_cast(s16x4, __builtin_amdgcn_ds_read_tr16_b64_v4i16((LAS v4i16_t*)(vb + dd * VDB + ks * 1024 + 512))); }
        __builtin_amdgcn_sched_barrier(0);
    }
    const float rm = swapmax(rowmax32(p0, p1) + ladj);
    float mloc = mhat - off;
    if (__any(rm > mloc + THR)) {
        const float mnew = fmaxf(mloc, rm);
        const float f = __builtin_amdgcn_exp2f(mloc - mnew);
        lsum *= f; mloc = mnew; mhat = mnew + off;
        if (hi == 0) wsf[r32] = f;
        asm volatile("s_waitcnt lgkmcnt(0)" ::: "memory");
#pragma unroll
        for (int g = 0; g < 4; ++g) { const f32x4 fv = *(const LAS f32x4*)(wsf + 8 * g + 4 * hi);
#pragma unroll
            for (int d0 = 0; d0 < NDB; ++d0) { o[d0][4 * g] *= fv.x; o[d0][4 * g + 1] *= fv.y; o[d0][4 * g + 2] *= fv.z; o[d0][4 * g + 3] *= fv.w; } }
    }
    float sacc = 0.f;
    const float ml = mloc - ladj;
#pragma unroll
    for (int r = 0; r < 16; ++r) { p0[r] = __builtin_amdgcn_exp2f(p0[r] - ml); p1[r] = __builtin_amdgcn_exp2f(p1[r] - ml); sacc += p0[r] + p1[r]; }
    lsum += sacc;
    bf16x8 pa[4];
    { v4u w;
      w.x = cvtpk(p0[0], p0[1]); w.y = cvtpk(p0[2], p0[3]); w.z = cvtpk(p0[4], p0[5]); w.w = cvtpk(p0[6], p0[7]); pa[0] = __builtin_bit_cast(bf16x8, w);
      w.x = cvtpk(p0[8], p0[9]); w.y = cvtpk(p0[10], p0[11]); w.z = cvtpk(p0[12], p0[13]); w.w = cvtpk(p0[14], p0[15]); pa[1] = __builtin_bit_cast(bf16x8, w);
      w.x = cvtpk(p1[0], p1[1]); w.y = cvtpk(p1[2], p1[3]); w.z = cvtpk(p1[4], p1[5]); w.w = cvtpk(p1[6], p1[7]); pa[2] = __builtin_bit_cast(bf16x8, w);
      w.x = cvtpk(p1[8], p1[9]); w.y = cvtpk(p1[10], p1[11]); w.z = cvtpk(p1[12], p1[13]); w.w = cvtpk(p1[14], p1[15]); pa[3] = __builtin_bit_cast(bf16x8, w); }
    if constexpr (NDB == 2) {
#pragma unroll
        for (int ks = 0; ks < 4; ++ks)
#pragma unroll
            for (int dd = 0; dd < 2; ++dd) {
                const bf16x8 B = (bf16x8){vlo[dd][ks][0], vlo[dd][ks][1], vlo[dd][ks][2], vlo[dd][ks][3], vh4[dd][ks][0], vh4[dd][ks][1], vh4[dd][ks][2], vh4[dd][ks][3]};
                o[dd] = __builtin_amdgcn_mfma_f32_32x32x16_bf16(pa[ks], B, o[dd], 0, 0, 0); }
    } else pv_step<NDB>(o, vt, lane, pa);
}
template <int NDB> __device__ __forceinline__ void finish_rows(float lsum, f32x16 (&o)[NDB], LAS float* wsf, int lane, float rowscale) {
    const int r32 = lane & 31, hi = lane >> 5;
    const float l = swapsum(lsum);
    if (hi == 0) wsf[32 + r32] = rowscale / fmaxf(l, 1e-30f);
    asm volatile("s_waitcnt lgkmcnt(0)" ::: "memory");
#pragma unroll
    for (int g = 0; g < 4; ++g) { const f32x4 fv = *(const LAS f32x4*)(wsf + 32 + 8 * g + 4 * hi);
#pragma unroll
        for (int d0 = 0; d0 < NDB; ++d0) { o[d0][4 * g] *= fv.x; o[d0][4 * g + 1] *= fv.y; o[d0][4 * g + 2] *= fv.z; o[d0][4 * g + 3] *= fv.w; } }
}
__device__ __forceinline__ void store_rows64(const f32x16 (&o)[2], LAS bf16* stg, bf16* gdst, int pitch, int lane) {
    const int d = lane & 31, hi = lane >> 5;
#pragma unroll
    for (int r = 0; r < 16; ++r) { const int row = crow(r, hi); stg[row * 64 + d] = (bf16)f2bf(o[0][r]); stg[row * 64 + 32 + d] = (bf16)f2bf(o[1][r]); }
    asm volatile("s_waitcnt lgkmcnt(0)" ::: "memory");
#pragma unroll
    for (int i = 0; i < 4; ++i) { const int row = i * 8 + (lane >> 3), ch = lane & 7; *(v4u*)(gdst + (size_t)row * pitch + ch * 8) = *(const LAS v4u*)(stg + row * 64 + ch * 8); }
    asm volatile("s_waitcnt lgkmcnt(0)" ::: "memory");
}


template <int NDB, int NK, bool FOX> struct RunCfg {
    LAS unsigned char* lds; int KOFF, VOFF, COFF;
    const bf16* Kg0; const bf16* Kg1; const bf16* Vg; int pitch;
    const float* cg; const LAS float* pre;
    int ksel;
    float slope2; int qw0; int low; bool slc; unsigned long long mysel;
};
template <int NK, int NVH> struct Stage2 { v4u k[NK]; v4u v[NVH]; float ck; };

template <int NDB, int NK, bool FOX> __device__ __forceinline__ void st_issue_k(Stage2<NK, NDB / 2>& st, const RunCfg<NDB, NK, FOX>& R, int j, int tid) {
    const int row = tid >> 3, c = tid & 7;
    st.k[0] = *(const v4u*)(R.Kg0 + (size_t)(64 * j + row) * R.pitch + c * 8);
    if constexpr (NK == 2) st.k[1] = *(const v4u*)(R.Kg1 + (size_t)(64 * j + row) * R.pitch + c * 8);
    if constexpr (FOX) { if (tid < 64) st.ck = (R.cg[(size_t)(64 * j + tid) * 16] + R.pre[j]) * LOG2E; }
}
template <int NDB, int NK, bool FOX> __device__ __forceinline__ void st_commit_k(const Stage2<NK, NDB / 2>& st, const RunCfg<NDB, NK, FOX>& R, int slot, int tid) {
    const int row = tid >> 3, c = tid & 7;
#pragma unroll
    for (int i = 0; i < NK; ++i) *(LAS v4u*)(R.lds + R.KOFF + (slot * NK + i) * KT + c * KCH + row * 16) = st.k[i];
    if constexpr (FOX) { if (tid < 64) ((LAS float*)(R.lds + R.COFF))[slot * 64 + tid] = st.ck; }
}
template <int NDB, int NK, bool FOX> __device__ __forceinline__ void st_issue_v(Stage2<NK, NDB / 2>& st, const RunCfg<NDB, NK, FOX>& R, int j, int tid) {
    const int row = tid >> 3, c = tid & 7;
#pragma unroll
    for (int i = 0; i < NDB / 2; ++i) st.v[i] = *(const v4u*)(R.Vg + (size_t)(64 * j + row) * R.pitch + (c + 8 * i) * 8);
}
template <int NDB, int NK, bool FOX> __device__ __forceinline__ void st_commit_v(const Stage2<NK, NDB / 2>& st, const RunCfg<NDB, NK, FOX>& R, int slot, int tid) {
    const int row = tid >> 3, c = tid & 7;
#pragma unroll
    for (int i = 0; i < NDB / 2; ++i) { const int c16 = c + 8 * i; *(LAS v4u*)(R.lds + R.VOFF + slot * NDB * VDB + (c16 >> 2) * VDB + row * 64 + (c16 & 3) * 16) = st.v[i]; }
}
template <int NDB, int NK, bool FOX> __device__ __forceinline__ bool rt_part(const RunCfg<NDB, NK, FOX>& R, int j) {
    if (j > (R.qw0 >> 6)) return false;
    if (R.slc) return __any(((R.mysel >> j) & 1ull) != 0ull) != 0;
    return true;
}
template <int NDB, int NK, bool FOX> __device__ __forceinline__ void rt_qk(f32x16& p0, f32x16& p1, const RunCfg<NDB, NK, FOX>& R, int j, int slot, float mhat, const bf16x8 (&qr)[4], int lane) {
    const int hi = lane >> 5;
    const LAS unsigned char* kb = R.lds + R.KOFF + (slot * NK + R.ksel) * KT + hi * KCH + (lane & 31) * 16;
    bf16x8 kf[8];
#pragma unroll
    for (int d0 = 0; d0 < 4; ++d0) { kf[2 * d0] = *(const LAS bf16x8*)(kb + d0 * 2 * KCH); kf[2 * d0 + 1] = *(const LAS bf16x8*)(kb + d0 * 2 * KCH + 512); }
    typedef float f32x2 __attribute__((ext_vector_type(2)));
    if constexpr (FOX) {
        const LAS float* ck = (const LAS float*)(R.lds + R.COFF) + slot * 64; const f32x4 nm = (f32x4){-mhat, -mhat, -mhat, -mhat};
#pragma unroll
        for (int g = 0; g < 4; ++g) { const f32x4 c0 = nm - *(const LAS f32x4*)(ck + 8 * g + 4 * hi), c1 = nm - *(const LAS f32x4*)(ck + 32 + 8 * g + 4 * hi);
            p0[4 * g] = c0.x; p0[4 * g + 1] = c0.y; p0[4 * g + 2] = c0.z; p0[4 * g + 3] = c0.w;
            p1[4 * g] = c1.x; p1[4 * g + 1] = c1.y; p1[4 * g + 2] = c1.z; p1[4 * g + 3] = c1.w; }
    } else {
        const float base = R.slope2 * (float)(64 * j + 4 * hi - (R.qw0 + (lane & 31))) - mhat;
        const float s = R.slope2;
        const f32x2 k2 = (f32x2){2.f * s, 2.f * s}, k8 = (f32x2){8.f * s, 8.f * s}, k32 = (f32x2){32.f * s, 32.f * s};
        f32x2 a = (f32x2){base, base + s};
#pragma unroll
        for (int g = 0; g < 4; ++g) { const f32x2 b2 = a + k2, c = a + k32, d2 = b2 + k32;
            p0[4 * g] = a.x; p0[4 * g + 1] = a.y; p0[4 * g + 2] = b2.x; p0[4 * g + 3] = b2.y;
            p1[4 * g] = c.x; p1[4 * g + 1] = c.y; p1[4 * g + 2] = d2.x; p1[4 * g + 3] = d2.y;
            a = a + k8; }
    }
#pragma unroll
    for (int d0 = 0; d0 < 4; ++d0) {
        p0 = __builtin_amdgcn_mfma_f32_32x32x16_bf16(kf[2 * d0], qr[d0], p0, 0, 0, 0);
        p1 = __builtin_amdgcn_mfma_f32_32x32x16_bf16(kf[2 * d0 + 1], qr[d0], p1, 0, 0, 0);
    }
}
template <int NDB, int NK, bool FOX> __device__ __forceinline__ void rt_mask(f32x16& p0, f32x16& p1, const RunCfg<NDB, NK, FOX>& R, int j, int lane) {
    const int hi = lane >> 5, qrel = R.qw0 + (lane & 31) - 64 * j;
    if (j == (R.qw0 >> 6)) {
#pragma unroll
        for (int r = 0; r < 16; ++r) { const int kvl = crow(r, hi); if (kvl > qrel) p0[r] = FA_NEG_INF; if (kvl + 32 > qrel) p1[r] = FA_NEG_INF; }
    }
    if (j == R.low) {
#pragma unroll
        for (int r = 0; r < 16; ++r) { const int kvl = crow(r, hi); if (kvl <= qrel - 512) p0[r] = FA_NEG_INF; if (kvl + 32 <= qrel - 512) p1[r] = FA_NEG_INF; }
    }
    if (R.slc) {
        if (((R.mysel >> j) & 1ull) == 0ull) {
#pragma unroll
            for (int r = 0; r < 16; ++r) { p0[r] = FA_NEG_INF; p1[r] = FA_NEG_INF; }
        }
    }
}
template <int NDB> __device__ __forceinline__ void rt_softmax_pv(float& mhat, float& st, float& lsum, f32x16 (&o)[NDB], f32x16& s0, f32x16& s1, bool has_next, f32x16& n0, f32x16& n1,
                                                                 const LAS unsigned char* vt, LAS float* wsf, int lane) {
    const int r32 = lane & 31, hi = lane >> 5;
    const float rm = swapmax(rowmax32(s0, s1));
    const bool fresh = (st == 0.f), live = rm > FA_NEG_INF;
    const bool trig = (rm > THR) || (fresh && live);
    if (__any(trig)) {
        const float d = trig ? (fresh ? rm : fmaxf(rm, 0.f)) : 0.f;
        const float f = fresh ? 1.f : __builtin_amdgcn_exp2f(-d);
        mhat += d; lsum *= f; st = live ? 1.f : st;
#pragma unroll
        for (int r = 0; r < 16; ++r) { s0[r] -= d; s1[r] -= d; }
        if (has_next) {
#pragma unroll
            for (int r = 0; r < 16; ++r) { n0[r] -= d; n1[r] -= d; }
        }
        if (hi == 0) wsf[r32] = f;
        asm volatile("s_waitcnt lgkmcnt(0)" ::: "memory");
#pragma unroll
        for (int g = 0; g < 4; ++g) { const f32x4 fv = *(const LAS f32x4*)(wsf + 8 * g + 4 * hi);
#pragma unroll
            for (int d0 = 0; d0 < NDB; ++d0) { o[d0][4 * g] *= fv.x; o[d0][4 * g + 1] *= fv.y; o[d0][4 * g + 2] *= fv.z; o[d0][4 * g + 3] *= fv.w; } }
    }
    typedef float f32x2 __attribute__((ext_vector_type(2)));
    f32x2 sa = (f32x2){0.f, 0.f}, sb = (f32x2){0.f, 0.f};
#pragma unroll
    for (int r = 0; r < 16; r += 2) { s0[r] = __builtin_amdgcn_exp2f(s0[r]); s0[r + 1] = __builtin_amdgcn_exp2f(s0[r + 1]); s1[r] = __builtin_amdgcn_exp2f(s1[r]); s1[r + 1] = __builtin_amdgcn_exp2f(s1[r + 1]);
        sa = sa + (f32x2){s0[r], s0[r + 1]}; sb = sb + (f32x2){s1[r], s1[r + 1]}; }
    sa = sa + sb;
    lsum += sa.x + sa.y;
    bf16x8 pa[4];
    { v4u w;
      w.x = cvtpk(s0[0], s0[1]); w.y = cvtpk(s0[2], s0[3]); w.z = cvtpk(s0[4], s0[5]); w.w = cvtpk(s0[6], s0[7]); pa[0] = __builtin_bit_cast(bf16x8, w);
      w.x = cvtpk(s0[8], s0[9]); w.y = cvtpk(s0[10], s0[11]); w.z = cvtpk(s0[12], s0[13]); w.w = cvtpk(s0[14], s0[15]); pa[1] = __builtin_bit_cast(bf16x8, w);
      w.x = cvtpk(s1[0], s1[1]); w.y = cvtpk(s1[2], s1[3]); w.z = cvtpk(s1[4], s1[5]); w.w = cvtpk(s1[6], s1[7]); pa[2] = __builtin_bit_cast(bf16x8, w);
      w.x = cvtpk(s1[8], s1[9]); w.y = cvtpk(s1[10], s1[11]); w.z = cvtpk(s1[12], s1[13]); w.w = cvtpk(s1[14], s1[15]); pa[3] = __builtin_bit_cast(bf16x8, w); }
    pv_step<NDB>(o, vt, lane, pa);
}
struct RunState { int j0, j1, j2; unsigned long long rem; int ks0, ks1, ks2, vs0; bool c0; };
__device__ __forceinline__ int rs_pop(unsigned long long& rem) { if (!rem) return -1; const int j = __builtin_ctzll(rem); rem &= rem - 1; return j; }
template <int NDB, int NK, bool FOX> __device__ __forceinline__ bool rt_step(RunState& T, Stage2<NK, NDB / 2>& stg, const RunCfg<NDB, NK, FOX>& R, int tid,
        const bf16x8 (&qr)[4], float& mhat, float& st, float& lsum, f32x16 (&o)[NDB], f32x16& c0, f32x16& c1, f32x16& n0, f32x16& n1, LAS float* wsf) {
    const int lane = tid & 63;
    const bool pn = (T.j1 >= 0) && rt_part(R, T.j1);
    if (pn) rt_qk(n0, n1, R, T.j1, T.ks1, mhat, qr, lane);
    if (T.c0) { rt_mask(c0, c1, R, T.j0, lane);
        rt_softmax_pv<NDB>(mhat, st, lsum, o, c0, c1, pn, n0, n1, R.lds + R.VOFF + T.vs0 * NDB * VDB, wsf, lane); }
    if (T.j1 < 0) { FA_SYNC(); return false; }
    if (T.j2 >= 0) st_commit_k(stg, R, T.ks2, tid);
    st_commit_v(stg, R, T.vs0 ^ 1, tid);
    const int j3 = rs_pop(T.rem);
    if (j3 >= 0) st_issue_k(stg, R, j3, tid);
    if (T.j2 >= 0) st_issue_v(stg, R, T.j2, tid);
    FA_SYNC();
    T.j0 = T.j1; T.j1 = T.j2; T.j2 = j3; const int s = T.ks0; T.ks0 = T.ks1; T.ks1 = T.ks2; T.ks2 = s; T.vs0 ^= 1; T.c0 = pn;
    return true;
}
template <int NDB, int NK, bool FOX> __device__ __forceinline__ void run_tiles(const RunCfg<NDB, NK, FOX>& R, int tid, unsigned long long tiles,
        const bf16x8 (&qr)[4], float& mhat, float& st, float& lsum, f32x16 (&o)[NDB], LAS float* wsf) {
    const int lane = tid & 63;
    Stage2<NK, NDB / 2> stg; stg.ck = 0.f;
    RunState T; T.rem = tiles; T.ks0 = 0; T.ks1 = 1; T.ks2 = 2; T.vs0 = 0;
    T.j0 = rs_pop(T.rem);
    st_issue_k(stg, R, T.j0, tid); st_issue_v(stg, R, T.j0, tid);
    st_commit_k(stg, R, 0, tid); st_commit_v(stg, R, 0, tid);
    T.j1 = rs_pop(T.rem);
    if (T.j1 >= 0) { st_issue_k(stg, R, T.j1, tid); st_commit_k(stg, R, 1, tid); st_issue_v(stg, R, T.j1, tid); }
    T.j2 = rs_pop(T.rem);
    if (T.j2 >= 0) st_issue_k(stg, R, T.j2, tid);
    FA_SYNC();
    f32x16 a0, a1, b0, b1;
    T.c0 = rt_part(R, T.j0);
    if (T.c0) rt_qk(a0, a1, R, T.j0, 0, mhat, qr, lane);
    for (;;) {
        if (!rt_step(T, stg, R, tid, qr, mhat, st, lsum, o, a0, a1, b0, b1, wsf)) break;
        if (!rt_step(T, stg, R, tid, qr, mhat, st, lsum, o, b0, b1, a0, a1, wsf)) break;
    }
}

struct CvtRide { TItem t; int it, hi, step; bool full; const float* wg; const float* wu; const float* wd; unsigned char* ws; LAS float* scr; };
__device__ __forceinline__ TItem ride_decode(const CvtRide& Cv, int r) {
    constexpr int IT_MOE = 16 * 32; unsigned char* ws = Cv.ws; TItem t;
    const int le = r / (3 * IT_MOE); r -= le * 3 * IT_MOE; const int which = r / IT_MOE; r -= which * IT_MOE; const int kb = r / 32, nb = r % 32, n0 = 32 * nb;
    t.k0 = 64 * kb; t.n0 = n0;
    if (which < 2) { t.W = (which == 0 ? Cv.wg : Cv.wu) + (size_t)le * D * FF; t.ld = FF; t.K = D; t.WT = WSP(bf16, WS_WGUT) + (size_t)le * 2048 * 1024; t.drow0 = (n0 >> 7) * 256 + which * 128 + (n0 & 127); }
    else { t.W = Cv.wd + (size_t)le * FF * D; t.ld = D; t.K = FF; t.WT = WSP(bf16, WS_WDT) + (size_t)le * 1024 * 1024; t.drow0 = n0; }
    return t;
}
__device__ __forceinline__ void ride_emit(const TItem& t, const LAS float* scr, int lane) {
    const int n = lane & 31, ch = lane >> 5;
#pragma unroll
    for (int jj = 0; jj < 4; ++jj) { const int c = 2 * jj + ch;
        float s[8];
#pragma unroll
        for (int q = 0; q < 8; ++q) s[q] = scr[(8 * c + q) * 32 + n];
        v4u o; o.x = pg8::cvt_pk_bf16(s[0], s[1]); o.y = pg8::cvt_pk_bf16(s[2], s[3]); o.z = pg8::cvt_pk_bf16(s[4], s[5]); o.w = pg8::cvt_pk_bf16(s[6], s[7]);
        *(v4u*)(t.WT + (size_t)(t.drow0 + n) * t.K + t.k0 + 8 * c) = o; }
    asm volatile("s_waitcnt lgkmcnt(0)" ::: "memory");
}
__device__ __forceinline__ void ride_finish(CvtRide& Cv, int lane) {
    if (Cv.full) { asm volatile("s_waitcnt vmcnt(0)" ::: "memory"); ride_emit(Cv.t, Cv.scr, lane); Cv.full = false; }
}
__device__ __forceinline__ void ride_finish2(CvtRide& Cv, int lane) {
    if (Cv.full) { asm volatile("s_waitcnt vmcnt(2)" ::: "memory"); ride_emit(Cv.t, Cv.scr, lane); Cv.full = false; }
}
__device__ __forceinline__ void ride_start(CvtRide& Cv, int lane) {
    if (!Cv.full && Cv.it < Cv.hi) {
        Cv.t = ride_decode(Cv, Cv.it); Cv.it += Cv.step; Cv.full = true;
        const __amdgpu_buffer_rsrc_t rs = __builtin_amdgcn_make_buffer_rsrc((void*)(Cv.t.W + (size_t)Cv.t.k0 * Cv.t.ld + Cv.t.n0), (short)0, 64 * Cv.t.ld * 4, 0x00020000);
        int ln = lane; asm volatile("" : "+v"(ln));
        const int voff = ((ln >> 3) * Cv.t.ld + (ln & 7) * 4) * 4;
#pragma unroll
        for (int i = 0; i < 8; ++i) __builtin_amdgcn_raw_ptr_buffer_load_lds(rs, (LAS void*)(Cv.scr + i * 256), 16, voff, i * 8 * Cv.t.ld * 4, 0, 0);
    }
}
constexpr int FX_KB = 0, FX_VB = 2 * KT, FX_CK = FX_VB + 2 * 2 * VDB, FX_WSF = FX_CK + 512, FX_OST = FX_WSF + 8 * 256, FX_PRE = FX_OST + 8 * 4096, FX_FLG = FX_PRE + 256, FX_END = FX_FLG + 128;
constexpr float PRUNE = 40.f;
__device__ __forceinline__ void fox_unit(LAS unsigned char* lds, int tid_in, int b, int h, int qt, const bf16* QKV, const float* CUM, const float* CHTOT, bf16* AO, float knmax, CvtRide& Cv) {
    int tid = tid_in; asm volatile("" : "+v"(tid));
    const int lane = tid & 63, wid = __builtin_amdgcn_readfirstlane(tid >> 6), r32 = lane & 31, hi = lane >> 5;
    const int q0 = qt * 256, qw0 = q0 + wid * 32, NT = 4 * (qt + 1), dg = qw0 >> 6;
    const bf16* Kg = QKV + (size_t)(b * S) * QP + 1024 + h * 64;
    const bf16* Vg = QKV + (size_t)(b * S) * QP + 2048 + h * 64;
    const float* cg = CUM + (size_t)(b * S) * 16 + h;
    LAS float* wsf = (LAS float*)(lds + FX_WSF) + wid * 64;
    LAS float* pre = (LAS float*)(lds + FX_PRE);
    LAS int* flg = (LAS int*)(lds + FX_FLG);
    if (wid == 0) {
        const float val = (lane < NT) ? CHTOT[(size_t)(b * 64 + lane) * 16 + h] : 0.f; float inc = val;
#pragma unroll
        for (int o = 1; o < 64; o <<= 1) { const float u = shl_(inc, lane - o); if (lane >= o) inc += u; }
        pre[lane] = inc - val;
    }
    bf16x8 qr[4]; load_q(qr, QKV + (size_t)(b * S + qw0 + r32) * QP + h * 64, hi);
    float ub;
    { float s2 = 0.f;
#pragma unroll
      for (int d0 = 0; d0 < 4; ++d0) { const v4u u = __builtin_bit_cast(v4u, qr[d0]);
          const float a0 = bf2f(u.x & 0xffffu), a1 = bf2f(u.x >> 16), a2 = bf2f(u.y & 0xffffu), a3 = bf2f(u.y >> 16), a4 = bf2f(u.z & 0xffffu), a5 = bf2f(u.z >> 16), a6 = bf2f(u.w & 0xffffu), a7 = bf2f(u.w >> 16);
          s2 += (a0 * a0 + a1 * a1) + (a2 * a2 + a3 * a3) + (a4 * a4 + a5 * a5) + (a6 * a6 + a7 * a7); }
      ub = sqrtf(swapsum(s2)) * knmax * 1.01f + 0.01f; }
    float mhat = NEGBIG, lsum = 0.f; f32x16 o[2];
#pragma unroll
    for (int i = 0; i < 16; ++i) { o[0][i] = 0.f; o[1][i] = 0.f; }
    FA_SYNC();
    Stage<1, 1> st; float ckv = 0.f;
    { const int j = NT - 1; tile_issue<1, 1>(st, Kg + (size_t)(64 * j) * QP, Kg, QP, Vg + (size_t)(64 * j) * QP, QP, tid); if (tid < 64) ckv = (cg[(size_t)(64 * j + tid) * 16] + pre[j]) * LOG2E; }
    tile_commit<1, 1>(st, lds + FX_KB, lds + FX_VB, tid); if (tid < 64) ((LAS float*)(lds + FX_CK))[tid] = ckv;
    { const int j = NT - 2; tile_issue<1, 1>(st, Kg + (size_t)(64 * j) * QP, Kg, QP, Vg + (size_t)(64 * j) * QP, QP, tid); if (tid < 64) ckv = (cg[(size_t)(64 * j + tid) * 16] + pre[j]) * LOG2E; }
    FA_SYNC();
    bool mine = true;
    for (int i = 0;; ++i) {
        const int j = NT - 1 - i, kv0 = j * 64, bsel = i & 1;
        if (j == dg || (j < dg && mine)) {
            const LAS unsigned char* kt = lds + FX_KB + bsel * KT; const LAS unsigned char* vt = lds + FX_VB + bsel * 2 * VDB;
            const LAS float* ck = (const LAS float*)(lds + FX_CK) + bsel * 64;
            f32x16 p0, p1; qk_tile(p0, p1, qr, kt, lane);
#pragma unroll
            for (int g = 0; g < 4; ++g) { const f32x4 c0 = *(const LAS f32x4*)(ck + 8 * g + 4 * hi), c1 = *(const LAS f32x4*)(ck + 32 + 8 * g + 4 * hi);
                p0[4 * g] -= c0.x; p0[4 * g + 1] -= c0.y; p0[4 * g + 2] -= c0.z; p0[4 * g + 3] -= c0.w;
                p1[4 * g] -= c1.x; p1[4 * g + 1] -= c1.y; p1[4 * g + 2] -= c1.z; p1[4 * g + 3] -= c1.w; }
            if (j == dg) {
                const int qrel = qw0 + r32 - kv0;
#pragma unroll
                for (int r = 0; r < 16; ++r) { const int kvl = crow(r, hi); if (kvl > qrel) p0[r] = FA_NEG_INF; if (kvl + 32 > qrel) p1[r] = FA_NEG_INF; }
            }
            softmax_pv<2>(mhat, lsum, o, p0, p1, 0.f, 0.f, vt, wsf, lane);
        }
        if (j == 0) { FA_SYNC(); break; }
        const int jn = j - 1;
        if (jn < dg) mine = mine && (__any((ub - pre[jn + 1] * LOG2E) - mhat > -PRUNE) != 0);
        if (lane == 0) flg[(i & 1) * 8 + wid] = (jn >= dg || mine) ? 1 : 0;
        tile_commit<1, 1>(st, lds + FX_KB + (bsel ^ 1) * KT, lds + FX_VB + (bsel ^ 1) * 2 * VDB, tid); if (tid < 64) ((LAS float*)(lds + FX_CK))[(bsel ^ 1) * 64 + tid] = ckv;
        if (i % 3 == 2) ride_finish(Cv, lane);
        if (j >= 2) { const int j2 = j - 2; tile_issue<1, 1>(st, Kg + (size_t)(64 * j2) * QP, Kg, QP, Vg + (size_t)(64 * j2) * QP, QP, tid); if (tid < 64) ckv = (cg[(size_t)(64 * j2 + tid) * 16] + pre[j2]) * LOG2E; }
        if (i % 3 == 0) ride_start(Cv, lane);
        FA_SYNC();
        { const LAS int* f = flg + (i & 1) * 8; const int any = (f[0] | f[1]) | (f[2] | f[3]) | (f[4] | f[5]) | (f[6] | f[7]);
          if (__builtin_amdgcn_readfirstlane(any) == 0) break; }
    }
    finish_rows<2>(lsum, o, wsf, lane, 1.f);
    store_rows64(o, (LAS bf16*)(lds + FX_OST) + wid * 2048, AO + (size_t)(b * S + qw0) * D + h * 64, D, lane);
}

__device__ __forceinline__ float alibi_mod(f32x16& p0, f32x16& p1, float slope2, int qrel, bool causal, bool lower, bool flagged, bool flag, int hi) {
#pragma unroll
    for (int r = 0; r < 16; ++r) { const int c = (r & 3) + 8 * (r >> 2); p0[r] = __builtin_fmaf(slope2, (float)c, p0[r]); p1[r] = __builtin_fmaf(slope2, (float)(c + 32), p1[r]); }
    if (causal) {
#pragma unroll
        for (int r = 0; r < 16; ++r) { const int kvl = crow(r, hi); if (kvl > qrel) p0[r] = FA_NEG_INF; if (kvl + 32 > qrel) p1[r] = FA_NEG_INF; }
    }
    if (lower) {
#pragma unroll
        for (int r = 0; r < 16; ++r) { const int kvl = crow(r, hi); if (kvl <= qrel - 512) p0[r] = FA_NEG_INF; if (kvl + 32 <= qrel - 512) p1[r] = FA_NEG_INF; }
    }
    if (flagged) {
        if (!flag) {
#pragma unroll
            for (int r = 0; r < 16; ++r) { p0[r] = FA_NEG_INF; p1[r] = FA_NEG_INF; }
        }
    }
    return slope2 * (float)(-qrel);
}

constexpr int DF_KB = 0, DF_VB = 4 * KT, DF_WSF = DF_VB + 2 * 4 * VDB, DF_X = DF_WSF + 8 * 256, DF_XW = 32 * 132 * 4, DF_FLG = DF_X + 4 * DF_XW, DF_UB = DF_FLG + 64, DF_END = DF_UB + 1024;
__device__ __forceinline__ void diff_unit(LAS unsigned char* lds, int tid_in, int b, int h, int qt, const bf16* QKV, bf16* AO, float lam, int lpost, const float* subg, const unsigned* KN2) {
    int tid = tid_in; asm volatile("" : "+v"(tid));
    const int lane = tid & 63, wid = __builtin_amdgcn_readfirstlane(tid >> 6), r32 = lane & 31, hi = lane >> 5;
    const int cs = wid >> 2, q0 = qt * 128, qw0 = q0 + (wid & 3) * 32, NT = 2 * (qt + 1), dg = qw0 >> 6;
    const bf16* K0 = QKV + (size_t)(b * S) * QP + C_AK + h * 128;
    const bf16* Vg = QKV + (size_t)(b * S) * QP + C_AV + h * 128;
    const float slope2 = exp2f(-2.f * (float)(h + 1)) * LOG2E;
    LAS float* wsf = (LAS float*)(lds + DF_WSF) + wid * 64;
    LAS int* flg = (LAS int*)(lds + DF_FLG);
    bf16x8 qr[4]; load_q(qr, QKV + (size_t)(b * S + qw0 + r32) * QP + C_AQ + h * 128 + cs * 64, hi);
    float ub;
    { float s2 = 0.f;
#pragma unroll
      for (int d0 = 0; d0 < 4; ++d0) { const v4u u = __builtin_bit_cast(v4u, qr[d0]);
          const float a0 = bf2f(u.x & 0xffffu), a1 = bf2f(u.x >> 16), a2 = bf2f(u.y & 0xffffu), a3 = bf2f(u.y >> 16), a4 = bf2f(u.z & 0xffffu), a5 = bf2f(u.z >> 16), a6 = bf2f(u.w & 0xffffu), a7 = bf2f(u.w >> 16);
          s2 += (a0 * a0 + a1 * a1) + (a2 * a2 + a3 * a3) + (a4 * a4 + a5 * a5) + (a6 * a6 + a7 * a7); }
      const unsigned* kg = KN2 + b * 96 + 16 + 4 * h + 2 * cs;
      ub = sqrtf(swapsum(s2)) * sqrtf(__uint_as_float(kg[0]) + __uint_as_float(kg[1])) * 1.01f + 0.01f; }
    LAS float* ubs = (LAS float*)(lds + DF_UB) + wid * 32 + r32;
    *ubs = ub;
    float mhat = NEGBIG, lsum = 0.f; f32x16 o[4];
#pragma unroll
    for (int i = 0; i < 16; ++i) { o[0][i] = 0.f; o[1][i] = 0.f; o[2][i] = 0.f; o[3][i] = 0.f; }
    Stage<2, 2> st;
    { const size_t ro = (size_t)(64 * (NT - 1)) * QP; tile_issue<2, 2>(st, K0 + ro, K0 + ro + 64, QP, Vg + ro, QP, tid); }
    tile_commit<2, 2>(st, lds + DF_KB, lds + DF_VB, tid);
    { const size_t ro = (size_t)(64 * (NT - 2)) * QP; tile_issue<2, 2>(st, K0 + ro, K0 + ro + 64, QP, Vg + ro, QP, tid); }
    FA_SYNC();
    bool mine = true;
    for (int i = 0;; ++i) {
        const int j = NT - 1 - i, kv0 = j * 64, bsel = i & 1;
        if (j == dg || (j < dg && mine)) {
            const LAS unsigned char* kt = lds + DF_KB + (bsel * 2 + cs) * KT; const LAS unsigned char* vt = lds + DF_VB + bsel * 4 * VDB;
            f32x16 p0, p1; qk_tile(p0, p1, qr, kt, lane);
            const float off = alibi_mod(p0, p1, slope2, qw0 + r32 - kv0, j == dg, false, false, true, hi);
            softmax_pv<4>(mhat, lsum, o, p0, p1, off, slope2 * (float)(4 * hi), vt, wsf, lane);
        }
        if (j == 0) { FA_SYNC(); break; }
        const int jn = j - 1;
        if (jn < dg) mine = mine && (__any((*ubs + slope2 * (float)(64 * jn + 63 - (qw0 + r32))) - mhat > -PRUNE) != 0);
        if (lane == 0) flg[(i & 1) * 8 + wid] = (jn >= dg || mine) ? 1 : 0;
        tile_commit<2, 2>(st, lds + DF_KB + (bsel ^ 1) * 2 * KT, lds + DF_VB + (bsel ^ 1) * 4 * VDB, tid);
        if (j >= 2) { const size_t ro = (size_t)(64 * (j - 2)) * QP; tile_issue<2, 2>(st, K0 + ro, K0 + ro + 64, QP, Vg + ro, QP, tid); }
        FA_SYNC();
        { const LAS int* f = flg + (i & 1) * 8; const int any = (f[0] | f[1]) | (f[2] | f[3]) | (f[4] | f[5]) | (f[6] | f[7]);
          if (__builtin_amdgcn_readfirstlane(any) == 0) break; }
    }
    finish_rows<4>(lsum, o, wsf, lane, 1.f);
    LAS float* X = (LAS float*)(lds + DF_X + (wid & 3) * DF_XW);
    if (cs == 1) {
#pragma unroll
        for (int r = 0; r < 16; ++r)
#pragma unroll
            for (int d0 = 0; d0 < 4; ++d0) X[crow(r, hi) * 132 + d0 * 32 + r32] = o[d0][r];
    }
    FA_SYNC();
    if (cs == 0) {
#pragma unroll
        for (int r = 0; r < 16; ++r)
#pragma unroll
            for (int d0 = 0; d0 < 4; ++d0) { LAS float* xp = X + crow(r, hi) * 132 + d0 * 32 + r32; *xp = o[d0][r] - lam * *xp; }
        asm volatile("s_waitcnt lgkmcnt(0)" ::: "memory");
        const int row = lane >> 1, half = lane & 1;
        f32x4 v[16]; float ss = 0.f;
#pragma unroll
        for (int i = 0; i < 16; ++i) { v[i] = *(const LAS f32x4*)(X + row * 132 + half * 64 + 4 * i); ss += (v[i].x * v[i].x + v[i].y * v[i].y) + (v[i].z * v[i].z + v[i].w * v[i].w); }
        ss += shx<1>(ss);
        int lp_ = lpost; asm volatile("" : "+s"(lp_));
        const float post = (lp_ == 0) ? 0.8f : (lp_ == 1) ? 0.64449093f : (lp_ == 2) ? 0.52928698f : 0.44394179f;
        const float rs = rsqrtf(ss * (1.f / 128.f) + EPS) * post;
        bf16* dst = AO + (size_t)(b * S + qw0 + row) * D + h * 128 + half * 64;
#pragma unroll
        for (int i = 0; i < 8; ++i) { const f32x4 g0 = *(const f32x4*)(subg + half * 64 + 8 * i), g1 = *(const f32x4*)(subg + half * 64 + 8 * i + 4);
            v4u w; w.x = cvtpk(v[2 * i].x * rs * g0.x, v[2 * i].y * rs * g0.y); w.y = cvtpk(v[2 * i].z * rs * g0.z, v[2 * i].w * rs * g0.w);
            w.z = cvtpk(v[2 * i + 1].x * rs * g1.x, v[2 * i + 1].y * rs * g1.y); w.w = cvtpk(v[2 * i + 1].z * rs * g1.z, v[2 * i + 1].w * rs * g1.w);
            *(v4u*)(dst + 8 * i) = w; }
    }
    FA_SYNC();
}

constexpr int NS_KB = 0, NS_VB = 4 * KT, NS_WSF = NS_VB + 4 * 2 * VDB, NS_IMP = NS_WSF + 8 * 256, NS_SEL = NS_IMP + 65536, NS_UNI = NS_SEL + 512, NS_END = NS_UNI + 64;
__device__ __forceinline__ void nsa_branch(LAS unsigned char* lds, int tid, const bool SLC, unsigned long long tiles, const bf16* Kg, const bf16* Vg, int cur, int qw0, float slope2,
                                           unsigned long long mysel, const bf16x8 (&qr)[4], float& mhat, float& lsum, f32x16 (&o)[2], LAS float* wsf, CvtRide& Cv) {
    const int lane = tid & 63, r32 = lane & 31, hi = lane >> 5;
    Stage<1, 1> stA, stB;
    unsigned long long rem = tiles;
    int jc = __builtin_ctzll(rem); rem &= rem - 1;
    tile_issue<1, 1>(stA, Kg + (size_t)(64 * jc) * QP, Kg, QP, Vg + (size_t)(64 * jc) * QP, QP, tid);
    tile_commit<1, 1>(stA, lds + NS_KB, lds + NS_VB, tid);
    int j1 = -1; if (rem) { j1 = __builtin_ctzll(rem); rem &= rem - 1; tile_issue<1, 1>(stA, Kg + (size_t)(64 * j1) * QP, Kg, QP, Vg + (size_t)(64 * j1) * QP, QP, tid); }
    int j2 = -1; if (rem) { j2 = __builtin_ctzll(rem); rem &= rem - 1; tile_issue<1, 1>(stB, Kg + (size_t)(64 * j2) * QP, Kg, QP, Vg + (size_t)(64 * j2) * QP, QP, tid); }
    FA_SYNC();
    int bsel = 0, nride = 0;
#define NSB_STEP(SA) { \
        const bool flag = SLC ? (((mysel >> jc) & 1ull) != 0ull) : true; \
        if (__any(flag)) { \
            const LAS unsigned char* kt = lds + NS_KB + bsel * KT; const LAS unsigned char* vt = lds + NS_VB + bsel * 2 * VDB; \
            f32x16 p0, p1; qk_tile(p0, p1, qr, kt, lane); \
            const float off = alibi_mod(p0, p1, slope2, qw0 + r32 - 64 * jc, jc == cur, (!SLC) && (jc == cur - 8), SLC, flag, hi); \
            softmax_pv<2>(mhat, lsum, o, p0, p1, off, slope2 * (float)(4 * hi), vt, wsf, lane); \
        } \
        if (j1 < 0) { ride_finish(Cv, lane); FA_SYNC(); break; }        \
        tile_commit<1, 1>(SA, lds + NS_KB + (bsel ^ 1) * KT, lds + NS_VB + (bsel ^ 1) * 2 * VDB, tid); \
        ++nride; if (nride == 4) { if (j2 >= 0) ride_finish2(Cv, lane); else ride_finish(Cv, lane); nride = 0; }        \
        int j3 = -1; if (rem) { j3 = __builtin_ctzll(rem); rem &= rem - 1; tile_issue<1, 1>(SA, Kg + (size_t)(64 * j3) * QP, Kg, QP, Vg + (size_t)(64 * j3) * QP, QP, tid); } \
        if (nride == 1) ride_start(Cv, lane); \
        FA_SYNC(); \
        jc = j1; j1 = j2; j2 = j3; bsel ^= 1; }
    for (;;) { NSB_STEP(stA) NSB_STEP(stB) }
#undef NSB_STEP
}
__device__ __forceinline__ void nsa_unit(LAS unsigned char* lds, int tid_in, int b, int g, int qt, const bf16* QKV, const bf16* KC, const bf16* VC, const float* GL, bf16* AO, CvtRide& Cv) {
    int tid = tid_in; asm volatile("" : "+v"(tid));
    const int lane = tid & 63, wid = __builtin_amdgcn_readfirstlane(tid >> 6), r32 = lane & 31, hi = lane >> 5;
    const int hg = wid & 3, psub = wid >> 2, cur = qt, q0 = qt * 64, qw0 = q0 + psub * 32, head = g * 4 + hg;
    const int qpos = qw0 + r32, trow = b * S + qpos;
    const float slope2 = exp2f(-(float)(head + 1)) * LOG2E;
    LAS float* wsf = (LAS float*)(lds + NS_WSF) + wid * 64;
    bf16x8 qr[4]; load_q(qr, QKV + (size_t)trow * QP + C_BQ + head * 64, hi);
    const float g_cmp = sigmoidf_(GL[(size_t)trow * 32 + head * 3 + 0]), g_slc = sigmoidf_(GL[(size_t)trow * 32 + head * 3 + 1]), g_win = sigmoidf_(GL[(size_t)trow * 32 + head * 3 + 2]);
    f32x16 outa[2];
    const int nmax = (q0 + 32) >> 4, ntc = (nmax >> 6) + 1;
    { Stage<1, 1> st;
#pragma unroll 1
      for (int tt = 0; tt < ntc; ++tt) {
          const bf16* kc = KC + ((size_t)(b * 256 + 64 * tt) * 2 + g) * 64; const bf16* vc = VC + ((size_t)(b * 256 + 64 * tt) * 2 + g) * 64;
          tile_issue<1, 1>(st, kc, kc, 128, vc, 128, tid);
          tile_commit<1, 1>(st, lds + NS_KB + tt * KT, lds + NS_VB + tt * 2 * VDB, tid);
      } }
    FA_SYNC();
    {
        float m = FA_NEG_INF, l = 0.f;
#pragma unroll 1
        for (int tt = 0; tt < ntc; ++tt) {
            f32x16 p0, p1; qk_tile(p0, p1, qr, lds + NS_KB + tt * KT, lane);
            float rm = FA_NEG_INF;
            const int dbase = qpos - 31 - 16 * (64 * tt + 4 * hi);
#pragma unroll
            for (int r = 0; r < 16; ++r) { const int d0 = dbase - 16 * ((r & 3) + 8 * (r >> 2)), d1 = d0 - 16 * 32;
                p0[r] = (d0 >= 0) ? p0[r] - slope2 * (float)d0 : FA_NEG_INF; p1[r] = (d1 >= 0) ? p1[r] - slope2 * (float)d1 : FA_NEG_INF;
                rm = fmaxf(rm, fmaxf(p0[r], p1[r])); }
            rm = swapmax(rm);
            const float mn = fmaxf(m, rm);
            if (mn > FA_NEG_INF) {
                float sa = 0.f;
#pragma unroll
                for (int r = 0; r < 16; ++r) sa += __builtin_amdgcn_exp2f(p0[r] - mn) + __builtin_amdgcn_exp2f(p1[r] - mn);
                l = l * __builtin_amdgcn_exp2f(m - mn) + sa; m = mn;
            }
        }
        l = swapsum(l);
        const float inv = (l > 0.f) ? 1.f / l : 0.f;
        const float mref = (m > FA_NEG_INF) ? m : 0.f;
        f32x16 oc[2];
#pragma unroll
        for (int i = 0; i < 16; ++i) { oc[0][i] = 0.f; oc[1][i] = 0.f; }
        LAS float* imp = (LAS float*)(lds + NS_IMP) + (hg * 64 + psub * 32 + r32) * 64;
        float carry = 0.f;
#pragma unroll 1
        for (int tt = 0; tt < ntc; ++tt) {
            f32x16 p0, p1; qk_tile(p0, p1, qr, lds + NS_KB + tt * KT, lane);
            const int dbase = qpos - 31 - 16 * (64 * tt + 4 * hi);
#pragma unroll
            for (int r = 0; r < 16; ++r) { const int d0 = dbase - 16 * ((r & 3) + 8 * (r >> 2)), d1 = d0 - 16 * 32;
                p0[r] = (d0 >= 0) ? __builtin_amdgcn_exp2f(p0[r] - slope2 * (float)d0 - mref) * inv : 0.f;
                p1[r] = (d1 >= 0) ? __builtin_amdgcn_exp2f(p1[r] - slope2 * (float)d1 - mref) * inv : 0.f; }
#pragma unroll
            for (int h2 = 0; h2 < 2; ++h2)
#pragma unroll
                for (int mm = 0; mm < 4; ++mm) {
                    const f32x16& pp = h2 ? p1 : p0;
                    const float G = (pp[4 * mm] + pp[4 * mm + 1]) + (pp[4 * mm + 2] + pp[4 * mm + 3]), L = pp[4 * mm + 3];
                    auto rr = __builtin_amdgcn_permlane32_swap(__float_as_uint(L), __float_as_uint(L), false, false);
                    const float Lo = __uint_as_float(hi ? rr[0] : rr[1]);
                    const float val = G + (hi ? Lo : carry);
                    carry = Lo;
                    imp[16 * tt + 8 * h2 + 2 * mm + hi] = val;
                }
            bf16x8 pa[4];
            { v4u w;
              w.x = cvtpk(p0[0], p0[1]); w.y = cvtpk(p0[2], p0[3]); w.z = cvtpk(p0[4], p0[5]); w.w = cvtpk(p0[6], p0[7]); pa[0] = __builtin_bit_cast(bf16x8, w);
              w.x = cvtpk(p0[8], p0[9]); w.y = cvtpk(p0[10], p0[11]); w.z = cvtpk(p0[12], p0[13]); w.w = cvtpk(p0[14], p0[15]); pa[1] = __builtin_bit_cast(bf16x8, w);
              w.x = cvtpk(p1[0], p1[1]); w.y = cvtpk(p1[2], p1[3]); w.z = cvtpk(p1[4], p1[5]); w.w = cvtpk(p1[6], p1[7]); pa[2] = __builtin_bit_cast(bf16x8, w);
              w.x = cvtpk(p1[8], p1[9]); w.y = cvtpk(p1[10], p1[11]); w.z = cvtpk(p1[12], p1[13]); w.w = cvtpk(p1[14], p1[15]); pa[3] = __builtin_bit_cast(bf16x8, w); }
            pv_step<2>(oc, lds + NS_VB + tt * 2 * VDB, lane, pa);
        }
        if (hi == 0) wsf[32 + r32] = g_cmp;
        asm volatile("s_waitcnt lgkmcnt(0)" ::: "memory");
#pragma unroll
        for (int gq = 0; gq < 4; ++gq) { const f32x4 fv = *(const LAS f32x4*)(wsf + 32 + 8 * gq + 4 * hi);
#pragma unroll
            for (int d0 = 0; d0 < 2; ++d0) { outa[d0][4 * gq] = oc[d0][4 * gq] * fv.x; outa[d0][4 * gq + 1] = oc[d0][4 * gq + 1] * fv.y; outa[d0][4 * gq + 2] = oc[d0][4 * gq + 2] * fv.z; outa[d0][4 * gq + 3] = oc[d0][4 * gq + 3] * fv.w; } }
    }
    FA_SYNC();
    {
        const LAS float* impb = (const LAS float*)(lds + NS_IMP);
        unsigned long long uni = 0ull;
#pragma unroll 1
        for (int pp = 0; pp < 8; ++pp) {
            const int pos = wid * 8 + pp;
            const bool avail = lane <= cur, forced = (lane == 0) || (lane == cur) || (lane == cur - 1);
            float iv = 0.f;
            if (avail && lane < 16 * ntc) iv = ((impb[(0 * 64 + pos) * 64 + lane] + impb[(1 * 64 + pos) * 64 + lane]) + impb[(2 * 64 + pos) * 64 + lane]) + impb[(3 * 64 + pos) * 64 + lane];
            const float score = avail ? iv + (forced ? 1e4f : 0.f) : NEGBIG;
            int rank = 0;
            for (int j = 0; j <= cur; ++j) { const float sj = __uint_as_float(__builtin_amdgcn_readlane(__float_as_uint(score), j)); rank += (sj > score || (sj == score && j < lane)) ? 1 : 0; }
            const unsigned long long sel = __ballot(avail && rank < 16);
            if (lane == 0) ((LAS unsigned long long*)(lds + NS_SEL))[pos] = sel;
            uni |= sel;
        }
        if (lane == 0) ((LAS unsigned long long*)(lds + NS_UNI))[wid] = uni;
    }
    FA_SYNC();
    const unsigned long long mysel = ((const LAS unsigned long long*)(lds + NS_SEL))[psub * 32 + r32];
    unsigned long long uni = 0ull;
#pragma unroll
    for (int w = 0; w < 8; ++w) uni |= ((const LAS unsigned long long*)(lds + NS_UNI))[w];
    uni = __builtin_amdgcn_readfirstlane((unsigned)uni) | ((unsigned long long)__builtin_amdgcn_readfirstlane((unsigned)(uni >> 32)) << 32);
    const bf16* base = QKV + (size_t)(b * S) * QP + g * 64;
#pragma unroll 1
    for (int br = 0; br < 2; ++br) {
        const bool slc = (br == 0);
        float mhat = NEGBIG, lsum = 0.f; f32x16 o[2];
#pragma unroll
        for (int i = 0; i < 16; ++i) { o[0][i] = 0.f; o[1][i] = 0.f; }
        const int lo = cur > 8 ? cur - 8 : 0;
        const unsigned long long wt = ((cur == 63) ? ~0ull : ((1ull << (cur + 1)) - 1ull)) & ~((1ull << lo) - 1ull);
#if ATTN_V2
        nsa_branch2(lds, tid, slc, slc ? uni : wt, base + (slc ? C_KS : C_KW), base + (slc ? C_VS : C_VW), cur, qw0, slope2, mysel, qr, lsum, o, wsf);
#else
        nsa_branch(lds, tid, slc, slc ? uni : wt, base + (slc ? C_KS : C_KW), base + (slc ? C_VS : C_VW), cur, qw0, slope2, mysel, qr, mhat, lsum, o, wsf, Cv);
#endif
        finish_rows<2>(lsum, o, wsf, lane, slc ? g_slc : g_win);
#pragma unroll
        for (int i = 0; i < 16; ++i) { outa[0][i] += o[0][i]; outa[1][i] += o[1][i]; }
    }
    store_rows64(outa, (LAS bf16*)(lds + NS_IMP) + wid * 2048, AO + (size_t)(b * S + qw0) * D + 512 + head * 64, D, lane);
    FA_SYNC();
}

constexpr int F2_K = 0, F2_V = 3 * KT, F2_C = F2_V + 2 * 2 * VDB, F2_WSF = F2_C + 768, F2_OST = F2_WSF + 8 * 256, F2_PRE = F2_OST + 8 * 4096, F2_END = F2_PRE + 256;
__device__ __forceinline__ void fox_unit2(LAS unsigned char* lds, int tid_in, int b, int h, int qt, const bf16* QKV, const float* CUM, const float* CHTOT, bf16* AO) {
    int tid = tid_in; asm volatile("" : "+v"(tid));
    const int lane = tid & 63, wid = __builtin_amdgcn_readfirstlane(tid >> 6), r32 = lane & 31, hi = lane >> 5;
    const int q0 = qt * 256, qw0 = q0 + wid * 32, NT = 4 * (qt + 1);
    LAS float* wsf = (LAS float*)(lds + F2_WSF) + wid * 64;
    LAS float* pre = (LAS float*)(lds + F2_PRE);
    if (wid == 0) {
        const float val = (lane < NT) ? CHTOT[(size_t)(b * 64 + lane) * 16 + h] : 0.f; float inc = val;
#pragma unroll
        for (int o = 1; o < 64; o <<= 1) { const float u = shl_(inc, lane - o); if (lane >= o) inc += u; }
        pre[lane] = inc - val;
    }
    bf16x8 qr[4]; load_q(qr, QKV + (size_t)(b * S + qw0 + r32) * QP + h * 64, hi);
    float mhat = 0.f, st = 0.f, lsum = 0.f; f32x16 o[2];
#pragma unroll
    for (int i = 0; i < 16; ++i) { o[0][i] = 0.f; o[1][i] = 0.f; }
    FA_SYNC();
    RunCfg<2, 1, true> R;
    R.lds = lds; R.KOFF = F2_K; R.VOFF = F2_V; R.COFF = F2_C;
    R.Kg0 = QKV + (size_t)(b * S) * QP + 1024 + h * 64; R.Kg1 = R.Kg0; R.Vg = QKV + (size_t)(b * S) * QP + 2048 + h * 64; R.pitch = QP;
    R.cg = CUM + (size_t)(b * S) * 16 + h; R.pre = pre; R.ksel = 0; R.slope2 = 0.f; R.qw0 = qw0; R.low = -1; R.slc = false; R.mysel = 0ull;
    run_tiles<2, 1, true>(R, tid, (NT == 64) ? ~0ull : ((1ull << NT) - 1ull), qr, mhat, st, lsum, o, wsf);
    finish_rows<2>(lsum, o, wsf, lane, 1.f);
    store_rows64(o, (LAS bf16*)(lds + F2_OST) + wid * 2048, AO + (size_t)(b * S + qw0) * D + h * 64, D, lane);
}

constexpr int D2_K = 0, D2_V = 3 * 2 * KT, D2_WSF = D2_V + 2 * 4 * VDB, D2_END = D2_WSF + 8 * 256, D2_X = 0;
__device__ __forceinline__ void diff_unit2(LAS unsigned char* lds, int tid_in, int b, int h, int qt, const bf16* QKV, bf16* AO, float lam, float post, const float* subg) {
    int tid = tid_in; asm volatile("" : "+v"(tid));
    const int lane = tid & 63, wid = __builtin_amdgcn_readfirstlane(tid >> 6), r32 = lane & 31, hi = lane >> 5;
    const int cs = wid >> 2, q0 = qt * 128, qw0 = q0 + (wid & 3) * 32, NT = 2 * (qt + 1);
    LAS float* wsf = (LAS float*)(lds + D2_WSF) + wid * 64;
    bf16x8 qr[4]; load_q(qr, QKV + (size_t)(b * S + qw0 + r32) * QP + C_AQ + h * 128 + cs * 64, hi);
    float mhat = 0.f, st = 0.f, lsum = 0.f; f32x16 o[4];
#pragma unroll
    for (int i = 0; i < 16; ++i) { o[0][i] = 0.f; o[1][i] = 0.f; o[2][i] = 0.f; o[3][i] = 0.f; }
    RunCfg<4, 2, false> R;
    R.lds = lds; R.KOFF = D2_K; R.VOFF = D2_V; R.COFF = 0;
    R.Kg0 = QKV + (size_t)(b * S) * QP + C_AK + h * 128; R.Kg1 = R.Kg0 + 64; R.Vg = QKV + (size_t)(b * S) * QP + C_AV + h * 128; R.pitch = QP;
    R.cg = nullptr; R.pre = nullptr; R.ksel = cs; R.slope2 = exp2f(-2.f * (float)(h + 1)) * LOG2E; R.qw0 = qw0; R.low = -1; R.slc = false; R.mysel = 0ull;
    run_tiles<4, 2, false>(R, tid, (NT == 64) ? ~0ull : ((1ull << NT) - 1ull), qr, mhat, st, lsum, o, wsf);
    finish_rows<4>(lsum, o, wsf, lane, 1.f);
    LAS float* X = (LAS float*)(lds + D2_X + (wid & 3) * DF_XW);
    if (cs == 1) {
#pragma unroll
        for (int r = 0; r < 16; ++r)
#pragma unroll
            for (int d0 = 0; d0 < 4; ++d0) X[crow(r, hi) * 132 + d0 * 32 + r32] = o[d0][r];
    }
    FA_SYNC();
    if (cs == 0) {
#pragma unroll
        for (int r = 0; r < 16; ++r)
#pragma unroll
            for (int d0 = 0; d0 < 4; ++d0) { LAS float* xp = X + crow(r, hi) * 132 + d0 * 32 + r32; *xp = o[d0][r] - lam * *xp; }
        asm volatile("s_waitcnt lgkmcnt(0)" ::: "memory");
        const int row = lane >> 1, half = lane & 1;
        f32x4 v[16]; float ss = 0.f;
#pragma unroll
        for (int i = 0; i < 16; ++i) { v[i] = *(const LAS f32x4*)(X + row * 132 + half * 64 + 4 * i); ss += (v[i].x * v[i].x + v[i].y * v[i].y) + (v[i].z * v[i].z + v[i].w * v[i].w); }
        ss += shx<1>(ss);
        const float rs = rsqrtf(ss * (1.f / 128.f) + EPS) * post;
        bf16* dst = AO + (size_t)(b * S + qw0 + row) * D + h * 128 + half * 64;
#pragma unroll
        for (int i = 0; i < 8; ++i) { const f32x4 g0 = *(const f32x4*)(subg + half * 64 + 8 * i), g1 = *(const f32x4*)(subg + half * 64 + 8 * i + 4);
            v4u w; w.x = cvtpk(v[2 * i].x * rs * g0.x, v[2 * i].y * rs * g0.y); w.y = cvtpk(v[2 * i].z * rs * g0.z, v[2 * i].w * rs * g0.w);
            w.z = cvtpk(v[2 * i + 1].x * rs * g1.x, v[2 * i + 1].y * rs * g1.y); w.w = cvtpk(v[2 * i + 1].z * rs * g1.z, v[2 * i + 1].w * rs * g1.w);
            *(v4u*)(dst + 8 * i) = w; }
    }
    FA_SYNC();
}
__device__ __forceinline__ void nsa_branch2(LAS unsigned char* lds, int tid, const bool SLC, unsigned long long tiles, const bf16* Kg, const bf16* Vg, int cur, int qw0, float slope2,
                                            unsigned long long mysel, const bf16x8 (&qr)[4], float& lsum, f32x16 (&o)[2], LAS float* wsf) {
    RunCfg<2, 1, false> R;
    R.lds = lds; R.KOFF = NS_KB; R.VOFF = NS_VB; R.COFF = 0;
    R.Kg0 = Kg; R.Kg1 = Kg; R.Vg = Vg; R.pitch = QP; R.cg = nullptr; R.pre = nullptr; R.ksel = 0; R.slope2 = slope2; R.qw0 = qw0;
    R.low = (!SLC && cur >= 8) ? cur - 8 : -1; R.slc = SLC; R.mysel = mysel;
    float mhat = 0.f, st = 0.f;
    run_tiles<2, 1, false>(R, tid, tiles, qr, mhat, st, lsum, o, wsf);
}

__device__ __forceinline__ void even_attn_phase(const Ctx& C0, int l) {
    PHASE_PROLOG(C0);
    const bf16* QKV = WSP(bf16, WS_QKV); bf16* AO = WSP(bf16, WS_AO);
    const int e = l >> 1;
    const float lam_init = 0.8f - 0.6f * __expf(-0.3f * (float)l);
    float lam;
    { const float* lp = INP(I_DLAM) + e * 256; int tl0 = C.tid; asm volatile("" : "+v"(tl0)); const int ln0 = tl0 & 63; const float a1 = wave_sum(lp[ln0] * lp[64 + ln0]), a2 = wave_sum(lp[128 + ln0] * lp[192 + ln0]);
      lam = __uint_as_float(__builtin_amdgcn_readfirstlane(__float_as_uint(__expf(a1) - __expf(a2) + lam_init))); }
    CvtRide Cv; Cv.wg = INP(I_WG); Cv.wu = INP(I_WU); Cv.wd = INP(I_WD); Cv.ws = ws; Cv.scr = (LAS float*)(C.lds + NS_IMP) + C.wave * 2048; Cv.full = false; Cv.step = C.NGW;
    Cv.it = l * CVT_MOE_L + C.gw; Cv.hi = (l + 1) * CVT_MOE_L;
    const unsigned* KN2 = WSP(unsigned, WS_CTL) + CW_KNP + l * 384;
    for (int vc = blockIdx.x; vc < 256; vc += gridDim.x) {
        { const int bh = vc >> 4, s = vc & 15, b = bh >> 2, h = bh & 3;
#pragma unroll 1
          for (int i = 0; i < 2; ++i) diff_unit(C.lds, C.tid, b, i ? 3 - h : h, i ? 31 - s : s, QKV, AO, lam, l, INP(I_DSUB) + e * 128, KN2); }
        { const int bg = vc >> 5, s = vc & 31;
#pragma unroll 1
          for (int i = 0; i < 2; ++i) nsa_unit(C.lds, C.tid, bg >> 1, bg & 1, i == 0 ? s : 63 - s, QKV, WSP(bf16, WS_KCMP), WSP(bf16, WS_VCMP), WSP(float, WS_GL), AO, Cv); }
    }
    { int tl = C.tid; asm volatile("" : "+v"(tl)); const int ln2 = tl & 63;
      while (Cv.full || Cv.it < Cv.hi) { ride_finish(Cv, ln2); ride_start(Cv, ln2); } }
}
__device__ __forceinline__ void fox_phase(const Ctx& C0, int l) {
    PHASE_PROLOG(C0);
    const bf16* QKV = WSP(bf16, WS_QKV); const float* CUM = WSP(float, WS_CUMF); const float* CHTOT = WSP(float, WS_CHTOT); bf16* AO = WSP(bf16, WS_AO);
    CvtRide Cv; Cv.wg = INP(I_WG); Cv.wu = INP(I_WU); Cv.wd = INP(I_WD); Cv.ws = ws; Cv.scr = (LAS float*)(C.lds + FX_END) + C.wave * 2048; Cv.full = false; Cv.step = C.NGW;
    Cv.it = l * CVT_MOE_L + C.gw; Cv.hi = (l + 1) * CVT_MOE_L;
    unsigned* qword = WSP(unsigned, WS_CTL) + CW_FQ + (l >> 1) * 64; const unsigned* KN = WSP(unsigned, WS_CTL) + CW_KNP + l * 384;
    LAS int* qslot = (LAS int*)(C.lds + LDS_BYTES - 64);
    if (C.tid == 0) qslot[0] = (int)__hip_atomic_fetch_add(qword, 1u, __ATOMIC_RELAXED, __HIP_MEMORY_SCOPE_AGENT);
    FA_SYNC();
    int idx = __builtin_amdgcn_readfirstlane(qslot[0]), par = 0;
    while (idx < 1024) {
        par ^= 1;
        if (C.tid == 0) qslot[par] = (int)__hip_atomic_fetch_add(qword, 1u, __ATOMIC_RELAXED, __HIP_MEMORY_SCOPE_AGENT);
        const int bh = idx & 63, qt = 15 - (idx >> 6);
        const unsigned* kg = KN + (bh >> 4) * 96 + 32 + 2 * (bh & 15);
        const float knmax = sqrtf(__uint_as_float(kg[0]) + __uint_as_float(kg[1]));
        fox_unit(C.lds, C.tid, bh >> 4, bh & 15, qt, QKV, CUM, CHTOT, AO, knmax, Cv);
        FA_SYNC();
        idx = __builtin_amdgcn_readfirstlane(qslot[par]);
    }
    while (Cv.full || Cv.it < Cv.hi) { ride_finish(Cv, C.lane); ride_start(Cv, C.lane); }
}
}

#ifndef USE_MFMA_FOX
#define USE_MFMA_FOX 1
#endif
#ifndef ATTN_V2
#define ATTN_V2 1
#endif
#ifndef USE_MFMA_EVEN
#define USE_MFMA_EVEN 1
#endif
__device__ __forceinline__ void p_attn(const Ctx& C, int l) {
    if ((l & 1) == 0) {
#if USE_MFMA_EVEN
        fa::even_attn_phase(C, l);
        return;
#endif
        const int nd = NB * 4 * S, nn = NB * 2 * S;
        for (int item = C.gw; item < nd + nn; item += C.NGW) {
            if (item < nd) attn_diff_row(C, l, item); else attn_nsa_row(C, l, item - nd);
        }
    } else {
#if USE_MFMA_FOX
        fa::fox_phase(C, l);
#else
        for (int item = C.gw; item < NB * 16 * S; item += C.NGW) attn_fox_row(C, item);
#endif
    }
}


__device__ __forceinline__ void p_knorm_diff(const Ctx& C0, int l) {
    PHASE_PROLOG(C0);
    const bf16* QKV = WSP(bf16, WS_QKV); unsigned* KN = WSP(unsigned, WS_CTL) + CW_KN2 + (l >> 1) * 64;
    LAS float* red = (LAS float*)(C.lds + 81920);
    for (int item = blockIdx.x; item < 256; item += gridDim.x) {
        const int bhc = item >> 3, q = item & 7, b = bhc >> 3, hc = bhc & 7;
        const bf16* Kb = QKV + (size_t)(b * S + q * 512 + C.tid) * QP + C_AK + hc * 64; float s2 = 0.f;
#pragma unroll
        for (int c = 0; c < 8; ++c) { const v4u u = *(const v4u*)(Kb + c * 8);
            const float a0 = bf2f(u.x & 0xffffu), a1 = bf2f(u.x >> 16), a2 = bf2f(u.y & 0xffffu), a3 = bf2f(u.y >> 16), a4 = bf2f(u.z & 0xffffu), a5 = bf2f(u.z >> 16), a6 = bf2f(u.w & 0xffffu), a7 = bf2f(u.w >> 16);
            s2 += (a0 * a0 + a1 * a1) + (a2 * a2 + a3 * a3) + (a4 * a4 + a5 * a5) + (a6 * a6 + a7 * a7); }
        const float m2 = wave_max(s2);
        __syncthreads();
        if (C.lane == 0) red[C.wave] = m2;
        __syncthreads();
        if (C.tid == 0) { const float m = fmaxf(fmaxf(fmaxf(red[0], red[1]), fmaxf(red[2], red[3])), fmaxf(fmaxf(red[4], red[5]), fmaxf(red[6], red[7])));
            __hip_atomic_fetch_max(KN + bhc, __float_as_uint(m), __ATOMIC_RELAXED, __HIP_MEMORY_SCOPE_AGENT); }
    }
}

__device__ __forceinline__ void p_knorm(const Ctx& C0, int l) {
    PHASE_PROLOG(C0);
    const bf16* QKV = WSP(bf16, WS_QKV); unsigned* KN = WSP(unsigned, WS_CTL) + CW_KN + (l >> 1) * 64;
    LAS float* red = (LAS float*)C.lds;
    for (int item = blockIdx.x; item < 256; item += gridDim.x) {
        const int bh = item >> 2, q = item & 3;
        const bf16* Kb = QKV + (size_t)((bh >> 4) * S + q * 1024) * QP + 1024 + (bh & 15) * 64; float m2 = 0.f;
#pragma unroll
        for (int kk = 0; kk < 2; ++kk) { const int k = C.tid + kk * NTHR; float s2 = 0.f;
#pragma unroll
            for (int c = 0; c < 8; ++c) { const v4u u = *(const v4u*)(Kb + (size_t)k * QP + c * 8);
                const float a0 = bf2f(u.x & 0xffffu), a1 = bf2f(u.x >> 16), a2 = bf2f(u.y & 0xffffu), a3 = bf2f(u.y >> 16), a4 = bf2f(u.z & 0xffffu), a5 = bf2f(u.z >> 16), a6 = bf2f(u.w & 0xffffu), a7 = bf2f(u.w >> 16);
                s2 += (a0 * a0 + a1 * a1) + (a2 * a2 + a3 * a3) + (a4 * a4 + a5 * a5) + (a6 * a6 + a7 * a7); }
            m2 = fmaxf(m2, s2); }
        m2 = wave_max(m2);
        __syncthreads();
        if (C.lane == 0) red[C.wave] = m2;
        __syncthreads();
        if (C.tid == 0) { const float m = fmaxf(fmaxf(fmaxf(red[0], red[1]), fmaxf(red[2], red[3])), fmaxf(fmaxf(red[4], red[5]), fmaxf(red[6], red[7])));
            __hip_atomic_fetch_max(KN + bh, __float_as_uint(m), __ATOMIC_RELAXED, __HIP_MEMORY_SCOPE_AGENT); }
    }
}
__device__ __forceinline__ void p_norm2(const Ctx& C0, int l, int dup = 0) {
    PHASE_PROLOG(C0);
    unsigned char* wsw = ws + (dup ? DUMMY_OFF : (size_t)0);
    const bf16* xcur = WSP(bf16, WS_XCUR); const float* mod = WSP(float, WS_MOD);
    bf16* H = (bf16*)(wsw + WS_H);
    const float* rwt = WSP(float, WS_RWT) + (size_t)l * 32 * 1024;
    int* tope = (int*)(wsw + WS_TOPE); float* topg = (float*)(wsw + WS_TOPG); int* slot = (int*)(wsw + WS_SLOT);
    unsigned* cnt = (unsigned*)(wsw + WS_CTL) + CW_CNT + l * 32;
    LAS float* wl = (LAS float*)C.lds;
    for (int i = C.tid; i < 32 * 256; i += NTHR) *(LAS f32x4*)(wl + 4 * i) = *(const f32x4*)(rwt + 4 * i);
    LAS unsigned* lcnt = (LAS unsigned*)(C.lds + 131072);
    LAS unsigned* lbase = lcnt + 32;
    LAS int* le = (LAS int*)(lbase + 32);
    LAS int* ls = le + 256;
    LAS float* lg = (LAS float*)(ls + 256);
    int* etok = WSP(int, WS_ETOK); float* egate = WSP(float, WS_EGATE);
    const float* p_nfg = INP(I_NFG); const float* p_rb = INP(I_RB);
    for (int chunk = blockIdx.x; chunk < T / 64; chunk += gridDim.x) {
        if (C.tid < 32) lcnt[C.tid] = 0u;
        __syncthreads();
        const int b = (chunk * 64) / S;
        const float* mrow = mod + ((size_t)l * 4 + b) * 6144;
#pragma unroll 1
        for (int pr = 0; pr < 2; ++pr) {
            const int ri0 = C.wave * 8 + pr * 4, t0 = chunk * 64 + ri0;
            int ln = C.lane; asm volatile("" : "+v"(ln));
            f32x4 v[4][4]; float ss[4];
#pragma unroll
            for (int rr = 0; rr < 4; ++rr) { float a = 0.f;
#pragma unroll
                for (int j = 0; j < 4; ++j) { const v2u u = *(const v2u*)(xcur + (size_t)(t0 + rr) * D + 4 * (ln + 64 * j));
                    v[rr][j] = (f32x4){bf2f(u.x & 0xffffu), bf2f(u.x >> 16), bf2f(u.y & 0xffffu), bf2f(u.y >> 16)}; a += (v[rr][j].x * v[rr][j].x + v[rr][j].y * v[rr][j].y) + (v[rr][j].z * v[rr][j].z + v[rr][j].w * v[rr][j].w); }
                ss[rr] = a; }
            float rinv[4];
#pragma unroll
            for (int rr = 0; rr < 4; ++rr) rinv[rr] = rsqrtf(wave_sum(ss[rr]) * (1.f / D) + EPS);
            f32x4 h[4][4];
#pragma unroll
            for (int j = 0; j < 4; ++j) { const int i0 = 4 * (ln + 64 * j);
                const f32x4 g = *(const f32x4*)(p_nfg + l * D + i0), sh = *(const f32x4*)(mrow + 3 * 1024 + i0), scl = *(const f32x4*)(mrow + 4 * 1024 + i0);
                const f32x4 gs = g * (scl + 1.f);
#pragma unroll
                for (int rr = 0; rr < 4; ++rr) { h[rr][j] = v[rr][j] * rinv[rr] * gs + sh;
                    v2u o; o.x = pk2(h[rr][j].x, h[rr][j].y); o.y = pk2(h[rr][j].z, h[rr][j].w);
                    *(v2u*)(H + (size_t)(t0 + rr) * D + i0) = o; } }
            float res[4];
            router_dots4(h, wl, C.lane, res);
            const float rb = p_rb[l * NE + (C.lane >> 1)];
#pragma unroll
            for (int rr = 0; rr < 4; ++rr) {
                float mine = res[rr] + rb;
                float tv[4]; int te[4];
#pragma unroll
                for (int k = 0; k < 4; ++k) {
                    const float mx = wave_max(mine);
                    const unsigned long long bm = __ballot(mine == mx);
                    const int idx = __builtin_ctzll(bm) >> 1;
                    tv[k] = mx; te[k] = idx;
                    if ((C.lane >> 1) == idx) mine = NEGBIG * 2.f;
                }
                const float e1 = __expf(tv[1] - tv[0]), e2 = __expf(tv[2] - tv[0]), e3 = __expf(tv[3] - tv[0]);
                const float inv = 1.f / (1.f + e1 + e2 + e3);
                if (C.lane < 4) {
                    const int k = C.lane, ri = ri0 + rr, t = t0 + rr;
                    const int ek = (k == 0) ? te[0] : (k == 1) ? te[1] : (k == 2) ? te[2] : te[3];
                    const float gk = ((k == 0) ? 1.f : (k == 1) ? e1 : (k == 2) ? e2 : e3) * inv;
                    tope[t * 4 + k] = ek; topg[t * 4 + k] = gk;
                    le[ri * 4 + k] = ek; ls[ri * 4 + k] = (int)atomicAdd((unsigned*)(lcnt + ek), 1u); lg[ri * 4 + k] = gk;
                }
            }
        }
        __syncthreads();
        int tt = C.tid; asm volatile("" : "+v"(tt));
        if (tt < 32) lbase[tt] = atomicAdd(cnt + tt, lcnt[tt]);
        __syncthreads();
        if (tt < 256) { const int e = le[tt], s = (int)lbase[e] + ls[tt]; slot[(size_t)chunk * 256 + tt] = s;
            if (!dup) { etok[e * 16384 + s] = chunk * 64 + (tt >> 2); egate[e * 16384 + s] = lg[tt]; } }
        __syncthreads();
    }
}

__device__ __forceinline__ void p_gather(const Ctx& C0, int l) {
    PHASE_PROLOG(C0);
    const bf16* H = WSP(bf16, WS_H); bf16* XG = WSP(bf16, WS_XG);
    const int* tope = WSP(int, WS_TOPE); const float* topg = WSP(float, WS_TOPG); const int* slot = WSP(int, WS_SLOT);
    int* rpos = WSP(int, WS_RPOS); float* rgate = WSP(float, WS_RGATE);
    const unsigned* cnt = WSP(unsigned, WS_CTL) + CW_CNT + l * 32;
    int pad = 0; if (C.lane < 32) pad = ((int)cnt[C.lane] + 255) & ~255;
    int inc = pad;
#pragma unroll
    for (int o = 1; o < 32; o <<= 1) { const int u = shl_(inc, C.lane - o); if (C.lane >= o) inc += u; }
    const int pstart = inc - pad;
    for (int t = C.gw; t < T; t += C.NGW) {
        const v4u h0 = *(const v4u*)(H + (size_t)t * D + 8 * C.lane), h1 = *(const v4u*)(H + (size_t)t * D + 512 + 8 * C.lane);
#pragma unroll
        for (int k = 0; k < 4; ++k) {
            const int e = tope[t * 4 + k]; const int row = shl_(pstart, e) + slot[t * 4 + k];
            *(v4u*)(XG + (size_t)row * D + 8 * C.lane) = h0; *(v4u*)(XG + (size_t)row * D + 512 + 8 * C.lane) = h1;
            if (C.lane == 0) { rpos[t * 4 + k] = row; rgate[row] = topg[t * 4 + k]; }
        }
    }
}


#ifndef USE_MFMA_GEMM
#define USE_MFMA_GEMM 1
#endif
#ifndef DUP_MASK
#define DUP_MASK 0
#endif
#define REP(k) _Pragma("unroll 1") for (int rep_ = 0; rep_ < 1 + ((DUP_MASK >> (k)) & 1); ++rep_)
__device__ __forceinline__ bool ph_in(int lo, int hi, int k) { asm volatile("" : "+s"(lo), "+s"(hi)); return lo <= k && k < hi; }
__global__ void __launch_bounds__(NTHR, 2) mega(Args args) {
    extern __shared__ __attribute__((aligned(16))) unsigned char lds_raw[];
    Ctx C0;
    C0.in = args.in; C0.out = args.out; C0.ws = args.ws; C0.lds = (LAS unsigned char*)lds_raw;
    C0.tid = threadIdx.x; C0.lane = C0.tid & 63; C0.wave = __builtin_amdgcn_readfirstlane(C0.tid >> 6);
    C0.gw = blockIdx.x * NWAVES + C0.wave; C0.NGW = gridDim.x * NWAVES;
    const int lo = args.ph_lo, hi = args.ph_hi;
    volatile LAS unsigned* barst = (volatile LAS unsigned*)(C0.lds + LDS_BYTES - 16);
    if (C0.tid < 4) barst[C0.tid] = 0u;
    if (C0.tid < 26) ((LAS unsigned long long*)(C0.lds + LDS_BYTES - 256))[C0.tid] = (unsigned long long)args.in[C0.tid];
    __syncthreads();
    XcdBarrier bar; bar.bar = (unsigned*)(args.ws + WS_CTL) + CW_BAR; bar.x = 0; bar.st = barst;
    const bool multi = (hi - lo) > 1;
    if (multi) bar = xcd_barrier_post((unsigned*)(args.ws + WS_CTL) + CW_BAR, barst);
#define IN(k) (ph_in(lo, hi, (k)))
#define SEAM(k) do { if (IN(k) && IN((k) + 1)) xcd_barrier(bar); } while (0)

    if (IN(0)) { REP(11) p_prologue(C0);
#if USE_MFMA_GEMM
        REP(0) p_convert(C0);
#endif
    }
    SEAM(0);
    for (int l = 0; l < DEPTH; ++l) {
        const int pb = 1 + l * 9;
        const bool even = (l & 1) == 0; const int e = l >> 1;
        if (IN(pb + 0)) { REP(8) p_norm1(C0, l, rep_); }
        SEAM(pb + 0);
        if (IN(pb + 1)) REP(1) {
            PHASE_PROLOG(C0);
#if USE_MFMA_GEMM
            pg8::Gemm g{WSP(bf16, WS_H), WSP(bf16, WS_WINT) + (size_t)l * 3072 * 1024, D};
            pg8::StaticOrder So; So.init(T, even ? 2816 : 3072, (int)gridDim.x, (int)blockIdx.x);
            pg8::EpiQKV E{WSP(bf16, WS_QKV), QP, WSP(unsigned, WS_CTL) + CW_KNP + l * 384, even ? 2 : 4, even ? 4 : 8};
            pg8::gemm_phase<pg8::EpiQKV, pg8::StaticOrder, true, true>(C.lds, C.tid, g, So, E);
#else
            const float* W = even ? INP(I_EWIN) + (size_t)e * D * EVEN_IN : INP(I_OWIN) + (size_t)e * D * ODD_IN;
            const int ldw = even ? EVEN_IN : ODD_IN, NT = even ? 22 : 24;
            bf16* QKV = WSP(bf16, WS_QKV);
            auto tf = [&](int, int, const float*& W0, const float*& W1) { W0 = W; W1 = W; return true; };
            auto epi = [&](int row, int col, const float* a0, const float*) {
                v2u o; o.x = pk2(a0[0], a0[1]); o.y = pk2(a0[2], a0[3]); *(v2u*)(QKV + (size_t)row * QP + col) = o; };
            simple_gemm<1>(C, WSP(bf16, WS_H), D, T / 64, NT, D, ldw, tf, epi);
#endif
        }
        SEAM(pb + 1);
        if (even) {
            if (IN(pb + 2)) REP(2) { p_cmp_mfma(C0, l); }
            SEAM(pb + 2);
        }
        if (IN(pb + 3)) { const int nrep_ = 1 + ((DUP_MASK >> (even ? 3 : 4)) & 1);
            _Pragma("unroll 1") for (int rep_ = 0; rep_ < nrep_; ++rep_) p_attn(C0, l); }
        SEAM(pb + 3);
        if (IN(pb + 4)) REP(10) {
            PHASE_PROLOG(C0);
#if USE_MFMA_GEMM
            pg8::Gemm g{WSP(bf16, WS_AO), WSP(bf16, WS_WOUTT) + (size_t)l * 1024 * 1024, D};
            pg8::StaticOrder So; So.init(T, D, (int)gridDim.x, (int)blockIdx.x);
            pg8::EpiOut E{(l == 0) ? INP(I_X) : (const float*)nullptr, WSP(bf16, WS_XCUR), (bf16*)(ws + (rep_ ? DUMMY_OFF : (size_t)0) + WS_XCUR), WSP(float, WS_MOD) + (size_t)l * 4 * 6144 + 2 * 1024};
            pg8::gemm_phase<pg8::EpiOut, pg8::StaticOrder, true, true>(C.lds, C.tid, g, So, E);
#else
            const float* W = even ? INP(I_EWOUT) + (size_t)e * D * D : INP(I_OWOUT) + (size_t)e * D * D;
            const float* xprev = (l == 0) ? INP(I_X) : WSP(float, WS_XCUR);
            float* xcur = WSP(float, WS_XCUR); const float* mod = WSP(float, WS_MOD);
            auto tf = [&](int, int, const float*& W0, const float*& W1) { W0 = W; W1 = W; return true; };
            auto epi = [&](int row, int col, const float* a0, const float*) {
                const int b = row / S; const f32x4 g1 = *(const f32x4*)(mod + ((size_t)l * 4 + b) * 6144 + 2 * 1024 + col);
                const f32x4 xp = *(const f32x4*)(xprev + (size_t)row * D + col);
                f32x4 o; o.x = xp.x + g1.x * a0[0]; o.y = xp.y + g1.y * a0[1]; o.z = xp.z + g1.z * a0[2]; o.w = xp.w + g1.w * a0[3];
                *(f32x4*)(xcur + (size_t)row * D + col) = o; };
            simple_gemm<1>(C, WSP(bf16, WS_AO), D, T / 64, 8, D, D, tf, epi);
#endif
        }
        SEAM(pb + 4);
        if (IN(pb + 5)) { REP(9) p_norm2(C0, l, rep_); }
        SEAM(pb + 5);
        if (IN(pb + 7)) REP(6) {
            PHASE_PROLOG(C0);
#if USE_MFMA_GEMM
            LAS int* tp = (LAS int*)(C.lds + 131072);
            moe_tile_prefix(WSP(unsigned, WS_CTL) + CW_CNT + l * 32, tp, C.tid);
            pg8::Gemm g{WSP(bf16, WS_H), WSP(bf16, WS_WGUT) + (size_t)l * 32 * 2048 * 1024, D};
            pg8::MoeOrder So{tp, 8, (int)gridDim.x, (int)blockIdx.x, WSP(int, WS_ETOK)};
            pg8::EpiMoe1 E{WSP(bf16, WS_ACT), INP(I_BG) + (size_t)l * NE * FF, INP(I_BU) + (size_t)l * NE * FF, nullptr};
            pg8::gemm_phase<pg8::EpiMoe1, pg8::MoeOrder, true, true, true>(C.lds, C.tid, g, So, E);
#else
            const unsigned* cnt = WSP(unsigned, WS_CTL) + CW_CNT + l * 32;
            bf16* ACT = WSP(bf16, WS_ACT);
            const float* WG = INP(I_WG) + (size_t)l * NE * D * FF; const float* WU = INP(I_WU) + (size_t)l * NE * D * FF;
            const float* BG = INP(I_BG) + (size_t)l * NE * FF;    const float* BU = INP(I_BU) + (size_t)l * NE * FF;
            int ecur = 0;
            auto tf = [&](int mt, int, const float*& W0, const float*& W1) { const int ex = expert_of_row(cnt, mt * 64); if (ex < 0) return false;
                ecur = ex; W0 = WG + (size_t)ex * D * FF; W1 = WU + (size_t)ex * D * FF; return true; };
            auto epi = [&](int row, int col, const float* a0, const float* a1) {
                const f32x4 bg = *(const f32x4*)(BG + ecur * FF + col), bu = *(const f32x4*)(BU + ecur * FF + col);
                float o[4];
#pragma unroll
                for (int j = 0; j < 4; ++j) { const float hg = fminf(a0[j] + bg[j], 7.f), hu = fminf(fmaxf(a1[j] + bu[j], -7.f), 7.f);
                    o[j] = hg * sigmoidf_(1.702f * hg) * (hu + 1.f); }
                v2u w; w.x = pk2(o[0], o[1]); w.y = pk2(o[2], o[3]); *(v2u*)(ACT + (size_t)row * FF + col) = w; };
            simple_gemm<2>(C, WSP(bf16, WS_XG), D, PMAX / 64, 8, D, FF, tf, epi);
#endif
        }
        SEAM(pb + 7);
        if (IN(pb + 8)) REP(7) {
            PHASE_PROLOG(C0);
#if USE_MFMA_GEMM
            LAS int* tp = (LAS int*)(C.lds + 131072);
            moe_tile_prefix(WSP(unsigned, WS_CTL) + CW_CNT + l * 32, tp, C.tid);
            pg8::Gemm g{WSP(bf16, WS_ACT), WSP(bf16, WS_WDT) + (size_t)l * 32 * 1024 * 1024, FF};
            pg8::MoeOrder So{tp, 4, (int)gridDim.x, (int)blockIdx.x, WSP(int, WS_ETOK)};
            pg8::EpiMoe2 E{WSP(bf16, WS_Y), INP(I_BD) + (size_t)l * NE * D, WSP(float, WS_EGATE), tp, nullptr};
            pg8::gemm_phase<pg8::EpiMoe2, pg8::MoeOrder, true, true>(C.lds, C.tid, g, So, E);
#else
            const unsigned* cnt = WSP(unsigned, WS_CTL) + CW_CNT + l * 32;
            bf16* Y = WSP(bf16, WS_Y); const float* rgate = WSP(float, WS_RGATE);
            const float* WD = INP(I_WD) + (size_t)l * NE * FF * D; const float* BD = INP(I_BD) + (size_t)l * NE * D;
            int ecur = 0;
            auto tf = [&](int mt, int, const float*& W0, const float*& W1) { const int ex = expert_of_row(cnt, mt * 64); if (ex < 0) return false;
                ecur = ex; W0 = WD + (size_t)ex * FF * D; W1 = W0; return true; };
            auto epi = [&](int row, int col, const float* a0, const float*) {
                const f32x4 bd = *(const f32x4*)(BD + ecur * D + col); const float gt = rgate[row];
                v2u w; w.x = pk2((a0[0] + bd.x) * gt, (a0[1] + bd.y) * gt); w.y = pk2((a0[2] + bd.z) * gt, (a0[3] + bd.w) * gt);
                *(v2u*)(Y + (size_t)row * D + col) = w; };
            simple_gemm<1>(C, WSP(bf16, WS_ACT), FF, PMAX / 64, 8, FF, D, tf, epi);
#endif
        }
        SEAM(pb + 8);
    }
    if (IN(37)) { p_norm1(C0, 4); }
#undef IN
#undef SEAM
}

constexpr int NPHASE = 38;
#ifndef MK_PER_PHASE
#define MK_PER_PHASE 0
#endif

extern "C" void kernel_launch(void* const* d_in, const int* in_sizes, int n_in, void* d_out, int out_size, void* d_ws, size_t ws_size, hipStream_t stream) {
    static int grid = 0;
    if (grid == 0) {
        if (n_in != 26 || ws_size < WS_END) { fprintf(stderr, "kernel_launch: unexpected n_in %d / ws %zu\n", n_in, ws_size); grid = -1; return; }
        int dev = 0, cus = 0, per_cu = 0;
        hipGetDevice(&dev); hipDeviceGetAttribute(&cus, hipDeviceAttributeMultiprocessorCount, dev);
        hipFuncSetAttribute((const void*)mega, hipFuncAttributeMaxDynamicSharedMemorySize, LDS_BYTES);
        hipOccupancyMaxActiveBlocksPerMultiprocessor(&per_cu, (const void*)mega, NTHR, LDS_BYTES);
        (void)hipGetLastError();
        grid = cus > 0 ? cus : 256;
    }
    if (grid < 0) return;
    hipMemsetAsync((char*)d_ws + WS_CTL, 0, CTL_ZERO_BYTES, stream);
    Args a{};
    for (int i = 0; i < 26; ++i) a.in[i] = (const float*)d_in[i];
    a.out = (float*)d_out; a.ws = (unsigned char*)d_ws;
#if MK_PER_PHASE
    for (int ph = 0; ph < NPHASE; ++ph) {
        a.ph_lo = ph; a.ph_hi = ph + 1;
        hipLaunchKernelGGL(mega, dim3(grid), dim3(NTHR), LDS_BYTES, stream, a);
    }
#else
    a.ph_lo = 0; a.ph_hi = NPHASE;
    hipLaunchKernelGGL(mega, dim3(grid), dim3(NTHR), LDS_BYTES, stream, a);
#endif
}
```

```cpp
#include <hip/hip_runtime.h>
#include <stdint.h>
#include <stdio.h>

#define LAS __attribute__((address_space(3)))
#define CAS_ __attribute__((address_space(4)))
#define GAS_ __attribute__((address_space(1)))
typedef unsigned short bf16;
typedef unsigned v4u __attribute__((ext_vector_type(4)));
typedef unsigned v2u __attribute__((ext_vector_type(2)));
typedef float f32x4 __attribute__((ext_vector_type(4)));

constexpr int NB = 4, S = 4096, D = 1024, T = NB * S, DEPTH = 4;
constexpr int EVEN_IN = 2840, ODD_IN = 3088, QP = 3072;
constexpr int NE = 32, TOPK = 4, FF = 1024;
constexpr int PMAX = T * TOPK + NE * 256;
constexpr float EPS = 1e-6f, NEGBIG = -1e30f;
constexpr int C_AQ = 0, C_AK = 512, C_AV = 1024, C_BQ = 1536, C_KC = 2048, C_VC = 2176, C_KS = 2304, C_VS = 2432, C_KW = 2560, C_VW = 2688, C_BG = 2816;
constexpr int NCMP = 255;

constexpr size_t MiB = 1u << 20;
constexpr size_t WS_CTL = 0, CTL_ZERO_BYTES = 1 * MiB;
constexpr size_t WS_MOD = 1 * MiB;
constexpr size_t WS_KCMP = 2 * MiB;
constexpr size_t WS_VCMP = 2 * MiB + 512 * 1024;
constexpr size_t WS_WXT = 3 * MiB;
constexpr size_t WS_RWT = 3 * MiB + 512 * 1024;
constexpr size_t WS_GL = 4 * MiB;
constexpr size_t WS_TOPE = 6 * MiB;
constexpr size_t WS_TOPG = 6 * MiB + 256 * 1024;
constexpr size_t WS_SLOT = 6 * MiB + 512 * 1024;
constexpr size_t WS_RPOS = 6 * MiB + 768 * 1024;
constexpr size_t WS_RGATE = 7 * MiB;
constexpr size_t WS_CUM = 7 * MiB + 512 * 1024;
constexpr size_t WS_XCUR = 8 * MiB;
constexpr size_t WS_H = 72 * MiB;
constexpr size_t WS_QKV = 104 * MiB;
constexpr size_t WS_AO = 200 * MiB;
constexpr size_t WS_XG = 232 * MiB;
constexpr size_t WS_ACT = 376 * MiB;
constexpr size_t WS_Y = 520 * MiB;
constexpr size_t WS_CUMF = 664 * MiB;
constexpr size_t WS_WINT = 666 * MiB;
constexpr size_t WS_WOUTT = 690 * MiB;
constexpr size_t WS_WGUT = 698 * MiB;
constexpr size_t WS_WDT = 1210 * MiB;
constexpr size_t WS_W1T = 1466 * MiB;
constexpr size_t WS_POSB = 1468 * MiB;
constexpr size_t WS_CHTOT = 1468 * MiB + 65536;
constexpr size_t WS_ETOK = 1470 * MiB;
constexpr size_t WS_EGATE = 1472 * MiB;
constexpr size_t WS_END = 1474 * MiB;
constexpr size_t DUMMY_OFF = 1480 * MiB;
constexpr int CW_BAR = 4096;
constexpr int CW_CNT = 1024;
constexpr int CW_FQ = 2048;
constexpr int CW_EQ = 2560;
constexpr int CW_KN2 = 3584;
constexpr int CW_KNP = 8192;
constexpr int CW_KN = 3072;

constexpr int LDS_BYTES = 147456;
constexpr int NWAVES = 8, NTHR = 512;

__device__ __forceinline__ float bf2f(unsigned v) { return __uint_as_float(v << 16); }
__device__ __forceinline__ unsigned f2bf(float f) { unsigned u = __float_as_uint(f); return (u + 0x7fffu + ((u >> 16) & 1u)) >> 16; }
__device__ __forceinline__ unsigned pk2(float lo, float hi) { return f2bf(lo) | (f2bf(hi) << 16); }
template <int M> __device__ __forceinline__ float shx(float v) {
    if constexpr (M == 32) { const unsigned u = __float_as_uint(v); auto rr = __builtin_amdgcn_permlane32_swap(u, u, false, false); return __uint_as_float(rr[0] ^ rr[1] ^ u); }
    else return __int_as_float(__builtin_amdgcn_ds_swizzle(__float_as_int(v), 0x1F | (M << 10)));
}
__device__ __forceinline__ float shl_(float v, int src_lane) { return __int_as_float(__builtin_amdgcn_ds_bpermute(src_lane << 2, __float_as_int(v))); }
__device__ __forceinline__ int shl_(int v, int src_lane) { return __builtin_amdgcn_ds_bpermute(src_lane << 2, v); }
__device__ __forceinline__ float wave_sum(float v) { v += shx<1>(v); v += shx<2>(v); v += shx<4>(v); v += shx<8>(v); v += shx<16>(v); v += shx<32>(v); return v; }
__device__ __forceinline__ float wave_max(float v) { v = fmaxf(v, shx<1>(v)); v = fmaxf(v, shx<2>(v)); v = fmaxf(v, shx<4>(v)); v = fmaxf(v, shx<8>(v)); v = fmaxf(v, shx<16>(v)); v = fmaxf(v, shx<32>(v)); return v; }
__device__ __forceinline__ float sigmoidf_(float x) { return 1.f / (1.f + __expf(-x)); }
__device__ __forceinline__ float alibi8(int h) { return exp2f(-(float)(h + 1)); }
__device__ __forceinline__ float alibi4(int h) { return exp2f(-2.f * (float)(h + 1)); }

#define XB_TMO      128
#define XB_XCNT(j)  (256  + 64 * (j))
#define XB_XSUB(j)  (1280 + 64 * (j))
#define XB_XGEN(j)  (2304 + 64 * (j))
#define XB_TOP      3328
#define XB_TOPGEN   3392
#define XCD_BAR_WORDS 3456
#define XB_SPIN_CAP (1u << 24)
__device__ __forceinline__ unsigned xb_ld(unsigned* p)              { return __hip_atomic_load(p, __ATOMIC_RELAXED, __HIP_MEMORY_SCOPE_AGENT); }
__device__ __forceinline__ unsigned xb_add(unsigned* p, unsigned v) { return __hip_atomic_fetch_add(p, v, __ATOMIC_RELAXED, __HIP_MEMORY_SCOPE_AGENT); }
__device__ __forceinline__ unsigned xb_xcc_id() { return (unsigned)__builtin_amdgcn_s_getreg((3 << 11) | 20) & 0xFu; }
#define XB_SPIN(cond, bar) do { unsigned _sp = 0; while (cond) { __builtin_amdgcn_s_sleep(1); \
    if ((++_sp & 255u) == 0u) { if (xb_ld(&(bar)[XB_TMO])) break; if (_sp > XB_SPIN_CAP) { atomicAdd(&(bar)[XB_TMO], 1u); break; } } } } while (0)
struct XcdBarrier { unsigned* bar; unsigned x; volatile LAS unsigned* st; };
__device__ __forceinline__ XcdBarrier xcd_barrier_post(unsigned* bar, volatile LAS unsigned* st) {
    XcdBarrier b; b.bar = bar; b.x = xb_xcc_id(); b.st = st;
    if (threadIdx.x == 0) (void)xb_add(&bar[XB_XCNT(b.x)], 1u);
    return b;
}
__device__ __forceinline__ void xcd_barrier_complete(unsigned* bar, unsigned x, unsigned& nloc, unsigned& nx) {
    const unsigned G = gridDim.x * gridDim.y * gridDim.z;
    unsigned sum, cnt, mine, sp = 0u;
    for (;;) {
        sum = 0u; cnt = 0u; mine = 0u;
#pragma unroll
        for (unsigned j = 0; j < 16; ++j) { const unsigned c = xb_ld(&bar[XB_XCNT(j)]); sum += c; cnt += (c > 0u) ? 1u : 0u; mine = (j == x) ? c : mine; }
        if (sum == G) break;
        __builtin_amdgcn_s_sleep(1);
        if ((++sp & 255u) == 0u) { if (xb_ld(&bar[XB_TMO])) break; if (sp > XB_SPIN_CAP) { atomicAdd(&bar[XB_TMO], 1u); break; } }
    }
    nloc = mine > 0u ? mine : 1u; nx = cnt > 0u ? cnt : 1u;
}
__device__ __forceinline__ void xcd_barrier(const XcdBarrier& b) {
    asm volatile("s_waitcnt vmcnt(0)" ::: "memory");
    __syncthreads();
    if (threadIdx.x == 0) {
        unsigned* bar = b.bar; asm volatile("" : "+s"(bar));
        __builtin_amdgcn_s_waitcnt(0);
        unsigned nloc = b.st[0], nx = b.st[1];
        if (nloc == 0u) { xcd_barrier_complete(bar, b.x, nloc, nx); b.st[0] = nloc; b.st[1] = nx; }
        const unsigned old = xb_add(&bar[XB_XSUB(b.x)], 1u);
        const unsigned gen = old / nloc;
        if (old + 1u == (gen + 1u) * nloc) {
            __builtin_amdgcn_fence(__ATOMIC_RELEASE, "agent");
            asm volatile("s_waitcnt vmcnt(0)" ::: "memory");
            const unsigned og = xb_add(&bar[XB_TOP], 1u);
            const unsigned tg = og / nx;
            if (og + 1u == (tg + 1u) * nx) xb_add(&bar[XB_TOPGEN], 1u);
            else XB_SPIN(xb_ld(&bar[XB_TOPGEN]) == tg, bar);
            __builtin_amdgcn_fence(__ATOMIC_ACQUIRE, "agent");
            xb_add(&bar[XB_XGEN(b.x)], 1u);
            asm volatile("s_waitcnt vmcnt(0)" ::: "memory");
        } else {
            XB_SPIN(xb_ld(&bar[XB_XGEN(b.x)]) == gen, bar);
            __builtin_amdgcn_fence(__ATOMIC_ACQUIRE, "agent");
            asm volatile("s_waitcnt vmcnt(0)" ::: "memory");
        }
    }
    __syncthreads();
}

struct Args { const float* in[26]; float* out; unsigned char* ws; int ph_lo, ph_hi; };
enum { I_X = 0, I_C, I_ADAW, I_ADAB, I_NMG, I_NFG, I_EWIN, I_EWOUT, I_DLAM, I_DSUB, I_CPOS, I_CW1, I_CW2, I_GATEB, I_OWIN, I_OWOUT, I_FOXB,
       I_RW, I_RB, I_WG, I_BG, I_WU, I_BU, I_WD, I_BD, I_FINALG };

struct Ctx {
    const float* const* in; float* out; unsigned char* ws; LAS unsigned char* lds;
    int tid, lane, wave, gw, NGW;
};
#define PHASE_PROLOG(C0) Ctx C = (C0); { GAS_ unsigned char* wsg_ = (GAS_ unsigned char*)C.ws; asm volatile("" : "+s"(wsg_), "+s"(C.wave)); C.ws = (unsigned char*)wsg_; } { unsigned z_ = 0u; asm volatile("" : "+s"(z_)); C.lane = (int)__builtin_amdgcn_mbcnt_hi(~0u, __builtin_amdgcn_mbcnt_lo(~0u, z_)); } C.tid = C.wave * 64 + C.lane; asm volatile("" : "+v"(C.tid)); C.gw = blockIdx.x * NWAVES + C.wave; \
    unsigned char* ws = C.ws; CAS_ const unsigned char* in_ = (CAS_ const unsigned char*)__builtin_amdgcn_kernarg_segment_ptr(); asm volatile("" : "+s"(in_)); (void)ws; (void)in_
#define WSP(T_, off) ((T_*)(ws + (off)))
#define INP(i) ((const float*)(GAS_ const float*)*(CAS_ const unsigned long long*)(in_ + 8 * (i)))

__device__ __forceinline__ void p_prologue(const Ctx& C0) {
    PHASE_PROLOG(C0);
    LAS float* sc = (LAS float*)C.lds;
    LAS float* red = sc + 4096;
    for (int i = C.tid; i < 4096; i += NTHR) { const float v = INP(I_C)[i]; sc[i] = v * sigmoidf_(v); }
    __syncthreads();
    float* mod = WSP(float, WS_MOD);
    for (int item = blockIdx.x; item < 4 * 48; item += gridDim.x) {
        const int l = item / 48, n0 = (item % 48) * 128, cg = C.tid & 31, kgp = C.tid >> 5;
        const float* w = INP(I_ADAW) + (size_t)l * D * 6144 + n0 + 4 * cg;
        f32x4 acc[4];
#pragma unroll
        for (int b = 0; b < 4; ++b) acc[b] = (f32x4){0.f, 0.f, 0.f, 0.f};
#pragma unroll 1
        for (int k0 = kgp * 64; k0 < kgp * 64 + 64; k0 += 16) {
            f32x4 wv[16];
#pragma unroll
            for (int i = 0; i < 16; ++i) wv[i] = *(const f32x4*)(w + (size_t)(k0 + i) * 6144);
#pragma unroll
            for (int i = 0; i < 16; ++i)
#pragma unroll
                for (int b = 0; b < 4; ++b) acc[b] = acc[b] + wv[i] * sc[b * 1024 + k0 + i];
        }
#pragma unroll
        for (int b = 0; b < 4; ++b) *(LAS f32x4*)(red + (kgp * 4 + b) * 128 + 4 * cg) = acc[b];
        __syncthreads();
        { const int b = C.tid >> 7, col = C.tid & 127; float s = INP(I_ADAB)[l * 6144 + n0 + col];
#pragma unroll
          for (int q = 0; q < 16; ++q) s += red[(q * 4 + b) * 128 + col];
          mod[((size_t)l * 4 + b) * 6144 + n0 + col] = s; }
        __syncthreads();
    }
    float* wxt = WSP(float, WS_WXT); float* rwt = WSP(float, WS_RWT);
    const float* p_ewin = INP(I_EWIN); const float* p_owin = INP(I_OWIN); const float* p_rw = INP(I_RW);
    const int gt = blockIdx.x * NTHR + C.tid, NGT = gridDim.x * NTHR;
    for (int i = gt; i < 4 * 32 * 1024; i += NGT) {
        const int l = i >> 15, j = (i >> 10) & 31, k = i & 1023;
        const bool even = (l & 1) == 0; const int e = l >> 1;
        float v = 0.f;
        if (even) { if (j < 24) v = p_ewin[((size_t)e * D + k) * EVEN_IN + C_BG + j]; }
        else      { if (j < 16) v = p_owin[((size_t)e * D + k) * ODD_IN + 3072 + j]; }
        wxt[i] = v;
        rwt[i] = p_rw[((size_t)l * D + k) * NE + j];
    }
    __syncthreads();
    for (int item = blockIdx.x; item < 4; item += gridDim.x) {
        const float* pos = INP(I_CPOS) + (size_t)item * 2048; const float* w1 = INP(I_CW1) + (size_t)item * 2048 * 128;
        const int j = C.tid & 127, part = C.tid >> 7; float s = 0.f;
#pragma unroll 1
        for (int i0 = part * 512; i0 < part * 512 + 512; i0 += 16) { float wv[16];
#pragma unroll
            for (int i = 0; i < 16; ++i) wv[i] = w1[(size_t)(i0 + i) * 128 + j];
#pragma unroll
            for (int i = 0; i < 16; ++i) s += pos[i0 + i] * wv[i]; }
        red[part * 128 + j] = s;
        __syncthreads();
        if (C.tid < 128) WSP(float, WS_POSB)[item * 128 + C.tid] = (red[C.tid] + red[128 + C.tid]) + (red[256 + C.tid] + red[384 + C.tid]);
        __syncthreads();
    }
}

__device__ __forceinline__ void moe_tile_prefix(const unsigned* cnt, LAS int* tp, int tid) {
    if (tid < 64) {
        int tl = 0; if (tid < 32) tl = ((int)cnt[tid] + 255) >> 8;
        int inc = tl;
#pragma unroll
        for (int o = 1; o < 32; o <<= 1) { const int u = shl_(inc, tid - o); if (tid >= o) inc += u; }
        if (tid < 32) { tp[tid + 1] = inc; tp[64 + tid] = (int)cnt[tid]; }
        if (tid == 0) tp[0] = 0;
    }
    __syncthreads();
}


template <int N, int MASK> struct TreeStage {
    template <int NV> static __device__ __forceinline__ void run(float (&v)[NV], int lane) {
        const bool up = (lane & MASK) != 0;
#pragma unroll
        for (int i = 0; i < N / 2; ++i) { const float a = v[i], b = v[i + N / 2]; const float send = up ? a : b, keep = up ? b : a; v[i] = keep + shx<MASK>(send); }
        TreeStage<N / 2, MASK / 2>::run(v, lane);
    }
};
template <int MASK> struct TreeStage<1, MASK> { template <int NV> static __device__ __forceinline__ void run(float (&)[NV], int) {} };
template <int NV> __device__ __forceinline__ float tree_reduce(float (&v)[NV], int lane) {
    TreeStage<NV, 32>::run(v, lane);
    float r = v[0];
    if (NV == 16) r += shx<2>(r);
    r += shx<1>(r);
    return r;
}

template <int NV> __device__ __forceinline__ void norm1_extras(const f32x4 (&h)[2][4], const LAS float* wl_in, int nx, int lane, float (&res)[2]) {
    const LAS float* wl = wl_in; asm volatile("" : "+v"(wl) : "v"(h[0][0].x), "v"(h[1][0].x), "v"(h[0][3].w), "v"(h[1][3].w));
    float v0[NV], v1[NV];
#pragma unroll
    for (int c = 0; c < NV; ++c) {
        float p0 = 0.f, p1 = 0.f;
        if (c < nx) {
            typedef float f32x2_ __attribute__((ext_vector_type(2)));
            f32x2_ a0 = {0.f, 0.f}, a1 = {0.f, 0.f};
#pragma unroll
            for (int j = 0; j < 4; ++j) { const f32x4 w = *(const LAS f32x4*)(wl + c * 1024 + 4 * (lane + 64 * j));
                a0 = __builtin_elementwise_fma(h[0][j].xy, w.xy, a0); a0 = __builtin_elementwise_fma(h[0][j].zw, w.zw, a0);
                a1 = __builtin_elementwise_fma(h[1][j].xy, w.xy, a1); a1 = __builtin_elementwise_fma(h[1][j].zw, w.zw, a1); }
            p0 = a0.x + a0.y; p1 = a1.x + a1.y;
        }
        asm volatile("" : "+v"(p0), "+v"(p1));
        v0[c] = p0; v1[c] = p1;
    }
    res[0] = tree_reduce<NV>(v0, lane); res[1] = tree_reduce<NV>(v1, lane);
}
__device__ __forceinline__ void router_dots4(const f32x4 (&h)[4][4], const LAS float* wl_in, int lane, float (&res)[4]) {
    typedef float f32x2_ __attribute__((ext_vector_type(2)));
    const LAS float* wl = wl_in; asm volatile("" : "+v"(wl) : "v"(h[0][0].x), "v"(h[1][0].x), "v"(h[2][3].w), "v"(h[3][3].w));
    float v[4][16];
    const bool up = (lane & 32) != 0;
#pragma unroll
    for (int c = 0; c < 32; ++c) {
        f32x2_ a[4];
#pragma unroll
        for (int r = 0; r < 4; ++r) a[r] = (f32x2_){0.f, 0.f};
#pragma unroll
        for (int j = 0; j < 4; ++j) { const f32x4 w = *(const LAS f32x4*)(wl + c * 1024 + 4 * (lane + 64 * j));
#pragma unroll
            for (int r = 0; r < 4; ++r) { a[r] = __builtin_elementwise_fma(h[r][j].xy, w.xy, a[r]); a[r] = __builtin_elementwise_fma(h[r][j].zw, w.zw, a[r]); } }
        float p[4];
#pragma unroll
        for (int r = 0; r < 4; ++r) p[r] = a[r].x + a[r].y;
        asm volatile("" : "+v"(p[0]), "+v"(p[1]), "+v"(p[2]), "+v"(p[3]));
#pragma unroll
        for (int r = 0; r < 4; ++r) {
            if (c < 16) v[r][c] = p[r];
            else { const float lo = v[r][c - 16], hi = p[r]; const float send = up ? lo : hi, keep = up ? hi : lo; v[r][c - 16] = keep + shx<32>(send); }
        }
    }
#pragma unroll
    for (int r = 0; r < 4; ++r) { TreeStage<16, 16>::run(v[r], lane); float t = v[r][0]; t += shx<1>(t); res[r] = t; }
}
__device__ __forceinline__ void p_norm1(const Ctx& C0, int l, int dup = 0) {
    PHASE_PROLOG(C0);
    unsigned char* wsw = ws + (dup ? DUMMY_OFF : (size_t)0);
    const bf16* xcur = WSP(bf16, WS_XCUR); const float* mod = WSP(float, WS_MOD);
    const bf16* Y = WSP(bf16, WS_Y); const int* tope = WSP(int, WS_TOPE); const int* slot = WSP(int, WS_SLOT);
    v2u xn[2][4]; int ten[2][4], sln[2][4];
#define N1_FETCH(tn) do { _Pragma("unroll") for (int rr = 0; rr < 2; ++rr) { \
        _Pragma("unroll") for (int j = 0; j < 4; ++j) xn[rr][j] = *(const v2u*)(xcur + (size_t)((tn) + rr) * D + 4 * (C.lane + 64 * j)); \
        _Pragma("unroll") for (int k = 0; k < 4; ++k) { ten[rr][k] = tope[((tn) + rr) * 4 + k]; sln[rr][k] = slot[((tn) + rr) * 4 + k]; } } } while (0)
    if (l > 0 && (int)blockIdx.x < T / 64) N1_FETCH((int)blockIdx.x * 64 + C.wave * 8);
    LAS int* tpl = (LAS int*)(C.lds + 102400);
    if (l > 0) moe_tile_prefix(WSP(unsigned, WS_CTL) + CW_CNT + (l - 1) * 32, tpl, C.tid);
    const float* wxt = WSP(float, WS_WXT) + (size_t)(l & 3) * 32 * 1024;
    const bool even = (l & 1) == 0;
    LAS float* wl = (LAS float*)C.lds;
    LAS float* lsgl = (LAS float*)(C.lds + 98304);
    const int nx = even ? 24 : 16;
    const float* p_x = INP(I_X); const float* p_fg = INP(I_FINALG); const float* p_nmg = INP(I_NMG); const float* p_gb = INP(I_GATEB); const float* p_fb = INP(I_FOXB);
    if (l < 4) {
        for (int i = C.tid; i < nx * 256; i += NTHR) *(LAS f32x4*)(wl + 4 * i) = *(const f32x4*)(wxt + 4 * i);
        __syncthreads(); }
    for (int chunk = blockIdx.x; chunk < T / 64; chunk += gridDim.x) {
        const int b = (chunk * 64) / S;
        const float* mrow = mod + ((size_t)(l & 3) * 4 + b) * 6144;
        if (l > 0 && chunk != (int)blockIdx.x) N1_FETCH(chunk * 64 + C.wave * 8);
#pragma unroll 1
        for (int pr = 0; pr < 4; ++pr) {
            const int t0 = chunk * 64 + C.wave * 8 + pr * 2;
            f32x4 v[2][4];
#pragma unroll
            for (int rr = 0; rr < 2; ++rr)
#pragma unroll
                for (int j = 0; j < 4; ++j) {
                    if (l == 0) v[rr][j] = *(const f32x4*)(p_x + (size_t)(t0 + rr) * D + 4 * (C.lane + 64 * j));
                    else { const v2u u = xn[rr][j];
                        v[rr][j] = (f32x4){bf2f(u.x & 0xffffu), bf2f(u.x >> 16), bf2f(u.y & 0xffffu), bf2f(u.y >> 16)}; } }
            if (l > 0) {
                const float* g2 = mod + ((size_t)(l - 1) * 4 + b) * 6144 + 5 * 1024;
                int rp[2][4];
#pragma unroll
                for (int rr = 0; rr < 2; ++rr)
#pragma unroll
                    for (int k = 0; k < 4; ++k) rp[rr][k] = 256 * tpl[ten[rr][k]] + sln[rr][k];
                if (pr < 3) N1_FETCH(t0 + 2);
                f32x4 s[2][4];
#pragma unroll
                for (int rr = 0; rr < 2; ++rr)
#pragma unroll
                    for (int j = 0; j < 4; ++j) s[rr][j] = (f32x4){0.f, 0.f, 0.f, 0.f};
#pragma unroll
                for (int rr = 0; rr < 2; ++rr)
#pragma unroll
                    for (int k = 0; k < 4; ++k)
#pragma unroll
                        for (int j = 0; j < 4; ++j) { const v2u u = *(const v2u*)(Y + (size_t)rp[rr][k] * D + 4 * (C.lane + 64 * j));
                            s[rr][j].x += bf2f(u.x & 0xffffu); s[rr][j].y += bf2f(u.x >> 16); s[rr][j].z += bf2f(u.y & 0xffffu); s[rr][j].w += bf2f(u.y >> 16); }
#pragma unroll
                for (int j = 0; j < 4; ++j) { const f32x4 g = *(const f32x4*)(g2 + 4 * (C.lane + 64 * j));
#pragma unroll
                    for (int rr = 0; rr < 2; ++rr) { v[rr][j] = v[rr][j] + g * s[rr][j];
                        if (l < 4) { v2u o; o.x = pk2(v[rr][j].x, v[rr][j].y); o.y = pk2(v[rr][j].z, v[rr][j].w);
                            *(v2u*)((bf16*)(wsw + WS_XCUR) + (size_t)(t0 + rr) * D + 4 * (C.lane + 64 * j)) = o; } } }
            }
            float ss[2];
#pragma unroll
            for (int rr = 0; rr < 2; ++rr) { float a = 0.f;
#pragma unroll
                for (int j = 0; j < 4; ++j) a += (v[rr][j].x * v[rr][j].x + v[rr][j].y * v[rr][j].y) + (v[rr][j].z * v[rr][j].z + v[rr][j].w * v[rr][j].w);
                ss[rr] = a; }
            ss[0] = wave_sum(ss[0]); ss[1] = wave_sum(ss[1]);
            const float r0 = rsqrtf(ss[0] * (1.f / D) + EPS), r1 = rsqrtf(ss[1] * (1.f / D) + EPS);
            if (l == 4) {
#pragma unroll
                for (int j = 0; j < 4; ++j) { const f32x4 g = *(const f32x4*)(p_fg + 4 * (C.lane + 64 * j));
                    float* ob = dup ? (float*)(wsw + WS_XCUR) : C.out;
                    *(f32x4*)(ob + (size_t)t0 * D + 4 * (C.lane + 64 * j)) = v[0][j] * r0 * g;
                    *(f32x4*)(ob + (size_t)(t0 + 1) * D + 4 * (C.lane + 64 * j)) = v[1][j] * r1 * g; }
                continue;
            }
            f32x4 h[2][4];
#pragma unroll
            for (int j = 0; j < 4; ++j) { const int i0 = 4 * (C.lane + 64 * j);
                const f32x4 g = *(const f32x4*)(p_nmg + l * D + i0), sh = *(const f32x4*)(mrow + i0), scl = *(const f32x4*)(mrow + 1024 + i0);
                const f32x4 gs = g * (scl + 1.f);
                h[0][j] = v[0][j] * r0 * gs + sh; h[1][j] = v[1][j] * r1 * gs + sh;
#pragma unroll
                for (int rr = 0; rr < 2; ++rr) { v2u o; o.x = pk2(h[rr][j].x, h[rr][j].y); o.y = pk2(h[rr][j].z, h[rr][j].w);
                    *(v2u*)((bf16*)(wsw + WS_H) + (size_t)(t0 + rr) * D + i0) = o; } }
            float res[2];
            if (even) {
                norm1_extras<32>(h, wl, 24, C.lane, res);
                const int c = C.lane >> 1;
                if ((C.lane & 1) == 0 && c < 24) { const float gb = p_gb[(l >> 1) * 24 + c];
                    ((float*)(wsw + WS_GL))[(size_t)t0 * 32 + c] = res[0] + gb; ((float*)(wsw + WS_GL))[(size_t)(t0 + 1) * 32 + c] = res[1] + gb; }
            } else {
                norm1_extras<16>(h, wl, 16, C.lane, res);
                const int c = C.lane >> 2;
                if ((C.lane & 3) == 0) { const float fb = p_fb[(l >> 1) * 16 + c];
#pragma unroll
                    for (int rr = 0; rr < 2; ++rr) { const float z = res[rr] + fb; lsgl[(C.wave * 8 + pr * 2 + rr) * 16 + c] = fminf(z, 0.f) - log1pf(__expf(-fabsf(z))); } }
            }
        }
#undef N1_FETCH
        if (l < 4 && !even) {
            __syncthreads();
            if (C.tid < 16 && !dup) { float run = 0.f; float* cum = WSP(float, WS_CUMF);
                for (int i = 0; i < 64; ++i) { run += lsgl[i * 16 + C.tid]; cum[(size_t)(chunk * 64 + i) * 16 + C.tid] = run; }
                WSP(float, WS_CHTOT)[chunk * 16 + C.tid] = run; }
            __syncthreads();
        }
    }
}

template <int NW, class TileFn, class Epi>
__device__ __forceinline__ void simple_gemm(Ctx& C, const bf16* Abase, int lda, int MT, int NT, int K, int ldw, const TileFn& tf, const Epi& epi) {
    LAS float* As = (LAS float*)C.lds;
    LAS float* Ws = As + 64 * 17;
    const int ty = C.tid >> 5, tx = C.tid & 31;
    for (int tile = blockIdx.x; tile < MT * NT; tile += gridDim.x) {
        const int mt = tile / NT, nt = tile % NT;
        const float* W0 = nullptr; const float* W1 = nullptr;
        if (!tf(mt, nt, W0, W1)) continue;
        float acc[NW][4][4];
#pragma unroll
        for (int w = 0; w < NW; ++w)
#pragma unroll
            for (int i = 0; i < 4; ++i)
#pragma unroll
                for (int j = 0; j < 4; ++j) acc[w][i][j] = 0.f;
        for (int k0 = 0; k0 < K; k0 += 16) {
            __syncthreads();
            { const int r = C.tid >> 3, kk = (C.tid & 7) * 2;
              const unsigned u = *(const unsigned*)(Abase + (size_t)(mt * 64 + r) * lda + k0 + kk);
              As[r * 17 + kk] = bf2f(u & 0xffffu); As[r * 17 + kk + 1] = bf2f(u >> 16); }
#pragma unroll
            for (int w = 0; w < NW; ++w) { const float* Wp = w == 0 ? W0 : W1;
                const int kk = C.tid >> 5, c4 = (C.tid & 31) * 4;
                *(LAS f32x4*)(Ws + (w * 16 + kk) * 128 + c4) = *(const f32x4*)(Wp + (size_t)(k0 + kk) * ldw + nt * 128 + c4); }
            __syncthreads();
#pragma unroll
            for (int kk = 0; kk < 16; ++kk) {
                float a[4];
#pragma unroll
                for (int i = 0; i < 4; ++i) a[i] = As[(ty * 4 + i) * 17 + kk];
#pragma unroll
                for (int w = 0; w < NW; ++w) { const f32x4 wv = *(const LAS f32x4*)(Ws + (w * 16 + kk) * 128 + tx * 4);
#pragma unroll
                    for (int i = 0; i < 4; ++i) { acc[w][i][0] += a[i] * wv.x; acc[w][i][1] += a[i] * wv.y; acc[w][i][2] += a[i] * wv.z; acc[w][i][3] += a[i] * wv.w; } }
            }
        }
#pragma unroll
        for (int i = 0; i < 4; ++i) epi(mt * 64 + ty * 4 + i, nt * 128 + tx * 4, acc[0][i], acc[NW - 1][i]);
    }
    __syncthreads();
}

__device__ __forceinline__ int expert_of_row(const unsigned* cnt, int r0) {
    int start = 0;
    for (int e = 0; e < NE; ++e) { const int pad = ((int)cnt[e] + 255) & ~255; if (r0 < start + pad) return e; start += pad; }
    return -1;
}


namespace pg8 {
typedef short bf16x8 __attribute__((ext_vector_type(8)));
typedef unsigned u32x4 __attribute__((ext_vector_type(4)));
constexpr int BM = 256, BK = 64, HALF = 128, HTB = HALF * BK * 2, STAGE_BYTES = 8 * HTB, NXCD = 8, WGM = 8;
__device__ __forceinline__ int lds_byte(int r, int c) { const int st = (r >> 4) * 2 + (c >> 5), rr = r & 15, cc = c & 31, ob = rr * 64 + cc * 2; return st * 1024 + (ob ^ (((ob >> 9) & 1) << 5)); }
__device__ __forceinline__ void stage_rc(int b, int& R, int& C) { const int st = b / 1024, sb = b % 1024, swz = sb ^ (((sb >> 9) & 1) << 5); R = (st >> 1) * 16 + swz / 64; C = (st & 1) * 32 + (swz % 64) / 2; }
__device__ __forceinline__ int perm32(int rho) { const int n = rho >> 4, i = rho & 15; return 8 * (i >> 2) + 4 * n + (i & 3); }
struct Unit { int pm, pn, pb; };
struct Gemm { const bf16* A; const bf16* Bt; int K; };
struct StaticOrder {
    int nM, nN, nwg, G, c;
    __device__ void init(int M, int N, int G_, int c_) { nM = M / BM; nN = N / BM; nwg = nM * nN; G = G_; c = c_; }
    __device__ bool next(int i, Unit& u) const {
        const long L = (long)i * G + c; if (L >= nwg) return false;
        int wgid = (int)L; { const int q = nwg / NXCD, r = nwg % NXCD, xcd = wgid % NXCD, off = wgid / NXCD; wgid = (xcd < r ? xcd * (q + 1) : r * (q + 1) + (xcd - r) * q) + off; }
        const int nig = WGM * nN, gid = wgid / nig, fm = gid * WGM, gsz = (nM - fm) < WGM ? (nM - fm) : WGM;
        u.pm = fm + ((wgid % nig) % gsz); u.pn = (wgid % nig) / gsz; u.pb = u.pn; return true;
    }
    __device__ __forceinline__ const int* a_ptr(const Unit&, int) const { return nullptr; }
};
struct MoeOrder {
    const LAS int* tp; int NPN, G, c; const int* etok;
    __device__ bool next(int i, Unit& u) const {
        const int L = i * G + c; const int pm = L / NPN; if (pm >= __builtin_amdgcn_readfirstlane(tp[32])) return false;
        int e = 0;
        for (int k = 1; k < 32; ++k) e += (pm >= tp[k]) ? 1 : 0;
        e = __builtin_amdgcn_readfirstlane(e);
        u.pm = pm; u.pn = L - pm * NPN; u.pb = e * NPN + u.pn; return true;
    }
    __device__ __forceinline__ const int* a_ptr(const Unit& u, int row) const {
        const int e = u.pb / NPN; int s = (u.pm - tp[e]) * 256 + row; const int ce = tp[64 + e] - 1; s = s < ce ? s : ce;
        return etok + e * 16384 + s;
    }
};
__device__ __forceinline__ unsigned cvt_pk_bf16(float lo, float hi) { unsigned r; asm volatile("v_cvt_pk_bf16_f32 %0, %1, %2" : "=v"(r) : "v"(lo), "v"(hi)); return r; }

template <class Epi, class Sched, bool ALIGN_EPI, bool SP2, bool GATHER = false>
__device__ __forceinline__ void gemm_phase(LAS unsigned char* lds, const int tid, const Gemm g, const Sched& S, const Epi& E_in) {
    Epi E = E_in;
    const int wid = __builtin_amdgcn_readfirstlane(tid >> 6), lane = tid & 63, wr = wid >> 2, wc = wid & 3, fr = lane & 15, fq = lane >> 4;
    const int K = g.K, nt = K / BK;
    unsigned voffA[2], voffB[2];
#pragma unroll
    for (int i = 0; i < 2; ++i) { int R, C; stage_rc(tid * 16 + i * 8192, R, C); const int Rb = Epi::PERM ? ((R & ~31) + perm32(R & 31)) : R;
        voffA[i] = (unsigned)(R * K + C) * 2u; voffB[i] = (unsigned)(Rb * K + C) * 2u; }
    const size_t kstep = (size_t)(BK * 2);
    const size_t hstep = (size_t)HALF * K * 2;
    const size_t tstep = 2 * hstep;
    const unsigned ldsw = (unsigned)wid * 1024u;
    const int aoff = lds_byte(wr * 64 + fr, fq * 8), boff = lds_byte(wc * 32 + fr, fq * 8);
#define PG8_SA(b, h) (((b) * 2 + (h)) * HTB)
#define PG8_SB(b, h) ((4 + (b) * 2 + (h)) * HTB)
#define PG8_STAGE(bufoff, gbase, voff) do { _Pragma("unroll") for (int _i = 0; _i < 2; ++_i) \
        __builtin_amdgcn_global_load_lds((const unsigned*)((const char*)(gbase) + (voff)[_i]), (LAS unsigned*)(lds + (bufoff) + ldsw + _i * 8192), 16, 0, 0); } while (0)
#define PG8_STAGE2(bufoff, gbase, o0, o1) do { \
        __builtin_amdgcn_global_load_lds((const unsigned*)((const char*)(gbase) + (o0)), (LAS unsigned*)(lds + (bufoff) + ldsw), 16, 0, 0); \
        __builtin_amdgcn_global_load_lds((const unsigned*)((const char*)(gbase) + (o1)), (LAS unsigned*)(lds + (bufoff) + ldsw + 8192), 16, 0, 0); } while (0)
#define PG8_LDA(dst, b, h) do { _Pragma("unroll") for (int m = 0; m < 4; ++m) _Pragma("unroll") for (int k = 0; k < 2; ++k) dst[m][k] = *(const LAS bf16x8*)(lds + PG8_SA(b, h) + aoff + m * 2048 + k * 1024); } while (0)
#define PG8_LDB(dst, b, h) do { _Pragma("unroll") for (int n = 0; n < 2; ++n) _Pragma("unroll") for (int k = 0; k < 2; ++k) dst[n][k] = *(const LAS bf16x8*)(lds + PG8_SB(b, h) + boff + n * 2048 + k * 1024); } while (0)
#define PG8_MMA(ai, bj, At, Bt) do { __builtin_amdgcn_s_setprio(1); _Pragma("unroll") for (int m = 0; m < 4; ++m) _Pragma("unroll") for (int n = 0; n < 2; ++n) _Pragma("unroll") for (int k = 0; k < 2; ++k) \
        acc[ai][bj][m][n] = __builtin_amdgcn_mfma_f32_16x16x32_bf16(Bt[n][k], At[m][k], acc[ai][bj][m][n], 0, 0, 0); __builtin_amdgcn_s_setprio(0); } while (0)
#define PG8_WAIT_V(n) asm volatile("s_waitcnt vmcnt(" #n ")" ::: "memory")
#define PG8_WAIT_L(n) asm volatile("s_waitcnt lgkmcnt(" #n ")" ::: "memory")
#define PG8_BAR __builtin_amdgcn_s_barrier()
#define PG8_SCHED __builtin_amdgcn_sched_barrier(0)
    Unit cur, nxt; int ui = 0;
    if (!S.next(0, cur)) return;
    f32x4 acc[2][2][4][2];
#pragma unroll
    for (int a = 0; a < 2; ++a)
#pragma unroll
        for (int b = 0; b < 2; ++b)
#pragma unroll
            for (int m = 0; m < 4; ++m)
#pragma unroll
                for (int n = 0; n < 2; ++n) acc[a][b][m][n] = (f32x4){0.f, 0.f, 0.f, 0.f};
    bf16x8 At[4][2], B0[2][2], B1[2][2];
    static_assert(!GATHER || SP2, "gathered A rows: SP2 loop only");
    const size_t ahs = GATHER ? (size_t)0 : hstep;
    constexpr int GOFF = STAGE_BYTES + 1024;
    unsigned vA[2][2], cc[2];
#pragma unroll
    for (int i = 0; i < 2; ++i) { int R, C; stage_rc(tid * 16 + i * 8192, R, C); cc[i] = (unsigned)(C * 2); vA[0][i] = voffA[i]; vA[1][i] = voffA[i]; }
    if constexpr (GATHER) {
#pragma unroll
        for (int h = 0; h < 2; ++h)
#pragma unroll
            for (int i = 0; i < 2; ++i) { int R, C; stage_rc(tid * 16 + i * 8192, R, C); vA[h][i] = (unsigned)(*S.a_ptr(cur, h * HALF + R)) * 2048u + cc[i]; }
    }
    const char* cA = (const char*)g.A + (GATHER ? (size_t)0 : (size_t)cur.pm * tstep); const char* cB = (const char*)g.Bt + (size_t)cur.pb * tstep;
    if constexpr (SP2) {
        PG8_STAGE(PG8_SB(0, 0), cB, voffB); PG8_STAGE(PG8_SB(0, 1), cB + hstep, voffB); PG8_STAGE2(PG8_SA(0, 0), cA, vA[0][0], vA[0][1]); PG8_STAGE2(PG8_SA(0, 1), cA + ahs, vA[1][0], vA[1][1]);
        if (wr == 1) PG8_BAR;
        PG8_WAIT_V(2); PG8_BAR;
        PG8_STAGE(PG8_SB(1, 0), cB + kstep, voffB); PG8_STAGE2(PG8_SA(1, 0), cA + kstep, vA[0][0], vA[0][1]); PG8_STAGE(PG8_SB(1, 1), cB + hstep + kstep, voffB);
        PG8_WAIT_V(6); PG8_BAR;
    } else {
        PG8_STAGE(PG8_SB(0, 0), cB, voffB); PG8_STAGE(PG8_SA(0, 0), cA, voffA); PG8_STAGE(PG8_SB(0, 1), cB + hstep, voffB); PG8_STAGE(PG8_SA(0, 1), cA + hstep, voffA);
        if (wr == 1) PG8_BAR;
        PG8_WAIT_V(4); PG8_BAR;
        PG8_STAGE(PG8_SB(1, 0), cB + kstep, voffB); PG8_STAGE(PG8_SA(1, 0), cA + kstep, voffA); PG8_STAGE(PG8_SB(1, 1), cB + hstep + kstep, voffB);
        PG8_WAIT_V(6); PG8_BAR;
    }
    for (;;) {
        const bool has_next = S.next(ui + 1, nxt);
        E.prefetch(lds, cur, ui, wid, lane);
        const char* nA = GATHER ? (const char*)g.A : (has_next ? (const char*)g.A + (size_t)nxt.pm * tstep : cA); const char* nB = has_next ? (const char*)g.Bt + (size_t)nxt.pb * tstep : cB;
        if constexpr (GATHER) {
            if (has_next) {
#pragma unroll
                for (int h = 0; h < 2; ++h)
#pragma unroll
                    for (int i = 0; i < 2; ++i) { int R, C; stage_rc(tid * 16 + i * 8192, R, C);
                        __builtin_amdgcn_global_load_lds((const unsigned*)S.a_ptr(nxt, h * HALF + R), (LAS unsigned*)(lds + GOFF + (h * 2 + i) * 2048 + wid * 256), 4, 0, 0); }
            }
        }
        for (int t = 0; t < nt; t += 2) {
            const bool last = (t == nt - 2);
            const char* a1 = cA + (size_t)(t + 1) * kstep;
            const char* a2 = last ? nA : cA + (size_t)(t + 2) * kstep; const char* b2 = last ? nB : cB + (size_t)(t + 2) * kstep;
            const char* a3 = a2 + kstep; const char* b3 = b2 + kstep;
            if constexpr (SP2) {
            PG8_LDB(B0, 0, 0); PG8_LDB(B1, 0, 1); PG8_SCHED; PG8_LDA(At, 0, 0); PG8_STAGE2(PG8_SA(1, 1), a1 + ahs, vA[1][0], vA[1][1]);
            if constexpr (GATHER) { if (last && has_next) {
#pragma unroll
                for (int h = 0; h < 2; ++h)
#pragma unroll
                    for (int i = 0; i < 2; ++i) vA[h][i] = *(const LAS unsigned*)(lds + GOFF + (h * 2 + i) * 2048 + tid * 4) * 2048u + cc[i]; } }
            PG8_WAIT_V(8); PG8_WAIT_L(0); PG8_BAR; PG8_MMA(0, 0, At, B0); PG8_MMA(0, 1, At, B1); PG8_BAR; PG8_SCHED;
            PG8_LDA(At, 0, 1); PG8_STAGE(PG8_SB(0, 0), b2, voffB); PG8_STAGE(PG8_SB(0, 1), b2 + hstep, voffB); PG8_STAGE2(PG8_SA(0, 0), a2, vA[0][0], vA[0][1]);
            PG8_WAIT_V(8); PG8_WAIT_L(0); PG8_BAR; PG8_MMA(1, 0, At, B0); PG8_MMA(1, 1, At, B1); PG8_BAR; PG8_SCHED;
            PG8_LDB(B0, 1, 0); PG8_LDB(B1, 1, 1); PG8_SCHED; PG8_LDA(At, 1, 0); PG8_STAGE2(PG8_SA(0, 1), a2 + ahs, vA[1][0], vA[1][1]);
            PG8_WAIT_V(8); PG8_WAIT_L(0); PG8_BAR; PG8_MMA(0, 0, At, B0); PG8_MMA(0, 1, At, B1); PG8_BAR; PG8_SCHED;
            PG8_LDA(At, 1, 1); PG8_STAGE(PG8_SB(1, 0), b3, voffB); PG8_STAGE(PG8_SB(1, 1), b3 + hstep, voffB); PG8_STAGE2(PG8_SA(1, 0), a3, vA[0][0], vA[0][1]);
            PG8_WAIT_V(8); PG8_WAIT_L(0); PG8_BAR; PG8_MMA(1, 0, At, B0); PG8_MMA(1, 1, At, B1); PG8_BAR; PG8_SCHED;
            } else {
            PG8_LDB(B0, 0, 0); PG8_SCHED; PG8_LDA(At, 0, 0); PG8_STAGE(PG8_SA(1, 1), a1 + hstep, voffA);
            PG8_WAIT_L(8); PG8_BAR; PG8_WAIT_L(0); PG8_MMA(0, 0, At, B0); PG8_BAR; PG8_SCHED;
            PG8_LDB(B1, 0, 1); PG8_STAGE(PG8_SB(0, 0), b2, voffB);
            PG8_BAR; PG8_WAIT_L(0); PG8_MMA(0, 1, At, B1); PG8_BAR;
            PG8_LDA(At, 0, 1); PG8_STAGE(PG8_SA(0, 0), a2, voffA);
            PG8_BAR; PG8_WAIT_L(0); PG8_MMA(1, 0, At, B0); PG8_BAR; PG8_SCHED;
            PG8_STAGE(PG8_SB(0, 1), b2 + hstep, voffB);
            PG8_WAIT_V(6); PG8_BAR; PG8_MMA(1, 1, At, B1); PG8_BAR;
            PG8_LDB(B0, 1, 0); PG8_SCHED; PG8_LDA(At, 1, 0); PG8_STAGE(PG8_SA(0, 1), a2 + hstep, voffA);
            PG8_WAIT_L(8); PG8_BAR; PG8_WAIT_L(0); PG8_MMA(0, 0, At, B0); PG8_BAR; PG8_SCHED;
            PG8_LDB(B1, 1, 1); PG8_STAGE(PG8_SB(1, 0), b3, voffB);
            PG8_BAR; PG8_WAIT_L(0); PG8_MMA(0, 1, At, B1); PG8_BAR;
            PG8_LDA(At, 1, 1); PG8_STAGE(PG8_SA(1, 0), a3, voffA);
            PG8_BAR; PG8_WAIT_L(0); PG8_MMA(1, 0, At, B0); PG8_BAR; PG8_SCHED;
            PG8_STAGE(PG8_SB(1, 1), b3 + hstep, voffB);
            PG8_WAIT_V(6); PG8_BAR; PG8_MMA(1, 1, At, B1); PG8_BAR;
            }
        }
        if constexpr (ALIGN_EPI) { if (wr == 0) PG8_BAR; }
        E.bind(lds, ui);
        { int te = tid; asm volatile("" : "+v"(te));
          E(acc, cur, wr, wc, te & 15, (te & 63) >> 4); }
        if (!has_next) break;
#pragma unroll
        for (int a = 0; a < 2; ++a)
#pragma unroll
            for (int b = 0; b < 2; ++b)
#pragma unroll
                for (int m = 0; m < 4; ++m)
#pragma unroll
                    for (int n = 0; n < 2; ++n) acc[a][b][m][n] = (f32x4){0.f, 0.f, 0.f, 0.f};
        cur = nxt; cA = nA; cB = nB; ++ui;
        if constexpr (ALIGN_EPI) { if (wr == 1) PG8_BAR; }
    }
    PG8_WAIT_V(0);
    if constexpr (!ALIGN_EPI) { if (wr == 0) PG8_BAR; }
    PG8_BAR;
#undef PG8_SA
#undef PG8_SB
#undef PG8_STAGE
#undef PG8_LDA
#undef PG8_STAGE2
#undef PG8_LDB
#undef PG8_MMA
#undef PG8_WAIT_V
#undef PG8_WAIT_L
#undef PG8_BAR
#undef PG8_SCHED
}

struct EpiQKV {
    static constexpr bool PERM = true;
    __device__ __forceinline__ void prefetch(LAS unsigned char*, const Unit&, int, int, int) const {}
    __device__ __forceinline__ void bind(LAS unsigned char*, int) {}
    bf16* O; int ldc; unsigned* knp; int klo, khi;
    __device__ __forceinline__ void operator()(const f32x4 (&acc)[2][2][4][2], const Unit& u, int wr, int wc, int fr, int fq) const {
        const int row0 = u.pm * BM + wr * 64 + fr, col0 = u.pn * BM + wc * 32 + 8 * fq;
        if (u.pn >= klo && u.pn < khi) {
#pragma unroll
            for (int bj = 0; bj < 2; ++bj) { float mx = 0.f;
#pragma unroll
                for (int ai = 0; ai < 2; ++ai)
#pragma unroll
                    for (int m = 0; m < 4; ++m) { const f32x4 a = acc[ai][bj][m][0], c = acc[ai][bj][m][1];
                        float s2 = ((a[0] * a[0] + a[1] * a[1]) + (a[2] * a[2] + a[3] * a[3])) + ((c[0] * c[0] + c[1] * c[1]) + (c[2] * c[2] + c[3] * c[3]));
                        s2 += shx<16>(s2); s2 += shx<32>(s2); mx = fmaxf(mx, s2); }
                mx = fmaxf(mx, shx<1>(mx)); mx = fmaxf(mx, shx<2>(mx)); mx = fmaxf(mx, shx<4>(mx)); mx = fmaxf(mx, shx<8>(mx));
                if ((fr | fq) == 0) __hip_atomic_fetch_max(knp + (u.pm >> 4) * 96 + u.pn * 8 + bj * 4 + wc, __float_as_uint(mx), __ATOMIC_RELAXED, __HIP_MEMORY_SCOPE_AGENT); }
        }
#pragma unroll
        for (int ai = 0; ai < 2; ++ai)
#pragma unroll
            for (int m = 0; m < 4; ++m) { bf16* rowp = O + (size_t)(row0 + ai * HALF + m * 16) * ldc + col0;
#pragma unroll
                for (int bj = 0; bj < 2; ++bj) { const f32x4 v0 = acc[ai][bj][m][0], v1 = acc[ai][bj][m][1];
                    u32x4 w; w.x = cvt_pk_bf16(v0[0], v0[1]); w.y = cvt_pk_bf16(v0[2], v0[3]); w.z = cvt_pk_bf16(v1[0], v1[1]); w.w = cvt_pk_bf16(v1[2], v1[3]);
                    *(u32x4*)(rowp + bj * HALF) = w; } }
    }
};
struct EpiOut {
    static constexpr bool PERM = true;
    __device__ __forceinline__ void prefetch(LAS unsigned char*, const Unit&, int, int, int) const {}
    __device__ __forceinline__ void bind(LAS unsigned char*, int) {}
    const float* x32; const bf16* xprev; bf16* xout; const float* g1;
    __device__ __forceinline__ void operator()(const f32x4 (&acc)[2][2][4][2], const Unit& u, int wr, int wc, int fr, int fq) const {
        const int row0 = u.pm * BM + wr * 64 + fr, col0 = u.pn * BM + wc * 32 + 8 * fq;
        const float* gv = g1 + (size_t)(u.pm >> 4) * 6144 + col0;
        f32x4 gg[2][2];
#pragma unroll
        for (int bj = 0; bj < 2; ++bj)
#pragma unroll
            for (int n = 0; n < 2; ++n) gg[bj][n] = *(const f32x4*)(gv + bj * HALF + n * 4);
#pragma unroll
        for (int ai = 0; ai < 2; ++ai)
#pragma unroll
            for (int m = 0; m < 4; ++m) { const size_t ro = (size_t)(row0 + ai * HALF + m * 16) * 1024 + col0;
#pragma unroll
                for (int bj = 0; bj < 2; ++bj) { f32x4 p0, p1;
                    if (x32) { p0 = *(const f32x4*)(x32 + ro + bj * HALF); p1 = *(const f32x4*)(x32 + ro + bj * HALF + 4); }
                    else { const u32x4 q = *(const u32x4*)(xprev + ro + bj * HALF);
                        p0 = (f32x4){bf2f(q.x & 0xffffu), bf2f(q.x >> 16), bf2f(q.y & 0xffffu), bf2f(q.y >> 16)};
                        p1 = (f32x4){bf2f(q.z & 0xffffu), bf2f(q.z >> 16), bf2f(q.w & 0xffffu), bf2f(q.w >> 16)}; }
                    const f32x4 o0 = p0 + gg[bj][0] * acc[ai][bj][m][0], o1 = p1 + gg[bj][1] * acc[ai][bj][m][1];
                    u32x4 w; w.x = cvt_pk_bf16(o0[0], o0[1]); w.y = cvt_pk_bf16(o0[2], o0[3]); w.z = cvt_pk_bf16(o1[0], o1[1]); w.w = cvt_pk_bf16(o1[2], o1[3]);
                    *(u32x4*)(xout + ro + bj * HALF) = w; } }
    }
};
constexpr int EOFF = STAGE_BYTES + 1024 + 8192;
struct EpiMoe1 {
    static constexpr bool PERM = true;
    bf16* act; const float* bgate; const float* bup;
    const LAS float* eb;
    __device__ __forceinline__ void prefetch(LAS unsigned char* lds, const Unit& u, int ui, int wid, int lane) const {
        if (wid < 4) { const float* src = ((wid & 2) ? bup : bgate) + (u.pb >> 3) * 1024 + u.pn * HALF + (wid & 1) * 64 + lane;
            __builtin_amdgcn_global_load_lds((const unsigned*)src, (LAS unsigned*)(lds + EOFF + (ui & 1) * 2048 + wid * 256), 4, 0, 0); }
    }
    __device__ __forceinline__ void bind(LAS unsigned char* lds, int ui) { eb = (const LAS float*)(lds + EOFF + (ui & 1) * 2048); }
    __device__ __forceinline__ void operator()(const f32x4 (&acc)[2][2][4][2], const Unit& u, int wr, int wc, int fr, int fq) const {
        const int row0 = u.pm * BM + wr * 64 + fr, col0 = u.pn * HALF + wc * 32 + 8 * fq;
        f32x4 bg[2], bu[2];
#pragma unroll
        for (int n = 0; n < 2; ++n) { bg[n] = *(const LAS f32x4*)(eb + wc * 32 + 8 * fq + 4 * n); bu[n] = *(const LAS f32x4*)(eb + 128 + wc * 32 + 8 * fq + 4 * n); }
#pragma unroll
        for (int ai = 0; ai < 2; ++ai)
#pragma unroll
            for (int m = 0; m < 4; ++m) { float o[8];
#pragma unroll
                for (int n = 0; n < 2; ++n) {
                    const f32x4 ag = acc[ai][0][m][n] + bg[n], au = acc[ai][1][m][n] + bu[n];
                    f32x4 hg, hu;
#pragma unroll
                    for (int j = 0; j < 4; ++j) { hg[j] = fminf(ag[j], 7.f); hu[j] = fminf(fmaxf(au[j], -7.f), 7.f); }
                    const f32x4 t = hg * (-1.702f * 1.44269504f);
                    f32x4 e;
#pragma unroll
                    for (int j = 0; j < 4; ++j) e[j] = __builtin_amdgcn_exp2f(t[j]);
                    const f32x4 d = e + 1.f;
                    f32x4 r;
#pragma unroll
                    for (int j = 0; j < 4; ++j) r[j] = __builtin_amdgcn_rcpf(d[j]);
                    const f32x4 ov = (hg * r) * (hu + 1.f);
#pragma unroll
                    for (int j = 0; j < 4; ++j) o[n * 4 + j] = ov[j]; }
                u32x4 w; w.x = cvt_pk_bf16(o[0], o[1]); w.y = cvt_pk_bf16(o[2], o[3]); w.z = cvt_pk_bf16(o[4], o[5]); w.w = cvt_pk_bf16(o[6], o[7]);
                *(u32x4*)(act + (size_t)(row0 + ai * HALF + m * 16) * 1024 + col0) = w; }
    }
};
struct EpiMoe2 {
    static constexpr bool PERM = true;
    bf16* y; const float* bdown; const float* egate; const LAS int* tp;
    const LAS float* eb;
    __device__ __forceinline__ void prefetch(LAS unsigned char* lds, const Unit& u, int ui, int wid, int lane) const {
        const int e = u.pb >> 2;
        const float* src;
        if (wid < 4) src = bdown + e * 1024 + u.pn * BM + wid * 64 + lane;
        else { int s = (u.pm - tp[e]) * 256 + (wid - 4) * 64 + lane; const int ce = tp[64 + e] - 1; s = s < ce ? s : ce; src = egate + e * 16384 + s; }
        __builtin_amdgcn_global_load_lds((const unsigned*)src, (LAS unsigned*)(lds + EOFF + (ui & 1) * 2048 + wid * 256), 4, 0, 0);
    }
    __device__ __forceinline__ void bind(LAS unsigned char* lds, int ui) { eb = (const LAS float*)(lds + EOFF + (ui & 1) * 2048); }
    __device__ __forceinline__ void operator()(const f32x4 (&acc)[2][2][4][2], const Unit& u, int wr, int wc, int fr, int fq) const {
        const int row0 = u.pm * BM + wr * 64 + fr, col0 = u.pn * BM + wc * 32 + 8 * fq;
        f32x4 bd[2][2];
#pragma unroll
        for (int bj = 0; bj < 2; ++bj)
#pragma unroll
            for (int n = 0; n < 2; ++n) bd[bj][n] = *(const LAS f32x4*)(eb + wc * 32 + 8 * fq + bj * HALF + 4 * n);
#pragma unroll
        for (int ai = 0; ai < 2; ++ai)
#pragma unroll
            for (int m = 0; m < 4; ++m) { const int rl = wr * 64 + fr + ai * HALF + m * 16, row = u.pm * BM + rl; const float gt = eb[256 + rl];
#pragma unroll
                for (int bj = 0; bj < 2; ++bj) { const f32x4 v0 = (acc[ai][bj][m][0] + bd[bj][0]) * gt, v1 = (acc[ai][bj][m][1] + bd[bj][1]) * gt;
                    u32x4 w; w.x = cvt_pk_bf16(v0[0], v0[1]); w.y = cvt_pk_bf16(v0[2], v0[3]); w.z = cvt_pk_bf16(v1[0], v1[1]); w.w = cvt_pk_bf16(v1[2], v1[3]);
                    *(u32x4*)(y + (size_t)row * 1024 + col0 + bj * HALF) = w; } }
        (void)row0;
    }
};
}

struct TItem { const float* W; bf16* WT; int ld, K, drow0, k0, n0; };
__device__ __forceinline__ void ti_load(float (&v)[32], const TItem& t, int lane) {
#pragma unroll
    for (int i = 0; i < 32; ++i) v[i] = __builtin_nontemporal_load(t.W + (size_t)(t.k0 + 2 * i + (lane >> 5)) * t.ld + t.n0 + (lane & 31));
}
__device__ __forceinline__ void ti_emit(const TItem& t, const LAS float* scr, int lane) {
    const int c = lane & 7;
#pragma unroll
    for (int j = 0; j < 4; ++j) { const int n = (lane >> 3) + 8 * j;
        float s[8];
#pragma unroll
        for (int q = 0; q < 8; ++q) { const int kk = 8 * c + q; s[q] = scr[kk * 32 + ((n + kk) & 31)]; }
        v4u o; o.x = pk2(s[0], s[1]); o.y = pk2(s[2], s[3]); o.z = pk2(s[4], s[5]); o.w = pk2(s[6], s[7]);
        *(v4u*)(t.WT + (size_t)(t.drow0 + n) * t.K + t.k0 + 8 * c) = o; }
    asm volatile("s_waitcnt lgkmcnt(0)" ::: "memory");
}
__device__ __forceinline__ void ti_store(const float (&v)[32], const TItem& t, LAS float* scr, int lane) {
#pragma unroll
    for (int i = 0; i < 32; ++i) { const int kk = 2 * i + (lane >> 5); scr[kk * 32 + (((lane & 31) + kk) & 31)] = v[i]; }
    asm volatile("s_waitcnt lgkmcnt(0)" ::: "memory");
    ti_emit(t, scr, lane);
}
constexpr int CVT_SMALL = 4 * 32 * 4 + (2 * 16 * 88 + 2 * 16 * 96) + 4 * 16 * 32, CVT_MOE_L = 32 * 3 * 16 * 32;
struct CvtPtrs { const float *cw1, *ewin, *owin, *ewout, *owout, *wg, *wu, *wd; unsigned char* ws; };
__device__ __forceinline__ TItem cvt_decode(const CvtPtrs& P, int it) {
    constexpr int IT_IN_E = 16 * 88, IT_IN_O = 16 * 96, IT_OUT = 16 * 32, IT_MOE = 16 * 32;
    constexpr int N_IN = 2 * IT_IN_E + 2 * IT_IN_O, N_OUT = 4 * IT_OUT, N_W1 = 4 * 32 * 4;
    unsigned char* ws = P.ws;
    TItem t; int r = it;
    if (r < N_W1) { const int m = r >> 7, kb = (r & 127) >> 2, nb = r & 3;
        t.W = P.cw1 + (size_t)m * 2048 * 128; t.ld = 128; t.K = 2048; t.WT = WSP(bf16, WS_W1T) + (size_t)m * 128 * 2048; t.drow0 = 32 * nb; t.k0 = 64 * kb; t.n0 = 32 * nb; return t; }
    r -= N_W1;
    if (r < N_IN) {
        int l; bool even;
        if (r < 2 * IT_IN_E) { const int e = r / IT_IN_E; r -= e * IT_IN_E; l = 2 * e; even = true; }
        else { r -= 2 * IT_IN_E; const int e = r / IT_IN_O; r -= e * IT_IN_O; l = 2 * e + 1; even = false; }
        const int nblk = even ? 88 : 96, kb = r / nblk, nb = r % nblk;
        t.W = even ? P.ewin + (size_t)(l >> 1) * D * EVEN_IN : P.owin + (size_t)(l >> 1) * D * ODD_IN; t.ld = even ? EVEN_IN : ODD_IN; t.K = D;
        t.WT = WSP(bf16, WS_WINT) + (size_t)l * 3072 * 1024; t.drow0 = 32 * nb; t.k0 = 64 * kb; t.n0 = 32 * nb; return t;
    }
    r -= N_IN;
    if (r < N_OUT) {
        const int l = r / IT_OUT; r -= l * IT_OUT; const int kb = r / 32, nb = r % 32;
        t.W = (l & 1) ? P.owout + (size_t)(l >> 1) * D * D : P.ewout + (size_t)(l >> 1) * D * D; t.ld = D; t.K = D;
        t.WT = WSP(bf16, WS_WOUTT) + (size_t)l * 1024 * 1024; t.drow0 = 32 * nb; t.k0 = 64 * kb; t.n0 = 32 * nb; return t;
    }
    r -= N_OUT;
    { const int le = r / (3 * IT_MOE); r -= le * 3 * IT_MOE; const int which = r / IT_MOE; r -= which * IT_MOE; const int kb = r / 32, nb = r % 32, n0 = 32 * nb;
      t.k0 = 64 * kb; t.n0 = n0;
      if (which < 2) { t.W = (which == 0 ? P.wg : P.wu) + (size_t)le * D * FF; t.ld = FF; t.K = D; t.WT = WSP(bf16, WS_WGUT) + (size_t)le * 2048 * 1024; t.drow0 = (n0 >> 7) * 256 + which * 128 + (n0 & 127); }
      else { t.W = P.wd + (size_t)le * FF * D; t.ld = D; t.K = FF; t.WT = WSP(bf16, WS_WDT) + (size_t)le * 1024 * 1024; t.drow0 = n0; } }
    return t;
}
__device__ __forceinline__ void p_convert(const Ctx& C0) {
    PHASE_PROLOG(C0);
    LAS float* scr = (LAS float*)(C.lds + 32768) + C.wave * 2048;
    CvtPtrs P; P.cw1 = INP(I_CW1); P.ewin = INP(I_EWIN); P.owin = INP(I_OWIN); P.ewout = INP(I_EWOUT); P.owout = INP(I_OWOUT); P.wg = INP(I_WG); P.wu = INP(I_WU); P.wd = INP(I_WD); P.ws = ws;
    constexpr int NITEMS = CVT_SMALL;
    int it = C.gw;
    if (it >= NITEMS) return;
    float va[32], vb[32];
    TItem ta = cvt_decode(P, it), tb = ta;
    ti_load(va, ta, C.lane);
    for (;;) {
        int nx = it + C.NGW; bool hb = nx < NITEMS;
        if (hb) { tb = cvt_decode(P, nx); ti_load(vb, tb, C.lane); }
        ti_store(va, ta, scr, C.lane);
        if (!hb) break;
        it = nx; nx = it + C.NGW; const bool ha = nx < NITEMS;
        if (ha) { ta = cvt_decode(P, nx); ti_load(va, ta, C.lane); }
        ti_store(vb, tb, scr, C.lane);
        if (!ha) break;
        it = nx;
    }
}

__device__ __forceinline__ void p_cmp(const Ctx& C0, int l) {
    PHASE_PROLOG(C0); const int e = l >> 1;
    const bf16* QKV = WSP(bf16, WS_QKV);
    LAS float* in = (LAS float*)C.lds;
    LAS float* red = in + 2048;
    LAS float* hid = red + 512;
    LAS float* red2 = hid + 128;
    if (blockIdx.x == 0) { for (int i = C.tid; i < 2 * NB * 2 * 64; i += NTHR) { const int kv2 = i / (NB * 2 * 64), r = i % (NB * 2 * 64), bb = r / 128, gd = r % 128;
        WSP(bf16, kv2 ? WS_VCMP : WS_KCMP)[((size_t)(bb * 256 + 255) * 2) * 64 + gd] = 0; } }
    for (int item = blockIdx.x; item < NB * NCMP * 2 * 2; item += gridDim.x) {
        const int kv = item & 1, g = (item >> 1) & 1, n = (item >> 2) % NCMP, b = (item >> 2) / NCMP;
        const float* pos = INP(I_CPOS) + ((size_t)e * 2 + kv) * 32 * 64;
        const float* w1 = INP(I_CW1) + ((size_t)e * 2 + kv) * 2048 * 128;
        const float* w2 = INP(I_CW2) + ((size_t)e * 2 + kv) * 128 * 64;
        const int col = (kv ? C_VC : C_KC) + g * 64;
        for (int i = C.tid; i < 2048; i += NTHR) { const int ll = i >> 6, dd = i & 63;
            in[i] = bf2f(QKV[(size_t)(b * S + 16 * n + ll) * QP + col + dd]) + pos[ll * 64 + dd]; }
        __syncthreads();
        { const int j = C.tid & 127, part = C.tid >> 7; float s = 0.f;
          for (int i = part * 512; i < part * 512 + 512; ++i) s += in[i] * w1[(size_t)i * 128 + j];
          red[part * 128 + j] = s; }
        __syncthreads();
        if (C.tid < 128) { const float s = red[C.tid] + red[128 + C.tid] + red[256 + C.tid] + red[384 + C.tid]; hid[C.tid] = s * sigmoidf_(s); }
        __syncthreads();
        { const int d = C.tid & 63, part = C.tid >> 6; float s = 0.f;
          for (int j = part * 16; j < part * 16 + 16; ++j) s += hid[j] * w2[j * 64 + d];
          red2[part * 64 + d] = s; }
        __syncthreads();
        if (C.tid < 64) { float s = 0.f;
#pragma unroll
            for (int p = 0; p < 8; ++p) s += red2[p * 64 + C.tid];
            bf16* dst = WSP(bf16, kv ? WS_VCMP : WS_KCMP);
            dst[((size_t)(b * 256 + n) * 2 + g) * 64 + C.tid] = (bf16)f2bf(s); }
        __syncthreads();
    }
}

__device__ __forceinline__ void p_cmp_mfma(const Ctx& C0, int l) {
    PHASE_PROLOG(C0); const int e = l >> 1;
    typedef short bf16x8 __attribute__((ext_vector_type(8)));
    const bf16* QKV = WSP(bf16, WS_QKV);
    LAS float* red = (LAS float*)C.lds;
    LAS float* hid = red + 8 * 16 * 128;
    const float* p_cw2 = INP(I_CW2);
    const int r = C.lane & 15, kg = C.lane >> 4;
    for (int u = blockIdx.x; u < 256; u += gridDim.x) {
        const int kv = u & 1, g = (u >> 1) & 1, b = (u >> 2) & 3, n0 = (u >> 4) * 16;
        const bf16* w1t = WSP(bf16, WS_W1T) + (size_t)(e * 2 + kv) * 128 * 2048;
        const int col = (kv ? C_VC : C_KC) + g * 64;
        const int n = n0 + r; const bool nvalid = n < NCMP;
        f32x4 acc[8];
#pragma unroll
        for (int j = 0; j < 8; ++j) acc[j] = (f32x4){0.f, 0.f, 0.f, 0.f};
#pragma unroll 2
        for (int ks = 0; ks < 8; ++ks) {
            const int ltok = 4 * C.wave + (ks >> 1), dd = (ks & 1) * 32 + kg * 8;
            bf16x8 a = (bf16x8){0, 0, 0, 0, 0, 0, 0, 0};
            if (nvalid) a = *(const bf16x8*)(QKV + (size_t)(b * S + 16 * n + ltok) * QP + col + dd);
            const int k0 = ltok * 64 + dd;
#pragma unroll
            for (int j = 0; j < 8; ++j) { const bf16x8 bb = *(const bf16x8*)(w1t + (size_t)(j * 16 + r) * 2048 + k0);
                acc[j] = __builtin_amdgcn_mfma_f32_16x16x32_bf16(a, bb, acc[j], 0, 0, 0); }
        }
#pragma unroll
        for (int j = 0; j < 8; ++j)
#pragma unroll
            for (int i = 0; i < 4; ++i) red[(C.wave * 16 + 4 * kg + i) * 128 + j * 16 + r] = acc[j][i];
        __syncthreads();
        const float* posb = WSP(float, WS_POSB) + (e * 2 + kv) * 128;
        for (int idx = C.tid; idx < 2048; idx += NTHR) { float s = posb[idx & 127];
#pragma unroll
            for (int w = 0; w < 8; ++w) s += red[(w * 16 + (idx >> 7)) * 128 + (idx & 127)];
            hid[idx] = s * sigmoidf_(s); }
        __syncthreads();
        { const int row = C.tid >> 5, d2 = (C.tid & 31) * 2; const float* w2 = p_cw2 + (size_t)(e * 2 + kv) * 128 * 64;
          float s0 = 0.f, s1 = 0.f;
#pragma unroll 8
          for (int j = 0; j < 128; ++j) { const float h = hid[row * 128 + j]; const float2 w = *(const float2*)(w2 + j * 64 + d2); s0 += h * w.x; s1 += h * w.y; }
          const int nn = n0 + row;
          bf16* dst = WSP(bf16, kv ? WS_VCMP : WS_KCMP) + ((size_t)(b * 256 + nn) * 2 + g) * 64 + d2;
          *(unsigned*)dst = (nn < NCMP) ? pk2(s0, s1) : 0u; }
        __syncthreads();
    }
}
__device__ __forceinline__ void p_scan(const Ctx& C0) {
    PHASE_PROLOG(C0);
    const float* GL = WSP(float, WS_GL); float* CUM = WSP(float, WS_CUMF);
    for (int item = C.gw; item < NB * 16; item += C.NGW) {
        const int b = item >> 4, h = item & 15;
        float loc = 0.f;
        for (int i = 0; i < 64; ++i) loc += GL[(size_t)(b * S + C.lane * 64 + i) * 32 + h];
        float inc = loc;
#pragma unroll
        for (int o = 1; o < 64; o <<= 1) { const float u = shl_(inc, C.lane - o); if (C.lane >= o) inc += u; }
        float run = inc - loc;
        for (int i = 0; i < 64; ++i) { run += GL[(size_t)(b * S + C.lane * 64 + i) * 32 + h]; CUM[(size_t)(b * S + C.lane * 64 + i) * 16 + h] = run; }
    }
}

template <int NO> struct RowState { float m, l; float o[NO]; };
template <int NO> __device__ __forceinline__ void rs_init(RowState<NO>& st) { st.m = NEGBIG; st.l = 0.f;
#pragma unroll
    for (int i = 0; i < NO; ++i) st.o[i] = 0.f; }
__device__ __forceinline__ float dot64(const LAS float* q, const bf16* krow) {
    float s = 0.f;
#pragma unroll
    for (int c = 0; c < 8; ++c) { const v4u u = *(const v4u*)(krow + c * 8); const LAS float* qq = q + c * 8;
        s += qq[0] * bf2f(u.x & 0xffffu) + qq[1] * bf2f(u.x >> 16) + qq[2] * bf2f(u.y & 0xffffu) + qq[3] * bf2f(u.y >> 16)
           + qq[4] * bf2f(u.z & 0xffffu) + qq[5] * bf2f(u.z >> 16) + qq[6] * bf2f(u.w & 0xffffu) + qq[7] * bf2f(u.w >> 16); }
    return s;
}
template <int NO> __device__ __forceinline__ void attn_chunk(RowState<NO>& st, float s, bool valid, const bf16* vbase, int vpitch, int lane) {
    const float cm = wave_max(valid ? s : NEGBIG);
    const float mnew = fmaxf(st.m, cm);
    const float p = valid ? __expf(s - mnew) : 0.f;
    const float f = __expf(st.m - mnew);
    st.l = st.l * f + wave_sum(p);
#pragma unroll
    for (int i = 0; i < NO; ++i) st.o[i] *= f;
    const unsigned long long act = __ballot(p != 0.f);
    if (act) {
        for (int j = 0; j < 64; ++j) {
            const float pj = shl_(p, j);
            if (pj != 0.f) {
#pragma unroll
                for (int i = 0; i < NO; ++i) st.o[i] += pj * bf2f(vbase[(size_t)j * vpitch + lane + 64 * i]);
            }
        }
    }
    st.m = mnew;
}

__device__ __forceinline__ void attn_diff_row(const Ctx& C0, int l, int item) {
    PHASE_PROLOG(C0); const int e = l >> 1;
    const bf16* QKV = WSP(bf16, WS_QKV); bf16* AO = WSP(bf16, WS_AO);
    LAS float* ql = (LAS float*)C.lds + C.wave * 1024;
    const int s = item % S, h = (item / S) & 3, b = item / (4 * S);
    const int t = b * S + s;
    const float slope = alibi4(h);
    const float lam_init = 0.8f - 0.6f * __expf(-0.3f * (float)l);
    float lam;
    { const float* lp = INP(I_DLAM) + e * 256; int tl0 = C.tid; asm volatile("" : "+v"(tl0)); const int ln0 = tl0 & 63; const float a1 = wave_sum(lp[ln0] * lp[64 + ln0]), a2 = wave_sum(lp[128 + ln0] * lp[192 + ln0]);
      lam = __uint_as_float(__builtin_amdgcn_readfirstlane(__float_as_uint(__expf(a1) - __expf(a2) + lam_init))); }
    float res[2];
    res[0] = 0.f; res[1] = 0.f;
#pragma unroll
    for (int c = 0; c < 2; ++c) {
        ql[C.lane] = 0.125f * bf2f(QKV[(size_t)t * QP + C_AQ + h * 128 + c * 64 + C.lane]);
        RowState<2> st; rs_init(st);
        for (int k0 = 0; k0 <= s; k0 += 64) {
            const int kp = k0 + C.lane; const bool valid = kp <= s;
            float sc = NEGBIG;
            if (valid) sc = dot64(ql, QKV + (size_t)(b * S + kp) * QP + C_AK + h * 128 + c * 64) - slope * (float)(s - kp);
            attn_chunk<2>(st, sc, valid, QKV + (size_t)(b * S + k0) * QP + C_AV + h * 128, QP, C.lane);
        }
        const float inv = 1.f / st.l, w = (c == 0) ? 1.f : -lam;
        res[0] += w * st.o[0] * inv; res[1] += w * st.o[1] * inv;
    }
    const float ms = wave_sum(res[0] * res[0] + res[1] * res[1]) * (1.f / 128.f);
    const float r = rsqrtf(ms + EPS) * (1.f - lam_init);
    const float* sg = INP(I_DSUB) + e * 128;
    AO[(size_t)t * D + h * 128 + C.lane] = (bf16)f2bf(res[0] * r * sg[C.lane]);
    AO[(size_t)t * D + h * 128 + 64 + C.lane] = (bf16)f2bf(res[1] * r * sg[64 + C.lane]);
}

__device__ __forceinline__ void attn_nsa_row(const Ctx& C0, int l, int item) {
    PHASE_PROLOG(C0);
    const bf16* QKV = WSP(bf16, WS_QKV); bf16* AO = WSP(bf16, WS_AO);
    const bf16* KC = WSP(bf16, WS_KCMP); const bf16* VC = WSP(bf16, WS_VCMP); const float* GL = WSP(float, WS_GL);
    LAS float* ql = (LAS float*)C.lds + C.wave * 1024;
    LAS float* pl = ql + 256;
    LAS float* ps = pl + 256;
    const int s = item % S, g = (item / S) & 1, b = item / (2 * S);
    const int t = b * S + s, lane = C.lane;
#pragma unroll
    for (int hg = 0; hg < 4; ++hg) ql[hg * 64 + lane] = 0.125f * bf2f(QKV[(size_t)t * QP + C_BQ + (g * 4 + hg) * 64 + lane]);
#pragma unroll
    for (int i = 0; i < 4; ++i) ps[lane + 64 * i] = 0.f;
    float out[4];
#pragma unroll
    for (int hg = 0; hg < 4; ++hg) {
        const float slope = alibi8(g * 4 + hg);
        float sc[4]; bool vd[4]; float mx = NEGBIG;
#pragma unroll
        for (int i = 0; i < 4; ++i) { const int n = lane + 64 * i; vd[i] = (n < NCMP) && (16 * n + 31 <= s); sc[i] = NEGBIG;
            if (vd[i]) sc[i] = dot64(ql + hg * 64, KC + ((size_t)(b * 256 + n) * 2 + g) * 64) - slope * (float)(s - (16 * n + 31));
            mx = fmaxf(mx, sc[i]); }
        mx = wave_max(mx);
        float p[4], sum = 0.f;
#pragma unroll
        for (int i = 0; i < 4; ++i) { p[i] = vd[i] ? __expf(sc[i] - mx) : 0.f; sum += p[i]; }
        sum = wave_sum(sum);
        const float inv = 1.f / fmaxf(sum, 1e-30f);
#pragma unroll
        for (int i = 0; i < 4; ++i) { p[i] *= inv; pl[lane + 64 * i] = p[i]; ps[lane + 64 * i] += p[i]; }
        float o = 0.f;
        const int nmax = (s >= 31) ? ((s - 31) >> 4) : -1;
        for (int n = 0; n <= nmax && n < NCMP; ++n) o += pl[n] * bf2f(VC[((size_t)(b * 256 + n) * 2 + g) * 64 + lane]);
        out[hg] = sigmoidf_(GL[(size_t)t * 32 + (g * 4 + hg) * 3 + 0]) * o;
    }
    const int cur = s >> 6;
    float imp = 0.f;
#pragma unroll
    for (int d = -1; d <= 3; ++d) { const int n = 4 * lane + d; if (n >= 0 && n < NCMP) imp += ps[n]; }
    const bool avail = lane <= cur, forced = (lane == 0) || (lane == cur) || (lane == cur - 1);
    const float score = avail ? imp + (forced ? 1e4f : 0.f) : NEGBIG;
    int rank = 0;
    for (int j = 0; j < 64; ++j) { const float sj = shl_(score, j); rank += (sj > score || (sj == score && j < lane)) ? 1 : 0; }
    const unsigned long long sel = __ballot(avail && rank < 16);
#pragma unroll
    for (int hg = 0; hg < 4; ++hg) {
        const float slope = alibi8(g * 4 + hg);
        RowState<1> st; rs_init(st);
        for (int j = 0; j <= cur; ++j) {
            if (!((sel >> j) & 1ull)) continue;
            const int kp = 64 * j + lane; const bool valid = kp <= s;
            float sc = NEGBIG;
            if (valid) sc = dot64(ql + hg * 64, QKV + (size_t)(b * S + kp) * QP + C_KS + g * 64) - slope * (float)(s - kp);
            attn_chunk<1>(st, sc, valid, QKV + (size_t)(b * S + 64 * j) * QP + C_VS + g * 64, QP, lane);
        }
        out[hg] += sigmoidf_(GL[(size_t)t * 32 + (g * 4 + hg) * 3 + 1]) * st.o[0] / fmaxf(st.l, 1e-30f);
    }
#pragma unroll
    for (int hg = 0; hg < 4; ++hg) {
        const float slope = alibi8(g * 4 + hg);
        RowState<1> st; rs_init(st);
        const int lo = (s - 511 > 0) ? ((s - 511) >> 6) : 0;
        for (int j = lo; j <= cur; ++j) {
            const int kp = 64 * j + lane; const bool valid = (kp <= s) && (s - kp < 512);
            float sc = NEGBIG;
            if (valid) sc = dot64(ql + hg * 64, QKV + (size_t)(b * S + kp) * QP + C_KW + g * 64) - slope * (float)(s - kp);
            attn_chunk<1>(st, sc, valid, QKV + (size_t)(b * S + 64 * j) * QP + C_VW + g * 64, QP, lane);
        }
        out[hg] += sigmoidf_(GL[(size_t)t * 32 + (g * 4 + hg) * 3 + 2]) * st.o[0] / fmaxf(st.l, 1e-30f);
    }
#pragma unroll
    for (int hg = 0; hg < 4; ++hg) AO[(size_t)t * D + 512 + (g * 4 + hg) * 64 + lane] = (bf16)f2bf(out[hg]);
}

__device__ __forceinline__ void attn_fox_row(const Ctx& C0, int item) {
    PHASE_PROLOG(C0);
    const bf16* QKV = WSP(bf16, WS_QKV); bf16* AO = WSP(bf16, WS_AO); const float* CUM = WSP(float, WS_CUMF);
    LAS float* ql = (LAS float*)C.lds + C.wave * 1024;
    const int s = item % S, h = (item / S) & 15, b = item / (16 * S);
    const int t = b * S + s;
    ql[C.lane] = 0.125f * bf2f(QKV[(size_t)t * QP + h * 64 + C.lane]);
    const float cq = CUM[(size_t)t * 16 + h];
    RowState<1> st; rs_init(st);
    for (int k0 = 0; k0 <= s; k0 += 64) {
        const int kp = k0 + C.lane; const bool valid = kp <= s;
        float sc = NEGBIG;
        if (valid) sc = dot64(ql, QKV + (size_t)(b * S + kp) * QP + 1024 + h * 64) + (cq - CUM[(size_t)(b * S + kp) * 16 + h]);
        attn_chunk<1>(st, sc, valid, QKV + (size_t)(b * S + k0) * QP + 2048 + h * 64, QP, C.lane);
    }
    AO[(size_t)t * D + h * 64 + C.lane] = (bf16)f2bf(st.o[0] / st.l);
}


namespace fa {
typedef float f32x16 __attribute__((ext_vector_type(16)));
typedef short bf16x8 __attribute__((ext_vector_type(8)));
typedef short s16x4 __attribute__((ext_vector_type(4)));
constexpr int KCH = 1040, KT = 8 * KCH, VDB = 4160;
constexpr float LOG2E = 1.4426950408889634f, QSCALE = 0.125f * LOG2E, THR = 20.f;
#define FA_NEG_INF (-__builtin_inff())
__device__ __forceinline__ int crow(int r, int hi) { return (r & 3) + 8 * (r >> 2) + 4 * hi; }
__device__ __forceinline__ unsigned cvtpk(float lo, float hi) { unsigned r; asm("v_cvt_pk_bf16_f32 %0, %1, %2" : "=v"(r) : "v"(lo), "v"(hi)); return r; }
__device__ __forceinline__ float swapmax(float m) { auto rr = __builtin_amdgcn_permlane32_swap(__float_as_uint(m), __float_as_uint(m), false, false); return fmaxf(__uint_as_float(rr[0]), __uint_as_float(rr[1])); }
__device__ __forceinline__ float swapsum(float m) { auto rr = __builtin_amdgcn_permlane32_swap(__float_as_uint(m), __float_as_uint(m), false, false); return __uint_as_float(rr[0]) + __uint_as_float(rr[1]); }
#define FA_SYNC() asm volatile("s_waitcnt lgkmcnt(0)\n\ts_barrier" ::: "memory")

template <int NK, int NVH> struct Stage { v4u k[NK]; v4u v[NVH]; };
template <int NK, int NVH> __device__ __forceinline__ void tile_issue(Stage<NK, NVH>& st, const bf16* K0, const bf16* K1, int kpitch, const bf16* V, int vpitch, int tid) {
    const int row = tid >> 3, c = tid & 7;
    st.k[0] = *(const v4u*)(K0 + (size_t)row * kpitch + c * 8);
    if constexpr (NK == 2) st.k[1] = *(const v4u*)(K1 + (size_t)row * kpitch + c * 8);
#pragma unroll
    for (int i = 0; i < NVH; ++i) st.v[i] = *(const v4u*)(V + (size_t)row * vpitch + (c + 8 * i) * 8);
}
template <int NK, int NVH> __device__ __forceinline__ void tile_commit(const Stage<NK, NVH>& st, LAS unsigned char* kbuf, LAS unsigned char* vbuf, int tid) {
    const int row = tid >> 3, c = tid & 7;
#pragma unroll
    for (int i = 0; i < NK; ++i) *(LAS v4u*)(kbuf + i * KT + c * KCH + row * 16) = st.k[i];
#pragma unroll
    for (int i = 0; i < NVH; ++i) { const int c16 = c + 8 * i; *(LAS v4u*)(vbuf + (c16 >> 2) * VDB + row * 64 + (c16 & 3) * 16) = st.v[i]; }
}
__device__ __forceinline__ void load_q(bf16x8 (&qr)[4], const bf16* qrow, int hi) {
#pragma unroll
    for (int d0 = 0; d0 < 4; ++d0) { const v4u u = *(const v4u*)(qrow + d0 * 16 + hi * 8);
        v4u w;
        w.x = cvtpk(bf2f(u.x & 0xffffu) * QSCALE, bf2f(u.x >> 16) * QSCALE); w.y = cvtpk(bf2f(u.y & 0xffffu) * QSCALE, bf2f(u.y >> 16) * QSCALE);
        w.z = cvtpk(bf2f(u.z & 0xffffu) * QSCALE, bf2f(u.z >> 16) * QSCALE); w.w = cvtpk(bf2f(u.w & 0xffffu) * QSCALE, bf2f(u.w >> 16) * QSCALE);
        qr[d0] = __builtin_bit_cast(bf16x8, w); }
}
template <int NDB> __device__ __forceinline__ void pv_step(f32x16 (&o)[NDB], const LAS unsigned char* vt, int lane, const bf16x8 (&pa)[4]) {
    typedef short v4i16_t __attribute__((ext_vector_type(4)));
    const int hi = lane >> 5;
    const LAS unsigned char* vb = vt + ((lane >> 4) & 1) * 32 + (lane & 3) * 8 + (4 * hi + ((lane & 15) >> 2)) * 64;
#pragma unroll
    for (int dp = 0; dp < NDB; dp += 2) {
        s16x4 lo[2][4], h4[2][4];
#pragma unroll
        for (int dd = 0; dd < 2; ++dd)
#pragma unroll
            for (int ks = 0; ks < 4; ++ks) {
                lo[dd][ks] = __builtin_bit_cast(s16x4, __builtin_amdgcn_ds_read_tr16_b64_v4i16((LAS v4i16_t*)(vb + (dp + dd) * VDB + ks * 1024)));
                h4[dd][ks] = __builtin_bit_cast(s16x4, __builtin_amdgcn_ds_read_tr16_b64_v4i16((LAS v4i16_t*)(vb + (dp + dd) * VDB + ks * 1024 + 512))); }
        __builtin_amdgcn_sched_barrier(0);
#pragma unroll
        for (int ks = 0; ks < 4; ++ks)
#pragma unroll
            for (int dd = 0; dd < 2; ++dd) {
                const bf16x8 B = (bf16x8){lo[dd][ks][0], lo[dd][ks][1], lo[dd][ks][2], lo[dd][ks][3], h4[dd][ks][0], h4[dd][ks][1], h4[dd][ks][2], h4[dd][ks][3]};
                o[dp + dd] = __builtin_amdgcn_mfma_f32_32x32x16_bf16(pa[ks], B, o[dp + dd], 0, 0, 0); }
    }
}
__device__ __forceinline__ void qk_tile(f32x16& p0, f32x16& p1, const bf16x8 (&qr)[4], const LAS unsigned char* kt, int lane) {
    const LAS unsigned char* kb = kt + (lane >> 5) * KCH + (lane & 31) * 16;
    p0 = (f32x16){0.f, 0.f, 0.f, 0.f, 0.f, 0.f, 0.f, 0.f, 0.f, 0.f, 0.f, 0.f, 0.f, 0.f, 0.f, 0.f}; p1 = p0;
#pragma unroll
    for (int d0 = 0; d0 < 4; ++d0) {
        const bf16x8 b0 = *(const LAS bf16x8*)(kb + d0 * 2 * KCH), b1 = *(const LAS bf16x8*)(kb + d0 * 2 * KCH + 512);
        p0 = __builtin_amdgcn_mfma_f32_32x32x16_bf16(b0, qr[d0], p0, 0, 0, 0);
        p1 = __builtin_amdgcn_mfma_f32_32x32x16_bf16(b1, qr[d0], p1, 0, 0, 0);
    }
}
__device__ __forceinline__ float max3f(float a, float b, float c) { return __builtin_fmaxf(__builtin_fmaxf(a, b), c); }
__device__ __forceinline__ float rowmax32(const f32x16& p0, const f32x16& p1) {
    float a = max3f(p0[0], p0[1], p1[0]), b = max3f(p0[2], p0[3], p1[1]);
    a = max3f(a, p1[2], p1[3]);
#pragma unroll
    for (int r = 4; r < 16; r += 4) { a = max3f(a, p0[r], p0[r + 1]); b = max3f(b, p0[r + 2], p0[r + 3]); a = max3f(a, p1[r], p1[r + 1]); b = max3f(b, p1[r + 2], p1[r + 3]); }
    return __builtin_fmaxf(a, b);
}
template <int NDB> __device__ __forceinline__ void softmax_pv(float& mhat, float& lsum, f32x16 (&o)[NDB], f32x16& p0, f32x16& p1, float off, float ladj, const LAS unsigned char* vt, LAS float* wsf, int lane) {
    const int r32 = lane & 31, hi = lane >> 5;
    typedef short v4i16_t __attribute__((ext_vector_type(4)));
    s16x4 vlo[2][4], vh4[2][4];
    if constexpr (NDB == 2) {
        const LAS unsigned char* vb = vt + ((lane >> 4) & 1) * 32 + (lane & 3) * 8 + (4 * hi + ((lane & 15) >> 2)) * 64;
#pragma unroll
        for (int dd = 0; dd < 2; ++dd)
#pragma unroll
            for (int ks = 0; ks < 4; ++ks) {
                vlo[dd][ks] = __builtin_bit_cast(s16x4, __builtin_amdgcn_ds_read_tr16_b64_v4i16((LAS v4i16_t*)(vb + dd * VDB + ks * 1024)));
                vh4[dd][ks] = __builtin_bit_cast(s16x4, __builtin_amdgcn_ds_read_tr16_b64_v4i16((LAS v4i16_t*)(vb + dd * VDB + ks * 1024 + 512))); }
        __builtin_amdgcn_sched_barrier(0);
    }
    const float rm = swapmax(rowmax32(p0, p1) + ladj);
    float mloc = mhat - off;
    if (__any(rm > mloc + THR)) {
        const float mnew = fmaxf(mloc, rm);
        const float f = __builtin_amdgcn_exp2f(mloc - mnew);
        lsum *= f; mloc = mnew; mhat = mnew + off;
        if (hi == 0) wsf[r32] = f;
        asm volatile("s_waitcnt lgkmcnt(0)" ::: "memory");
#pragma unroll
        for (int g = 0; g < 4; ++g) { const f32x4 fv = *(const LAS f32x4*)(wsf + 8 * g + 4 * hi);
#pragma unroll
            for (int d0 = 0; d0 < NDB; ++d0) { o[d0][4 * g] *= fv.x; o[d0][4 * g + 1] *= fv.y; o[d0][4 * g + 2] *= fv.z; o[d0][4 * g + 3] *= fv.w; } }
    }
    float sacc = 0.f;
    const float ml = mloc - ladj;
#pragma unroll
    for (int r = 0; r < 16; ++r) { p0[r] = __builtin_amdgcn_exp2f(p0[r] - ml); p1[r] = __builtin_amdgcn_exp2f(p1[r] - ml); sacc += p0[r] + p1[r]; }
    lsum += sacc;
    bf16x8 pa[4];
    { v4u w;
      w.x = cvtpk(p0[0], p0[1]); w.y = cvtpk(p0[2], p0[3]); w.z = cvtpk(p0[4], p0[5]); w.w = cvtpk(p0[6], p0[7]); pa[0] = __builtin_bit_cast(bf16x8, w);
      w.x = cvtpk(p0[8], p0[9]); w.y = cvtpk(p0[10], p0[11]); w.z = cvtpk(p0[12], p0[13]); w.w = cvtpk(p0[14], p0[15]); pa[1] = __builtin_bit_cast(bf16x8, w);
      w.x = cvtpk(p1[0], p1[1]); w.y = cvtpk(p1[2], p1[3]); w.z = cvtpk(p1[4], p1[5]); w.w = cvtpk(p1[6], p1[7]); pa[2] = __builtin_bit_cast(bf16x8, w);
      w.x = cvtpk(p1[8], p1[9]); w.y = cvtpk(p1[10], p1[11]); w.z = cvtpk(p1[12], p1[13]); w.w = cvtpk(p1[14], p1[15]); pa[3] = __builtin_bit_cast(bf16x8, w); }
    if constexpr (NDB == 2) {
#pragma unroll
        for (int ks = 0; ks < 4; ++ks)
#pragma unroll
            for (int dd = 0; dd < 2; ++dd) {
                const bf16x8 B = (bf16x8){vlo[dd][ks][0], vlo[dd][ks][1], vlo[dd][ks][2], vlo[dd][ks][3], vh4[dd][ks][0], vh4[dd][ks][1], vh4[dd][ks][2], vh4[dd][ks][3]};
                o[dd] = __builtin_amdgcn_mfma_f32_32x32x16_bf16(pa[ks], B, o[dd], 0, 0, 0); }
    } else pv_step<NDB>(o, vt, lane, pa);
}
template <int NDB> __device__ __forceinline__ void finish_rows(float lsum, f32x16 (&o)[NDB], LAS float* wsf, int lane, float rowscale) {
    const int r32 = lane & 31, hi = lane >> 5;
    const float l = swapsum(lsum);
    if (hi == 0) wsf[32 + r32] = rowscale / fmaxf(l, 1e-30f);
    asm volatile("s_waitcnt lgkmcnt(0)" ::: "memory");
#pragma unroll
    for (int g = 0; g < 4; ++g) { const f32x4 fv = *(const LAS f32x4*)(wsf + 32 + 8 * g + 4 * hi);
#pragma unroll
        for (int d0 = 0; d0 < NDB; ++d0) { o[d0][4 * g] *= fv.x; o[d0][4 * g + 1] *= fv.y; o[d0][4 * g + 2] *= fv.z; o[d0][4 * g + 3] *= fv.w; } }
}
__device__ __forceinline__ void store_rows64(const f32x16 (&o)[2], LAS bf16* stg, bf16* gdst, int pitch, int lane) {
    const int d = lane & 31, hi = lane >> 5;
#pragma unroll
    for (int r = 0; r < 16; ++r) { const int row = crow(r, hi); stg[row * 64 + d] = (bf16)f2bf(o[0][r]); stg[row * 64 + 32 + d] = (bf16)f2bf(o[1][r]); }
    asm volatile("s_waitcnt lgkmcnt(0)" ::: "memory");
#pragma unroll
    for (int i = 0; i < 4; ++i) { const int row = i * 8 + (lane >> 3), ch = lane & 7; *(v4u*)(gdst + (size_t)row * pitch + ch * 8) = *(const LAS v4u*)(stg + row * 64 + ch * 8); }
    asm volatile("s_waitcnt lgkmcnt(0)" ::: "memory");
}


template <int NDB, int NK, bool FOX> struct RunCfg {
    LAS unsigned char* lds; int KOFF, VOFF, COFF;
    const bf16* Kg0; const bf16* Kg1; const bf16* Vg; int pitch;
    const float* cg; const LAS float* pre;
    int ksel;
    float slope2; int qw0; int low; bool slc; unsigned long long mysel;
};
template <int NK, int NVH> struct Stage2 { v4u k[NK]; v4u v[NVH]; float ck; };

template <int NDB, int NK, bool FOX> __device__ __forceinline__ void st_issue_k(Stage2<NK, NDB / 2>& st, const RunCfg<NDB, NK, FOX>& R, int j, int tid) {
    const int row = tid >> 3, c = tid & 7;
    st.k[0] = *(const v4u*)(R.Kg0 + (size_t)(64 * j + row) * R.pitch + c * 8);
    if constexpr (NK == 2) st.k[1] = *(const v4u*)(R.Kg1 + (size_t)(64 * j + row) * R.pitch + c * 8);
    if constexpr (FOX) { if (tid < 64) st.ck = (R.cg[(size_t)(64 * j + tid) * 16] + R.pre[j]) * LOG2E; }
}
template <int NDB, int NK, bool FOX> __device__ __forceinline__ void st_commit_k(const Stage2<NK, NDB / 2>& st, const RunCfg<NDB, NK, FOX>& R, int slot, int tid) {
    const int row = tid >> 3, c = tid & 7;
#pragma unroll
    for (int i = 0; i < NK; ++i) *(LAS v4u*)(R.lds + R.KOFF + (slot * NK + i) * KT + c * KCH + row * 16) = st.k[i];
    if constexpr (FOX) { if (tid < 64) ((LAS float*)(R.lds + R.COFF))[slot * 64 + tid] = st.ck; }
}
template <int NDB, int NK, bool FOX> __device__ __forceinline__ void st_issue_v(Stage2<NK, NDB / 2>& st, const RunCfg<NDB, NK, FOX>& R, int j, int tid) {
    const int row = tid >> 3, c = tid & 7;
#pragma unroll
    for (int i = 0; i < NDB / 2; ++i) st.v[i] = *(const v4u*)(R.Vg + (size_t)(64 * j + row) * R.pitch + (c + 8 * i) * 8);
}
template <int NDB, int NK, bool FOX> __device__ __forceinline__ void st_commit_v(const Stage2<NK, NDB / 2>& st, const RunCfg<NDB, NK, FOX>& R, int slot, int tid) {
    const int row = tid >> 3, c = tid & 7;
#pragma unroll
    for (int i = 0; i < NDB / 2; ++i) { const int c16 = c + 8 * i; *(LAS v4u*)(R.lds + R.VOFF + slot * NDB * VDB + (c16 >> 2) * VDB + row * 64 + (c16 & 3) * 16) = st.v[i]; }
}
template <int NDB, int NK, bool FOX> __device__ __forceinline__ bool rt_part(const RunCfg<NDB, NK, FOX>& R, int j) {
    if (j > (R.qw0 >> 6)) return false;
    if (R.slc) return __any(((R.mysel >> j) & 1ull) != 0ull) != 0;
    return true;
}
template <int NDB, int NK, bool FOX> __device__ __forceinline__ void rt_qk(f32x16& p0, f32x16& p1, const RunCfg<NDB, NK, FOX>& R, int j, int slot, float mhat, const bf16x8 (&qr)[4], int lane) {
    const int hi = lane >> 5;
    const LAS unsigned char* kb = R.lds + R.KOFF + (slot * NK + R.ksel) * KT + hi * KCH + (lane & 31) * 16;
    bf16x8 kf[8];
#pragma unroll
    for (int d0 = 0; d0 < 4; ++d0) { kf[2 * d0] = *(const LAS bf16x8*)(kb + d0 * 2 * KCH); kf[2 * d0 + 1] = *(const LAS bf16x8*)(kb + d0 * 2 * KCH + 512); }
    typedef float f32x2 __attribute__((ext_vector_type(2)));
    if constexpr (FOX) {
        const LAS float* ck = (const LAS float*)(R.lds + R.COFF) + slot * 64; const f32x4 nm = (f32x4){-mhat, -mhat, -mhat, -mhat};
#pragma unroll
        for (int g = 0; g < 4; ++g) { const f32x4 c0 = nm - *(const LAS f32x4*)(ck + 8 * g + 4 * hi), c1 = nm - *(const LAS f32x4*)(ck + 32 + 8 * g + 4 * hi);
            p0[4 * g] = c0.x; p0[4 * g + 1] = c0.y; p0[4 * g + 2] = c0.z; p0[4 * g + 3] = c0.w;
            p1[4 * g] = c1.x; p1[4 * g + 1] = c1.y; p1[4 * g + 2] = c1.z; p1[4 * g + 3] = c1.w; }
    } else {
        const float base = R.slope2 * (float)(64 * j + 4 * hi - (R.qw0 + (lane & 31))) - mhat;
        const float s = R.slope2;
        const f32x2 k2 = (f32x2){2.f * s, 2.f * s}, k8 = (f32x2){8.f * s, 8.f * s}, k32 = (f32x2){32.f * s, 32.f * s};
        f32x2 a = (f32x2){base, base + s};
#pragma unroll
        for (int g = 0; g < 4; ++g) { const f32x2 b2 = a + k2, c = a + k32, d2 = b2 + k32;
            p0[4 * g] = a.x; p0[4 * g + 1] = a.y; p0[4 * g + 2] = b2.x; p0[4 * g + 3] = b2.y;
            p1[4 * g] = c.x; p1[4 * g + 1] = c.y; p1[4 * g + 2] = d2.x; p1[4 * g + 3] = d2.y;
            a = a + k8; }
    }
#pragma unroll
    for (int d0 = 0; d0 < 4; ++d0) {
        p0 = __builtin_amdgcn_mfma_f32_32x32x16_bf16(kf[2 * d0], qr[d0], p0, 0, 0, 0);
        p1 = __builtin_amdgcn_mfma_f32_32x32x16_bf16(kf[2 * d0 + 1], qr[d0], p1, 0, 0, 0);
    }
}
template <int NDB, int NK, bool FOX> __device__ __forceinline__ void rt_mask(f32x16& p0, f32x16& p1, const RunCfg<NDB, NK, FOX>& R, int j, int lane) {
    const int hi = lane >> 5, qrel = R.qw0 + (lane & 31) - 64 * j;
    if (j == (R.qw0 >> 6)) {
#pragma unroll
        for (int r = 0; r < 16; ++r) { const int kvl = crow(r, hi); if (kvl > qrel) p0[r] = FA_NEG_INF; if (kvl + 32 > qrel) p1[r] = FA_NEG_INF; }
    }
    if (j == R.low) {
#pragma unroll
        for (int r = 0; r < 16; ++r) { const int kvl = crow(r, hi); if (kvl <= qrel - 512) p0[r] = FA_NEG_INF; if (kvl + 32 <= qrel - 512) p1[r] = FA_NEG_INF; }
    }
    if (R.slc) {
        if (((R.mysel >> j) & 1ull) == 0ull) {
#pragma unroll
            for (int r = 0; r < 16; ++r) { p0[r] = FA_NEG_INF; p1[r] = FA_NEG_INF; }
        }
    }
}
template <int NDB> __device__ __forceinline__ void rt_softmax_pv(float& mhat, float& st, float& lsum, f32x16 (&o)[NDB], f32x16& s0, f32x16& s1, bool has_next, f32x16& n0, f32x16& n1,
                                                                 const LAS unsigned char* vt, LAS float* wsf, int lane) {
    const int r32 = lane & 31, hi = lane >> 5;
    const float rm = swapmax(rowmax32(s0, s1));
    const bool fresh = (st == 0.f), live = rm > FA_NEG_INF;
    const bool trig = (rm > THR) || (fresh && live);
    if (__any(trig)) {
        const float d = trig ? (fresh ? rm : fmaxf(rm, 0.f)) : 0.f;
        const float f = fresh ? 1.f : __builtin_amdgcn_exp2f(-d);
        mhat += d; lsum *= f; st = live ? 1.f : st;
#pragma unroll
        for (int r = 0; r < 16; ++r) { s0[r] -= d; s1[r] -= d; }
        if (has_next) {
#pragma unroll
            for (int r = 0; r < 16; ++r) { n0[r] -= d; n1[r] -= d; }
        }
        if (hi == 0) wsf[r32] = f;
        asm volatile("s_waitcnt lgkmcnt(0)" ::: "memory");
#pragma unroll
        for (int g = 0; g < 4; ++g) { const f32x4 fv = *(const LAS f32x4*)(wsf + 8 * g + 4 * hi);
#pragma unroll
            for (int d0 = 0; d0 < NDB; ++d0) { o[d0][4 * g] *= fv.x; o[d0][4 * g + 1] *= fv.y; o[d0][4 * g + 2] *= fv.z; o[d0][4 * g + 3] *= fv.w; } }
    }
    typedef float f32x2 __attribute__((ext_vector_type(2)));
    f32x2 sa = (f32x2){0.f, 0.f}, sb = (f32x2){0.f, 0.f};
#pragma unroll
    for (int r = 0; r < 16; r += 2) { s0[r] = __builtin_amdgcn_exp2f(s0[r]); s0[r + 1] = __builtin_amdgcn_exp2f(s0[r + 1]); s1[r] = __builtin_amdgcn_exp2f(s1[r]); s1[r + 1] = __builtin_amdgcn_exp2f(s1[r + 1]);
        sa = sa + (f32x2){s0[r], s0[r + 1]}; sb = sb + (f32x2){s1[r], s1[r + 1]}; }
    sa = sa + sb;
    lsum += sa.x + sa.y;
    bf16x8 pa[4];
    { v4u w;
      w.x = cvtpk(s0[0], s0[1]); w.y = cvtpk(s0[2], s0[3]); w.z = cvtpk(s0[4], s0[5]); w.w = cvtpk(s0[6], s0[7]); pa[0] = __builtin_bit_cast(bf16x8, w);
      w.x = cvtpk(s0[8], s0[9]); w.y = cvtpk(s0[10], s0[11]); w.z = cvtpk(s0[12], s0[13]); w.w = cvtpk(s0[14], s0[15]); pa[1] = __builtin_bit_cast(bf16x8, w);
      w.x = cvtpk(s1[0], s1[1]); w.y = cvtpk(s1[2], s1[3]); w.z = cvtpk(s1[4], s1[5]); w.w = cvtpk(s1[6], s1[7]); pa[2] = __builtin_bit_cast(bf16x8, w);
      w.x = cvtpk(s1[8], s1[9]); w.y = cvtpk(s1[10], s1[11]); w.z = cvtpk(s1[12], s1[13]); w.w = cvtpk(s1[14], s1[15]); pa[3] = __builtin_bit_cast(bf16x8, w); }
    pv_step<NDB>(o, vt, lane, pa);
}
struct RunState { int j0, j1, j2; unsigned long long rem; int ks0, ks1, ks2, vs0; bool c0; };
__device__ __forceinline__ int rs_pop(unsigned long long& rem) { if (!rem) return -1; const int j = __builtin_ctzll(rem); rem &= rem - 1; return j; }
template <int NDB, int NK, bool FOX> __device__ __forceinline__ bool rt_step(RunState& T, Stage2<NK, NDB / 2>& stg, const RunCfg<NDB, NK, FOX>& R, int tid,
        const bf16x8 (&qr)[4], float& mhat, float& st, float& lsum, f32x16 (&o)[NDB], f32x16& c0, f32x16& c1, f32x16& n0, f32x16& n1, LAS float* wsf) {
    const int lane = tid & 63;
    const bool pn = (T.j1 >= 0) && rt_part(R, T.j1);
    if (pn) rt_qk(n0, n1, R, T.j1, T.ks1, mhat, qr, lane);
    if (T.c0) { rt_mask(c0, c1, R, T.j0, lane);
        rt_softmax_pv<NDB>(mhat, st, lsum, o, c0, c1, pn, n0, n1, R.lds + R.VOFF + T.vs0 * NDB * VDB, wsf, lane); }
    if (T.j1 < 0) { FA_SYNC(); return false; }
    if (T.j2 >= 0) st_commit_k(stg, R, T.ks2, tid);
    st_commit_v(stg, R, T.vs0 ^ 1, tid);
    const int j3 = rs_pop(T.rem);
    if (j3 >= 0) st_issue_k(stg, R, j3, tid);
    if (T.j2 >= 0) st_issue_v(stg, R, T.j2, tid);
    FA_SYNC();
    T.j0 = T.j1; T.j1 = T.j2; T.j2 = j3; const int s = T.ks0; T.ks0 = T.ks1; T.ks1 = T.ks2; T.ks2 = s; T.vs0 ^= 1; T.c0 = pn;
    return true;
}
template <int NDB, int NK, bool FOX> __device__ __forceinline__ void run_tiles(const RunCfg<NDB, NK, FOX>& R, int tid, unsigned long long tiles,
        const bf16x8 (&qr)[4], float& mhat, float& st, float& lsum, f32x16 (&o)[NDB], LAS float* wsf) {
    const int lane = tid & 63;
    Stage2<NK, NDB / 2> stg; stg.ck = 0.f;
    RunState T; T.rem = tiles; T.ks0 = 0; T.ks1 = 1; T.ks2 = 2; T.vs0 = 0;
    T.j0 = rs_pop(T.rem);
    st_issue_k(stg, R, T.j0, tid); st_issue_v(stg, R, T.j0, tid);
    st_commit_k(stg, R, 0, tid); st_commit_v(stg, R, 0, tid);
    T.j1 = rs_pop(T.rem);
    if (T.j1 >= 0) { st_issue_k(stg, R, T.j1, tid); st_commit_k(stg, R, 1, tid); st_issue_v(stg, R, T.j1, tid); }
    T.j2 = rs_pop(T.rem);
    if (T.j2 >= 0) st_issue_k(stg, R, T.j2, tid);
    FA_SYNC();
    f32x16 a0, a1, b0, b1;
    T.c0 = rt_part(R, T.j0);
    if (T.c0) rt_qk(a0, a1, R, T.j0, 0, mhat, qr, lane);
    for (;;) {
        if (!rt_step(T, stg, R, tid, qr, mhat, st, lsum, o, a0, a1, b0, b1, wsf)) break;
        if (!rt_step(T, stg, R, tid, qr, mhat, st, lsum, o, b0, b1, a0, a1, wsf)) break;
    }
}

struct CvtRide { TItem t; int it, hi, step; bool full; const float* wg; const float* wu; const float* wd; unsigned char* ws; LAS float* scr; };
__device__ __forceinline__ TItem ride_decode(const CvtRide& Cv, int r) {
    constexpr int IT_MOE = 16 * 32; unsigned char* ws = Cv.ws; TItem t;
    const int le = r / (3 * IT_MOE); r -= le * 3 * IT_MOE; const int which = r / IT_MOE; r -= which * IT_MOE; const int kb = r / 32, nb = r % 32, n0 = 32 * nb;
    t.k0 = 64 * kb; t.n0 = n0;
    if (which < 2) { t.W = (which == 0 ? Cv.wg : Cv.wu) + (size_t)le * D * FF; t.ld = FF; t.K = D; t.WT = WSP(bf16, WS_WGUT) + (size_t)le * 2048 * 1024; t.drow0 = (n0 >> 7) * 256 + which * 128 + (n0 & 127); }
    else { t.W = Cv.wd + (size_t)le * FF * D; t.ld = D; t.K = FF; t.WT = WSP(bf16, WS_WDT) + (size_t)le * 1024 * 1024; t.drow0 = n0; }
    return t;
}
__device__ __forceinline__ void ride_emit(const TItem& t, const LAS float* scr, int lane) {
    const int n = lane & 31, ch = lane >> 5;
#pragma unroll
    for (int jj = 0; jj < 4; ++jj) { const int c = 2 * jj + ch;
        float s[8];
#pragma unroll
        for (int q = 0; q < 8; ++q) s[q] = scr[(8 * c + q) * 32 + n];
        v4u o; o.x = pg8::cvt_pk_bf16(s[0], s[1]); o.y = pg8::cvt_pk_bf16(s[2], s[3]); o.z = pg8::cvt_pk_bf16(s[4], s[5]); o.w = pg8::cvt_pk_bf16(s[6], s[7]);
        *(v4u*)(t.WT + (size_t)(t.drow0 + n) * t.K + t.k0 + 8 * c) = o; }
    asm volatile("s_waitcnt lgkmcnt(0)" ::: "memory");
}
__device__ __forceinline__ void ride_finish(CvtRide& Cv, int lane) {
    if (Cv.full) { asm volatile("s_waitcnt vmcnt(0)" ::: "memory"); ride_emit(Cv.t, Cv.scr, lane); Cv.full = false; }
}
__device__ __forceinline__ void ride_finish2(CvtRide& Cv, int lane) {
    if (Cv.full) { asm volatile("s_waitcnt vmcnt(2)" ::: "memory"); ride_emit(Cv.t, Cv.scr, lane); Cv.full = false; }
}
__device__ __forceinline__ void ride_start(CvtRide& Cv, int lane) {
    if (!Cv.full && Cv.it < Cv.hi) {
        Cv.t = ride_decode(Cv, Cv.it); Cv.it += Cv.step; Cv.full = true;
        const __amdgpu_buffer_rsrc_t rs = __builtin_amdgcn_make_buffer_rsrc((void*)(Cv.t.W + (size_t)Cv.t.k0 * Cv.t.ld + Cv.t.n0), (short)0, 64 * Cv.t.ld * 4, 0x00020000);
        int ln = lane; asm volatile("" : "+v"(ln));
        const int voff = ((ln >> 3) * Cv.t.ld + (ln & 7) * 4) * 4;
#pragma unroll
        for (int i = 0; i < 8; ++i) __builtin_amdgcn_raw_ptr_buffer_load_lds(rs, (LAS void*)(Cv.scr + i * 256), 16, voff, i * 8 * Cv.t.ld * 4, 0, 0);
    }
}
constexpr int FX_KB = 0, FX_VB = 2 * KT, FX_CK = FX_VB + 2 * 2 * VDB, FX_WSF = FX_CK + 512, FX_OST = FX_WSF + 8 * 256, FX_PRE = FX_OST + 8 * 4096, FX_FLG = FX_PRE + 256, FX_END = FX_FLG + 128;
constexpr float PRUNE = 40.f;
__device__ __forceinline__ void fox_unit(LAS unsigned char* lds, int tid_in, int b, int h, int qt, const bf16* QKV, const float* CUM, const float* CHTOT, bf16* AO, float knmax, CvtRide& Cv) {
    int tid = tid_in; asm volatile("" : "+v"(tid));
    const int lane = tid & 63, wid = __builtin_amdgcn_readfirstlane(tid >> 6), r32 = lane & 31, hi = lane >> 5;
    const int q0 = qt * 256, qw0 = q0 + wid * 32, NT = 4 * (qt + 1), dg = qw0 >> 6;
    const bf16* Kg = QKV + (size_t)(b * S) * QP + 1024 + h * 64;
    const bf16* Vg = QKV + (size_t)(b * S) * QP + 2048 + h * 64;
    const float* cg = CUM + (size_t)(b * S) * 16 + h;
    LAS float* wsf = (LAS float*)(lds + FX_WSF) + wid * 64;
    LAS float* pre = (LAS float*)(lds + FX_PRE);
    LAS int* flg = (LAS int*)(lds + FX_FLG);
    if (wid == 0) {
        const float val = (lane < NT) ? CHTOT[(size_t)(b * 64 + lane) * 16 + h] : 0.f; float inc = val;
#pragma unroll
        for (int o = 1; o < 64; o <<= 1) { const float u = shl_(inc, lane - o); if (lane >= o) inc += u; }
        pre[lane] = inc - val;
    }
    bf16x8 qr[4]; load_q(qr, QKV + (size_t)(b * S + qw0 + r32) * QP + h * 64, hi);
    float ub;
    { float s2 = 0.f;
#pragma unroll
      for (int d0 = 0; d0 < 4; ++d0) { const v4u u = __builtin_bit_cast(v4u, qr[d0]);
          const float a0 = bf2f(u.x & 0xffffu), a1 = bf2f(u.x >> 16), a2 = bf2f(u.y & 0xffffu), a3 = bf2f(u.y >> 16), a4 = bf2f(u.z & 0xffffu), a5 = bf2f(u.z >> 16), a6 = bf2f(u.w & 0xffffu), a7 = bf2f(u.w >> 16);
          s2 += (a0 * a0 + a1 * a1) + (a2 * a2 + a3 * a3) + (a4 * a4 + a5 * a5) + (a6 * a6 + a7 * a7); }
      ub = sqrtf(swapsum(s2)) * knmax * 1.01f + 0.01f; }
    float mhat = NEGBIG, lsum = 0.f; f32x16 o[2];
#pragma unroll
    for (int i = 0; i < 16; ++i) { o[0][i] = 0.f; o[1][i] = 0.f; }
    FA_SYNC();
    Stage<1, 1> st; float ckv = 0.f;
    { const int j = NT - 1; tile_issue<1, 1>(st, Kg + (size_t)(64 * j) * QP, Kg, QP, Vg + (size_t)(64 * j) * QP, QP, tid); if (tid < 64) ckv = (cg[(size_t)(64 * j + tid) * 16] + pre[j]) * LOG2E; }
    tile_commit<1, 1>(st, lds + FX_KB, lds + FX_VB, tid); if (tid < 64) ((LAS float*)(lds + FX_CK))[tid] = ckv;
    { const int j = NT - 2; tile_issue<1, 1>(st, Kg + (size_t)(64 * j) * QP, Kg, QP, Vg + (size_t)(64 * j) * QP, QP, tid); if (tid < 64) ckv = (cg[(size_t)(64 * j + tid) * 16] + pre[j]) * LOG2E; }
    FA_SYNC();
    bool mine = true;
    for (int i = 0;; ++i) {
        const int j = NT - 1 - i, kv0 = j * 64, bsel = i & 1;
        if (j == dg || (j < dg && mine)) {
            const LAS unsigned char* kt = lds + FX_KB + bsel * KT; const LAS unsigned char* vt = lds + FX_VB + bsel * 2 * VDB;
            const LAS float* ck = (const LAS float*)(lds + FX_CK) + bsel * 64;
            f32x16 p0, p1; qk_tile(p0, p1, qr, kt, lane);
#pragma unroll
            for (int g = 0; g < 4; ++g) { const f32x4 c0 = *(const LAS f32x4*)(ck + 8 * g + 4 * hi), c1 = *(const LAS f32x4*)(ck + 32 + 8 * g + 4 * hi);
                p0[4 * g] -= c0.x; p0[4 * g + 1] -= c0.y; p0[4 * g + 2] -= c0.z; p0[4 * g + 3] -= c0.w;
                p1[4 * g] -= c1.x; p1[4 * g + 1] -= c1.y; p1[4 * g + 2] -= c1.z; p1[4 * g + 3] -= c1.w; }
            if (j == dg) {
                const int qrel = qw0 + r32 - kv0;
#pragma unroll
                for (int r = 0; r < 16; ++r) { const int kvl = crow(r, hi); if (kvl > qrel) p0[r] = FA_NEG_INF; if (kvl + 32 > qrel) p1[r] = FA_NEG_INF; }
            }
            softmax_pv<2>(mhat, lsum, o, p0, p1, 0.f, 0.f, vt, wsf, lane);
        }
        if (j == 0) { FA_SYNC(); break; }
        const int jn = j - 1;
        if (jn < dg) mine = mine && (__any((ub - pre[jn + 1] * LOG2E) - mhat > -PRUNE) != 0);
        if (lane == 0) flg[(i & 1) * 8 + wid] = (jn >= dg || mine) ? 1 : 0;
        tile_commit<1, 1>(st, lds + FX_KB + (bsel ^ 1) * KT, lds + FX_VB + (bsel ^ 1) * 2 * VDB, tid); if (tid < 64) ((LAS float*)(lds + FX_CK))[(bsel ^ 1) * 64 + tid] = ckv;
        if (i % 3 == 2) ride_finish(Cv, lane);
        if (j >= 2) { const int j2 = j - 2; tile_issue<1, 1>(st, Kg + (size_t)(64 * j2) * QP, Kg, QP, Vg + (size_t)(64 * j2) * QP, QP, tid); if (tid < 64) ckv = (cg[(size_t)(64 * j2 + tid) * 16] + pre[j2]) * LOG2E; }
        if (i % 3 == 0) ride_start(Cv, lane);
        FA_SYNC();
        { const LAS int* f = flg + (i & 1) * 8; const int any = (f[0] | f[1]) | (f[2] | f[3]) | (f[4] | f[5]) | (f[6] | f[7]);
          if (__builtin_amdgcn_readfirstlane(any) == 0) break; }
    }
    finish_rows<2>(lsum, o, wsf, lane, 1.f);
    store_rows64(o, (LAS bf16*)(lds + FX_OST) + wid * 2048, AO + (size_t)(b * S + qw0) * D + h * 64, D, lane);
}

__device__ __forceinline__ float alibi_mod(f32x16& p0, f32x16& p1, float slope2, int qrel, bool causal, bool lower, bool flagged, bool flag, int hi) {
#pragma unroll
    for (int r = 0; r < 16; ++r) { const int c = (r & 3) + 8 * (r >> 2); p0[r] = __builtin_fmaf(slope2, (float)c, p0[r]); p1[r] = __builtin_fmaf(slope2, (float)(c + 32), p1[r]); }
    if (causal) {
#pragma unroll
        for (int r = 0; r < 16; ++r) { const int kvl = crow(r, hi); if (kvl > qrel) p0[r] = FA_NEG_INF; if (kvl + 32 > qrel) p1[r] = FA_NEG_INF; }
    }
    if (lower) {
#pragma unroll
        for (int r = 0; r < 16; ++r) { const int kvl = crow(r, hi); if (kvl <= qrel - 512) p0[r] = FA_NEG_INF; if (kvl + 32 <= qrel - 512) p1[r] = FA_NEG_INF; }
    }
    if (flagged) {
        if (!flag) {
#pragma unroll
            for (int r = 0; r < 16; ++r) { p0[r] = FA_NEG_INF; p1[r] = FA_NEG_INF; }
        }
    }
    return slope2 * (float)(-qrel);
}

constexpr int DF_KB = 0, DF_VB = 4 * KT, DF_WSF = DF_VB + 2 * 4 * VDB, DF_X = DF_WSF + 8 * 256, DF_XW = 32 * 132 * 4, DF_FLG = DF_X + 4 * DF_XW, DF_UB = DF_FLG + 64, DF_END = DF_UB + 1024;
__device__ __forceinline__ void diff_unit(LAS unsigned char* lds, int tid_in, int b, int h, int qt, const bf16* QKV, bf16* AO, float lam, int lpost, const float* subg, const unsigned* KN2) {
    int tid = tid_in; asm volatile("" : "+v"(tid));
    const int lane = tid & 63, wid = __builtin_amdgcn_readfirstlane(tid >> 6), r32 = lane & 31, hi = lane >> 5;
    const int cs = wid >> 2, q0 = qt * 128, qw0 = q0 + (wid & 3) * 32, NT = 2 * (qt + 1), dg = qw0 >> 6;
    const bf16* K0 = QKV + (size_t)(b * S) * QP + C_AK + h * 128;
    const bf16* Vg = QKV + (size_t)(b * S) * QP + C_AV + h * 128;
    const float slope2 = exp2f(-2.f * (float)(h + 1)) * LOG2E;
    LAS float* wsf = (LAS float*)(lds + DF_WSF) + wid * 64;
    LAS int* flg = (LAS int*)(lds + DF_FLG);
    bf16x8 qr[4]; load_q(qr, QKV + (size_t)(b * S + qw0 + r32) * QP + C_AQ + h * 128 + cs * 64, hi);
    float ub;
    { float s2 = 0.f;
#pragma unroll
      for (int d0 = 0; d0 < 4; ++d0) { const v4u u = __builtin_bit_cast(v4u, qr[d0]);
          const float a0 = bf2f(u.x & 0xffffu), a1 = bf2f(u.x >> 16), a2 = bf2f(u.y & 0xffffu), a3 = bf2f(u.y >> 16), a4 = bf2f(u.z & 0xffffu), a5 = bf2f(u.z >> 16), a6 = bf2f(u.w & 0xffffu), a7 = bf2f(u.w >> 16);
          s2 += (a0 * a0 + a1 * a1) + (a2 * a2 + a3 * a3) + (a4 * a4 + a5 * a5) + (a6 * a6 + a7 * a7); }
      const unsigned* kg = KN2 + b * 96 + 16 + 4 * h + 2 * cs;
      ub = sqrtf(swapsum(s2)) * sqrtf(__uint_as_float(kg[0]) + __uint_as_float(kg[1])) * 1.01f + 0.01f; }
    LAS float* ubs = (LAS float*)(lds + DF_UB) + wid * 32 + r32;
    *ubs = ub;
    float mhat = NEGBIG, lsum = 0.f; f32x16 o[4];
#pragma unroll
    for (int i = 0; i < 16; ++i) { o[0][i] = 0.f; o[1][i] = 0.f; o[2][i] = 0.f; o[3][i] = 0.f; }
    Stage<2, 2> st;
    { const size_t ro = (size_t)(64 * (NT - 1)) * QP; tile_issue<2, 2>(st, K0 + ro, K0 + ro + 64, QP, Vg + ro, QP, tid); }
    tile_commit<2, 2>(st, lds + DF_KB, lds + DF_VB, tid);
    { const size_t ro = (size_t)(64 * (NT - 2)) * QP; tile_issue<2, 2>(st, K0 + ro, K0 + ro + 64, QP, Vg + ro, QP, tid); }
    FA_SYNC();
    bool mine = true;
    for (int i = 0;; ++i) {
        const int j = NT - 1 - i, kv0 = j * 64, bsel = i & 1;
        if (j == dg || (j < dg && mine)) {
            const LAS unsigned char* kt = lds + DF_KB + (bsel * 2 + cs) * KT; const LAS unsigned char* vt = lds + DF_VB + bsel * 4 * VDB;
            f32x16 p0, p1; qk_tile(p0, p1, qr, kt, lane);
            const float off = alibi_mod(p0, p1, slope2, qw0 + r32 - kv0, j == dg, false, false, true, hi);
            softmax_pv<4>(mhat, lsum, o, p0, p1, off, slope2 * (float)(4 * hi), vt, wsf, lane);
        }
        if (j == 0) { FA_SYNC(); break; }
        const int jn = j - 1;
        if (jn < dg) mine = mine && (__any((*ubs + slope2 * (float)(64 * jn + 63 - (qw0 + r32))) - mhat > -PRUNE) != 0);
        if (lane == 0) flg[(i & 1) * 8 + wid] = (jn >= dg || mine) ? 1 : 0;
        tile_commit<2, 2>(st, lds + DF_KB + (bsel ^ 1) * 2 * KT, lds + DF_VB + (bsel ^ 1) * 4 * VDB, tid);
        if (j >= 2) { const size_t ro = (size_t)(64 * (j - 2)) * QP; tile_issue<2, 2>(st, K0 + ro, K0 + ro + 64, QP, Vg + ro, QP, tid); }
        FA_SYNC();
        { const LAS int* f = flg + (i & 1) * 8; const int any = (f[0] | f[1]) | (f[2] | f[3]) | (f[4] | f[5]) | (f[6] | f[7]);
          if (__builtin_amdgcn_readfirstlane(any) == 0) break; }
    }
    finish_rows<4>(lsum, o, wsf, lane, 1.f);
    LAS float* X = (LAS float*)(lds + DF_X + (wid & 3) * DF_XW);
    if (cs == 1) {
#pragma unroll
        for (int r = 0; r < 16; ++r)
#pragma unroll
            for (int d0 = 0; d0 < 4; ++d0) X[crow(r, hi) * 132 + d0 * 32 + r32] = o[d0][r];
    }
    FA_SYNC();
    if (cs == 0) {
#pragma unroll
        for (int r = 0; r < 16; ++r)
#pragma unroll
            for (int d0 = 0; d0 < 4; ++d0) { LAS float* xp = X + crow(r, hi) * 132 + d0 * 32 + r32; *xp = o[d0][r] - lam * *xp; }
        asm volatile("s_waitcnt lgkmcnt(0)" ::: "memory");
        const int row = lane >> 1, half = lane & 1;
        f32x4 v[16]; float ss = 0.f;
#pragma unroll
        for (int i = 0; i < 16; ++i) { v[i] = *(const LAS f32x4*)(X + row * 132 + half * 64 + 4 * i); ss += (v[i].x * v[i].x + v[i].y * v[i].y) + (v[i].z * v[i].z + v[i].w * v[i].w); }
        ss += shx<1>(ss);
        int lp_ = lpost; asm volatile("" : "+s"(lp_));
        const float post = (lp_ == 0) ? 0.8f : (lp_ == 1) ? 0.64449093f : (lp_ == 2) ? 0.52928698f : 0.44394179f;
        const float rs = rsqrtf(ss * (1.f / 128.f) + EPS) * post;
        bf16* dst = AO + (size_t)(b * S + qw0 + row) * D + h * 128 + half * 64;
#pragma unroll
        for (int i = 0; i < 8; ++i) { const f32x4 g0 = *(const f32x4*)(subg + half * 64 + 8 * i), g1 = *(const f32x4*)(subg + half * 64 + 8 * i + 4);
            v4u w; w.x = cvtpk(v[2 * i].x * rs * g0.x, v[2 * i].y * rs * g0.y); w.y = cvtpk(v[2 * i].z * rs * g0.z, v[2 * i].w * rs * g0.w);
            w.z = cvtpk(v[2 * i + 1].x * rs * g1.x, v[2 * i + 1].y * rs * g1.y); w.w = cvtpk(v[2 * i + 1].z * rs * g1.z, v[2 * i + 1].w * rs * g1.w);
            *(v4u*)(dst + 8 * i) = w; }
    }
    FA_SYNC();
}

constexpr int NS_KB = 0, NS_VB = 4 * KT, NS_WSF = NS_VB + 4 * 2 * VDB, NS_IMP = NS_WSF + 8 * 256, NS_SEL = NS_IMP + 65536, NS_UNI = NS_SEL + 512, NS_END = NS_UNI + 64;
__device__ __forceinline__ void nsa_branch(LAS unsigned char* lds, int tid, const bool SLC, unsigned long long tiles, const bf16* Kg, const bf16* Vg, int cur, int qw0, float slope2,
                                           unsigned long long mysel, const bf16x8 (&qr)[4], float& mhat, float& lsum, f32x16 (&o)[2], LAS float* wsf, CvtRide& Cv) {
    const int lane = tid & 63, r32 = lane & 31, hi = lane >> 5;
    Stage<1, 1> stA, stB;
    unsigned long long rem = tiles;
    int jc = __builtin_ctzll(rem); rem &= rem - 1;
    tile_issue<1, 1>(stA, Kg + (size_t)(64 * jc) * QP, Kg, QP, Vg + (size_t)(64 * jc) * QP, QP, tid);
    tile_commit<1, 1>(stA, lds + NS_KB, lds + NS_VB, tid);
    int j1 = -1; if (rem) { j1 = __builtin_ctzll(rem); rem &= rem - 1; tile_issue<1, 1>(stA, Kg + (size_t)(64 * j1) * QP, Kg, QP, Vg + (size_t)(64 * j1) * QP, QP, tid); }
    int j2 = -1; if (rem) { j2 = __builtin_ctzll(rem); rem &= rem - 1; tile_issue<1, 1>(stB, Kg + (size_t)(64 * j2) * QP, Kg, QP, Vg + (size_t)(64 * j2) * QP, QP, tid); }
    FA_SYNC();
    int bsel = 0, nride = 0;
#define NSB_STEP(SA) { \
        const bool flag = SLC ? (((mysel >> jc) & 1ull) != 0ull) : true; \
        if (__any(flag)) { \
            const LAS unsigned char* kt = lds + NS_KB + bsel * KT; const LAS unsigned char* vt = lds + NS_VB + bsel * 2 * VDB; \
            f32x16 p0, p1; qk_tile(p0, p1, qr, kt, lane); \
            const float off = alibi_mod(p0, p1, slope2, qw0 + r32 - 64 * jc, jc == cur, (!SLC) && (jc == cur - 8), SLC, flag, hi); \
            softmax_pv<2>(mhat, lsum, o, p0, p1, off, slope2 * (float)(4 * hi), vt, wsf, lane); \
        } \
        if (j1 < 0) { ride_finish(Cv, lane); FA_SYNC(); break; }        \
        tile_commit<1, 1>(SA, lds + NS_KB + (bsel ^ 1) * KT, lds + NS_VB + (bsel ^ 1) * 2 * VDB, tid); \
        ++nride; if (nride == 3) { if (j2 >= 0) ride_finish2(Cv, lane); else ride_finish(Cv, lane); nride = 0; }        \
        int j3 = -1; if (rem) { j3 = __builtin_ctzll(rem); rem &= rem - 1; tile_issue<1, 1>(SA, Kg + (size_t)(64 * j3) * QP, Kg, QP, Vg + (size_t)(64 * j3) * QP, QP, tid); } \
        if (nride == 1) ride_start(Cv, lane); \
        FA_SYNC(); \
        jc = j1; j1 = j2; j2 = j3; bsel ^= 1; }
    for (;;) { NSB_STEP(stA) NSB_STEP(stB) }
#undef NSB_STEP
}
__device__ __forceinline__ void nsa_unit(LAS unsigned char* lds, int tid_in, int b, int g, int qt, const bf16* QKV, const bf16* KC, const bf16* VC, const float* GL, bf16* AO, CvtRide& Cv) {
    int tid = tid_in; asm volatile("" : "+v"(tid));
    const int lane = tid & 63, wid = __builtin_amdgcn_readfirstlane(tid >> 6), r32 = lane & 31, hi = lane >> 5;
    const int hg = wid & 3, psub = wid >> 2, cur = qt, q0 = qt * 64, qw0 = q0 + psub * 32, head = g * 4 + hg;
    const int qpos = qw0 + r32, trow = b * S + qpos;
    const float slope2 = exp2f(-(float)(head + 1)) * LOG2E;
    LAS float* wsf = (LAS float*)(lds + NS_WSF) + wid * 64;
    bf16x8 qr[4]; load_q(qr, QKV + (size_t)trow * QP + C_BQ + head * 64, hi);
    const float g_cmp = sigmoidf_(GL[(size_t)trow * 32 + head * 3 + 0]), g_slc = sigmoidf_(GL[(size_t)trow * 32 + head * 3 + 1]), g_win = sigmoidf_(GL[(size_t)trow * 32 + head * 3 + 2]);
    f32x16 outa[2];
    const int nmax = (q0 + 32) >> 4, ntc = (nmax >> 6) + 1;
    { Stage<1, 1> sc[4];
#pragma unroll
      for (int tt = 0; tt < 4; ++tt) if (tt < ntc) {
          const bf16* kc = KC + ((size_t)(b * 256 + 64 * tt) * 2 + g) * 64; const bf16* vc = VC + ((size_t)(b * 256 + 64 * tt) * 2 + g) * 64;
          tile_issue<1, 1>(sc[tt], kc, kc, 128, vc, 128, tid); }
#pragma unroll
      for (int tt = 0; tt < 4; ++tt) if (tt < ntc) tile_commit<1, 1>(sc[tt], lds + NS_KB + tt * KT, lds + NS_VB + tt * 2 * VDB, tid);
    }
    FA_SYNC();
    {
        float m = FA_NEG_INF, l = 0.f;
#pragma unroll 1
        for (int tt = 0; tt < ntc; ++tt) {
            f32x16 p0, p1; qk_tile(p0, p1, qr, lds + NS_KB + tt * KT, lane);
            float rm = FA_NEG_INF;
            const int dbase = qpos - 31 - 16 * (64 * tt + 4 * hi);
#pragma unroll
            for (int r = 0; r < 16; ++r) { const int d0 = dbase - 16 * ((r & 3) + 8 * (r >> 2)), d1 = d0 - 16 * 32;
                p0[r] = (d0 >= 0) ? p0[r] - slope2 * (float)d0 : FA_NEG_INF; p1[r] = (d1 >= 0) ? p1[r] - slope2 * (float)d1 : FA_NEG_INF;
                rm = fmaxf(rm, fmaxf(p0[r], p1[r])); }
            rm = swapmax(rm);
            const float mn = fmaxf(m, rm);
            if (mn > FA_NEG_INF) {
                float sa = 0.f;
#pragma unroll
                for (int r = 0; r < 16; ++r) sa += __builtin_amdgcn_exp2f(p0[r] - mn) + __builtin_amdgcn_exp2f(p1[r] - mn);
                l = l * __builtin_amdgcn_exp2f(m - mn) + sa; m = mn;
            }
        }
        l = swapsum(l);
        const float inv = (l > 0.f) ? 1.f / l : 0.f;
        const float mref = (m > FA_NEG_INF) ? m : 0.f;
        f32x16 oc[2];
#pragma unroll
        for (int i = 0; i < 16; ++i) { oc[0][i] = 0.f; oc[1][i] = 0.f; }
        LAS float* imp = (LAS float*)(lds + NS_IMP) + (hg * 64 + psub * 32 + r32) * 64;
        float carry = 0.f;
#pragma unroll 1
        for (int tt = 0; tt < ntc; ++tt) {
            f32x16 p0, p1; qk_tile(p0, p1, qr, lds + NS_KB + tt * KT, lane);
            const int dbase = qpos - 31 - 16 * (64 * tt + 4 * hi);
#pragma unroll
            for (int r = 0; r < 16; ++r) { const int d0 = dbase - 16 * ((r & 3) + 8 * (r >> 2)), d1 = d0 - 16 * 32;
                p0[r] = (d0 >= 0) ? __builtin_amdgcn_exp2f(p0[r] - slope2 * (float)d0 - mref) * inv : 0.f;
                p1[r] = (d1 >= 0) ? __builtin_amdgcn_exp2f(p1[r] - slope2 * (float)d1 - mref) * inv : 0.f; }
#pragma unroll
            for (int h2 = 0; h2 < 2; ++h2)
#pragma unroll
                for (int mm = 0; mm < 4; ++mm) {
                    const f32x16& pp = h2 ? p1 : p0;
                    const float G = (pp[4 * mm] + pp[4 * mm + 1]) + (pp[4 * mm + 2] + pp[4 * mm + 3]), L = pp[4 * mm + 3];
                    auto rr = __builtin_amdgcn_permlane32_swap(__float_as_uint(L), __float_as_uint(L), false, false);
                    const float Lo = __uint_as_float(hi ? rr[0] : rr[1]);
                    const float val = G + (hi ? Lo : carry);
                    carry = Lo;
                    imp[16 * tt + 8 * h2 + 2 * mm + hi] = val;
                }
            bf16x8 pa[4];
            { v4u w;
              w.x = cvtpk(p0[0], p0[1]); w.y = cvtpk(p0[2], p0[3]); w.z = cvtpk(p0[4], p0[5]); w.w = cvtpk(p0[6], p0[7]); pa[0] = __builtin_bit_cast(bf16x8, w);
              w.x = cvtpk(p0[8], p0[9]); w.y = cvtpk(p0[10], p0[11]); w.z = cvtpk(p0[12], p0[13]); w.w = cvtpk(p0[14], p0[15]); pa[1] = __builtin_bit_cast(bf16x8, w);
              w.x = cvtpk(p1[0], p1[1]); w.y = cvtpk(p1[2], p1[3]); w.z = cvtpk(p1[4], p1[5]); w.w = cvtpk(p1[6], p1[7]); pa[2] = __builtin_bit_cast(bf16x8, w);
              w.x = cvtpk(p1[8], p1[9]); w.y = cvtpk(p1[10], p1[11]); w.z = cvtpk(p1[12], p1[13]); w.w = cvtpk(p1[14], p1[15]); pa[3] = __builtin_bit_cast(bf16x8, w); }
            pv_step<2>(oc, lds + NS_VB + tt * 2 * VDB, lane, pa);
        }
        if (hi == 0) wsf[32 + r32] = g_cmp;
        asm volatile("s_waitcnt lgkmcnt(0)" ::: "memory");
#pragma unroll
        for (int gq = 0; gq < 4; ++gq) { const f32x4 fv = *(const LAS f32x4*)(wsf + 32 + 8 * gq + 4 * hi);
#pragma unroll
            for (int d0 = 0; d0 < 2; ++d0) { outa[d0][4 * gq] = oc[d0][4 * gq] * fv.x; outa[d0][4 * gq + 1] = oc[d0][4 * gq + 1] * fv.y; outa[d0][4 * gq + 2] = oc[d0][4 * gq + 2] * fv.z; outa[d0][4 * gq + 3] = oc[d0][4 * gq + 3] * fv.w; } }
    }
    FA_SYNC();
    {
        const LAS float* impb = (const LAS float*)(lds + NS_IMP);
        unsigned long long uni = 0ull;
#pragma unroll 1
        for (int pp = 0; pp < 8; ++pp) {
            const int pos = wid * 8 + pp;
            const bool avail = lane <= cur, forced = (lane == 0) || (lane == cur) || (lane == cur - 1);
            float iv = 0.f;
            if (avail && lane < 16 * ntc) iv = ((impb[(0 * 64 + pos) * 64 + lane] + impb[(1 * 64 + pos) * 64 + lane]) + impb[(2 * 64 + pos) * 64 + lane]) + impb[(3 * 64 + pos) * 64 + lane];
            const float score = avail ? iv + (forced ? 1e4f : 0.f) : NEGBIG;
            int rank = 0;
            for (int j = 0; j <= cur; ++j) { const float sj = __uint_as_float(__builtin_amdgcn_readlane(__float_as_uint(score), j)); rank += (sj > score || (sj == score && j < lane)) ? 1 : 0; }
            const unsigned long long sel = __ballot(avail && rank < 16);
            if (lane == 0) ((LAS unsigned long long*)(lds + NS_SEL))[pos] = sel;
            uni |= sel;
        }
        if (lane == 0) ((LAS unsigned long long*)(lds + NS_UNI))[wid] = uni;
    }
    FA_SYNC();
    const unsigned long long mysel = ((const LAS unsigned long long*)(lds + NS_SEL))[psub * 32 + r32];
    unsigned long long uni = 0ull;
#pragma unroll
    for (int w = 0; w < 8; ++w) uni |= ((const LAS unsigned long long*)(lds + NS_UNI))[w];
    uni = __builtin_amdgcn_readfirstlane((unsigned)uni) | ((unsigned long long)__builtin_amdgcn_readfirstlane((unsigned)(uni >> 32)) << 32);
    const bf16* base = QKV + (size_t)(b * S) * QP + g * 64;
#pragma unroll 1
    for (int br = 0; br < 2; ++br) {
        const bool slc = (br == 0);
        float mhat = NEGBIG, lsum = 0.f; f32x16 o[2];
#pragma unroll
        for (int i = 0; i < 16; ++i) { o[0][i] = 0.f; o[1][i] = 0.f; }
        const int lo = cur > 8 ? cur - 8 : 0;
        const unsigned long long wt = ((cur == 63) ? ~0ull : ((1ull << (cur + 1)) - 1ull)) & ~((1ull << lo) - 1ull);
#if ATTN_V2
        nsa_branch2(lds, tid, slc, slc ? uni : wt, base + (slc ? C_KS : C_KW), base + (slc ? C_VS : C_VW), cur, qw0, slope2, mysel, qr, lsum, o, wsf);
#else
        nsa_branch(lds, tid, slc, slc ? uni : wt, base + (slc ? C_KS : C_KW), base + (slc ? C_VS : C_VW), cur, qw0, slope2, mysel, qr, mhat, lsum, o, wsf, Cv);
#endif
        finish_rows<2>(lsum, o, wsf, lane, slc ? g_slc : g_win);
#pragma unroll
        for (int i = 0; i < 16; ++i) { outa[0][i] += o[0][i]; outa[1][i] += o[1][i]; }
    }
    store_rows64(outa, (LAS bf16*)(lds + NS_IMP) + wid * 2048, AO + (size_t)(b * S + qw0) * D + 512 + head * 64, D, lane);
    FA_SYNC();
}

constexpr int F2_K = 0, F2_V = 3 * KT, F2_C = F2_V + 2 * 2 * VDB, F2_WSF = F2_C + 768, F2_OST = F2_WSF + 8 * 256, F2_PRE = F2_OST + 8 * 4096, F2_END = F2_PRE + 256;
__device__ __forceinline__ void fox_unit2(LAS unsigned char* lds, int tid_in, int b, int h, int qt, const bf16* QKV, const float* CUM, const float* CHTOT, bf16* AO) {
    int tid = tid_in; asm volatile("" : "+v"(tid));
    const int lane = tid & 63, wid = __builtin_amdgcn_readfirstlane(tid >> 6), r32 = lane & 31, hi = lane >> 5;
    const int q0 = qt * 256, qw0 = q0 + wid * 32, NT = 4 * (qt + 1);
    LAS float* wsf = (LAS float*)(lds + F2_WSF) + wid * 64;
    LAS float* pre = (LAS float*)(lds + F2_PRE);
    if (wid == 0) {
        const float val = (lane < NT) ? CHTOT[(size_t)(b * 64 + lane) * 16 + h] : 0.f; float inc = val;
#pragma unroll
        for (int o = 1; o < 64; o <<= 1) { const float u = shl_(inc, lane - o); if (lane >= o) inc += u; }
        pre[lane] = inc - val;
    }
    bf16x8 qr[4]; load_q(qr, QKV + (size_t)(b * S + qw0 + r32) * QP + h * 64, hi);
    float mhat = 0.f, st = 0.f, lsum = 0.f; f32x16 o[2];
#pragma unroll
    for (int i = 0; i < 16; ++i) { o[0][i] = 0.f; o[1][i] = 0.f; }
    FA_SYNC();
    RunCfg<2, 1, true> R;
    R.lds = lds; R.KOFF = F2_K; R.VOFF = F2_V; R.COFF = F2_C;
    R.Kg0 = QKV + (size_t)(b * S) * QP + 1024 + h * 64; R.Kg1 = R.Kg0; R.Vg = QKV + (size_t)(b * S) * QP + 2048 + h * 64; R.pitch = QP;
    R.cg = CUM + (size_t)(b * S) * 16 + h; R.pre = pre; R.ksel = 0; R.slope2 = 0.f; R.qw0 = qw0; R.low = -1; R.slc = false; R.mysel = 0ull;
    run_tiles<2, 1, true>(R, tid, (NT == 64) ? ~0ull : ((1ull << NT) - 1ull), qr, mhat, st, lsum, o, wsf);
    finish_rows<2>(lsum, o, wsf, lane, 1.f);
    store_rows64(o, (LAS bf16*)(lds + F2_OST) + wid * 2048, AO + (size_t)(b * S + qw0) * D + h * 64, D, lane);
}

constexpr int D2_K = 0, D2_V = 3 * 2 * KT, D2_WSF = D2_V + 2 * 4 * VDB, D2_END = D2_WSF + 8 * 256, D2_X = 0;
__device__ __forceinline__ void diff_unit2(LAS unsigned char* lds, int tid_in, int b, int h, int qt, const bf16* QKV, bf16* AO, float lam, float post, const float* subg) {
    int tid = tid_in; asm volatile("" : "+v"(tid));
    const int lane = tid & 63, wid = __builtin_amdgcn_readfirstlane(tid >> 6), r32 = lane & 31, hi = lane >> 5;
    const int cs = wid >> 2, q0 = qt * 128, qw0 = q0 + (wid & 3) * 32, NT = 2 * (qt + 1);
    LAS float* wsf = (LAS float*)(lds + D2_WSF) + wid * 64;
    bf16x8 qr[4]; load_q(qr, QKV + (size_t)(b * S + qw0 + r32) * QP + C_AQ + h * 128 + cs * 64, hi);
    float mhat = 0.f, st = 0.f, lsum = 0.f; f32x16 o[4];
#pragma unroll
    for (int i = 0; i < 16; ++i) { o[0][i] = 0.f; o[1][i] = 0.f; o[2][i] = 0.f; o[3][i] = 0.f; }
    RunCfg<4, 2, false> R;
    R.lds = lds; R.KOFF = D2_K; R.VOFF = D2_V; R.COFF = 0;
    R.Kg0 = QKV + (size_t)(b * S) * QP + C_AK + h * 128; R.Kg1 = R.Kg0 + 64; R.Vg = QKV + (size_t)(b * S) * QP + C_AV + h * 128; R.pitch = QP;
    R.cg = nullptr; R.pre = nullptr; R.ksel = cs; R.slope2 = exp2f(-2.f * (float)(h + 1)) * LOG2E; R.qw0 = qw0; R.low = -1; R.slc = false; R.mysel = 0ull;
    run_tiles<4, 2, false>(R, tid, (NT == 64) ? ~0ull : ((1ull << NT) - 1ull), qr, mhat, st, lsum, o, wsf);
    finish_rows<4>(lsum, o, wsf, lane, 1.f);
    LAS float* X = (LAS float*)(lds + D2_X + (wid & 3) * DF_XW);
    if (cs == 1) {
#pragma unroll
        for (int r = 0; r < 16; ++r)
#pragma unroll
            for (int d0 = 0; d0 < 4; ++d0) X[crow(r, hi) * 132 + d0 * 32 + r32] = o[d0][r];
    }
    FA_SYNC();
    if (cs == 0) {
#pragma unroll
        for (int r = 0; r < 16; ++r)
#pragma unroll
            for (int d0 = 0; d0 < 4; ++d0) { LAS float* xp = X + crow(r, hi) * 132 + d0 * 32 + r32; *xp = o[d0][r] - lam * *xp; }
        asm volatile("s_waitcnt lgkmcnt(0)" ::: "memory");
        const int row = lane >> 1, half = lane & 1;
        f32x4 v[16]; float ss = 0.f;
#pragma unroll
        for (int i = 0; i < 16; ++i) { v[i] = *(const LAS f32x4*)(X + row * 132 + half * 64 + 4 * i); ss += (v[i].x * v[i].x + v[i].y * v[i].y) + (v[i].z * v[i].z + v[i].w * v[i].w); }
        ss += shx<1>(ss);
        const float rs = rsqrtf(ss * (1.f / 128.f) + EPS) * post;
        bf16* dst = AO + (size_t)(b * S + qw0 + row) * D + h * 128 + half * 64;
#pragma unroll
        for (int i = 0; i < 8; ++i) { const f32x4 g0 = *(const f32x4*)(subg + half * 64 + 8 * i), g1 = *(const f32x4*)(subg + half * 64 + 8 * i + 4);
            v4u w; w.x = cvtpk(v[2 * i].x * rs * g0.x, v[2 * i].y * rs * g0.y); w.y = cvtpk(v[2 * i].z * rs * g0.z, v[2 * i].w * rs * g0.w);
            w.z = cvtpk(v[2 * i + 1].x * rs * g1.x, v[2 * i + 1].y * rs * g1.y); w.w = cvtpk(v[2 * i + 1].z * rs * g1.z, v[2 * i + 1].w * rs * g1.w);
            *(v4u*)(dst + 8 * i) = w; }
    }
    FA_SYNC();
}
__device__ __forceinline__ void nsa_branch2(LAS unsigned char* lds, int tid, const bool SLC, unsigned long long tiles, const bf16* Kg, const bf16* Vg, int cur, int qw0, float slope2,
                                            unsigned long long mysel, const bf16x8 (&qr)[4], float& lsum, f32x16 (&o)[2], LAS float* wsf) {
    RunCfg<2, 1, false> R;
    R.lds = lds; R.KOFF = NS_KB; R.VOFF = NS_VB; R.COFF = 0;
    R.Kg0 = Kg; R.Kg1 = Kg; R.Vg = Vg; R.pitch = QP; R.cg = nullptr; R.pre = nullptr; R.ksel = 0; R.slope2 = slope2; R.qw0 = qw0;
    R.low = (!SLC && cur >= 8) ? cur - 8 : -1; R.slc = SLC; R.mysel = mysel;
    float mhat = 0.f, st = 0.f;
    run_tiles<2, 1, false>(R, tid, tiles, qr, mhat, st, lsum, o, wsf);
}

__device__ __forceinline__ void even_attn_phase(const Ctx& C0, int l) {
    PHASE_PROLOG(C0);
    const bf16* QKV = WSP(bf16, WS_QKV); bf16* AO = WSP(bf16, WS_AO);
    const int e = l >> 1;
    const float lam_init = 0.8f - 0.6f * __expf(-0.3f * (float)l);
    float lam;
    { const float* lp = INP(I_DLAM) + e * 256; int tl0 = C.tid; asm volatile("" : "+v"(tl0)); const int ln0 = tl0 & 63; const float a1 = wave_sum(lp[ln0] * lp[64 + ln0]), a2 = wave_sum(lp[128 + ln0] * lp[192 + ln0]);
      lam = __uint_as_float(__builtin_amdgcn_readfirstlane(__float_as_uint(__expf(a1) - __expf(a2) + lam_init))); }
    CvtRide Cv; Cv.wg = INP(I_WG); Cv.wu = INP(I_WU); Cv.wd = INP(I_WD); Cv.ws = ws; Cv.scr = (LAS float*)(C.lds + NS_IMP) + C.wave * 2048; Cv.full = false; Cv.step = C.NGW;
    Cv.it = l * CVT_MOE_L + C.gw; Cv.hi = (l + 1) * CVT_MOE_L;
    const unsigned* KN2 = WSP(unsigned, WS_CTL) + CW_KNP + l * 384;
    for (int vc = blockIdx.x; vc < 256; vc += gridDim.x) {
        { const int bh = vc >> 4, s = vc & 15, b = bh >> 2, h = bh & 3;
#pragma unroll 1
          for (int i = 0; i < 2; ++i) diff_unit(C.lds, C.tid, b, i ? 3 - h : h, i ? 31 - s : s, QKV, AO, lam, l, INP(I_DSUB) + e * 128, KN2); }
        { const int bg = vc >> 5, s = vc & 31;
#pragma unroll 1
          for (int i = 0; i < 2; ++i) nsa_unit(C.lds, C.tid, bg >> 1, bg & 1, i == 0 ? s : 63 - s, QKV, WSP(bf16, WS_KCMP), WSP(bf16, WS_VCMP), WSP(float, WS_GL), AO, Cv); }
    }
    { int tl = C.tid; asm volatile("" : "+v"(tl)); const int ln2 = tl & 63;
      while (Cv.full || Cv.it < Cv.hi) { ride_finish(Cv, ln2); ride_start(Cv, ln2); } }
}
__device__ __forceinline__ void fox_phase(const Ctx& C0, int l) {
    PHASE_PROLOG(C0);
    const bf16* QKV = WSP(bf16, WS_QKV); const float* CUM = WSP(float, WS_CUMF); const float* CHTOT = WSP(float, WS_CHTOT); bf16* AO = WSP(bf16, WS_AO);
    CvtRide Cv; Cv.wg = INP(I_WG); Cv.wu = INP(I_WU); Cv.wd = INP(I_WD); Cv.ws = ws; Cv.scr = (LAS float*)(C.lds + FX_END) + C.wave * 2048; Cv.full = false; Cv.step = C.NGW;
    Cv.it = l * CVT_MOE_L + C.gw; Cv.hi = (l + 1) * CVT_MOE_L;
    unsigned* qword = WSP(unsigned, WS_CTL) + CW_FQ + (l >> 1) * 64; const unsigned* KN = WSP(unsigned, WS_CTL) + CW_KNP + l * 384;
    LAS int* qslot = (LAS int*)(C.lds + LDS_BYTES - 64);
    if (C.tid == 0) qslot[0] = (int)__hip_atomic_fetch_add(qword, 1u, __ATOMIC_RELAXED, __HIP_MEMORY_SCOPE_AGENT);
    FA_SYNC();
    int idx = __builtin_amdgcn_readfirstlane(qslot[0]), par = 0;
    while (idx < 1024) {
        par ^= 1;
        if (C.tid == 0) qslot[par] = (int)__hip_atomic_fetch_add(qword, 1u, __ATOMIC_RELAXED, __HIP_MEMORY_SCOPE_AGENT);
        const int bh = idx & 63, qt = 15 - (idx >> 6);
        const unsigned* kg = KN + (bh >> 4) * 96 + 32 + 2 * (bh & 15);
        const float knmax = sqrtf(__uint_as_float(kg[0]) + __uint_as_float(kg[1]));
        fox_unit(C.lds, C.tid, bh >> 4, bh & 15, qt, QKV, CUM, CHTOT, AO, knmax, Cv);
        FA_SYNC();
        idx = __builtin_amdgcn_readfirstlane(qslot[par]);
    }
    while (Cv.full || Cv.it < Cv.hi) { ride_finish(Cv, C.lane); ride_start(Cv, C.lane); }
}
}

#ifndef USE_MFMA_FOX
#define USE_MFMA_FOX 1
#endif
#ifndef ATTN_V2
#define ATTN_V2 1
#endif
#ifndef USE_MFMA_EVEN
#define USE_MFMA_EVEN 1
#endif
__device__ __forceinline__ void p_attn(const Ctx& C, int l) {
    if ((l & 1) == 0) {
#if USE_MFMA_EVEN
        fa::even_attn_phase(C, l);
        return;
#endif
        const int nd = NB * 4 * S, nn = NB * 2 * S;
        for (int item = C.gw; item < nd + nn; item += C.NGW) {
            if (item < nd) attn_diff_row(C, l, item); else attn_nsa_row(C, l, item - nd);
        }
    } else {
#if USE_MFMA_FOX
        fa::fox_phase(C, l);
#else
        for (int item = C.gw; item < NB * 16 * S; item += C.NGW) attn_fox_row(C, item);
#endif
    }
}


__device__ __forceinline__ void p_knorm_diff(const Ctx& C0, int l) {
    PHASE_PROLOG(C0);
    const bf16* QKV = WSP(bf16, WS_QKV); unsigned* KN = WSP(unsigned, WS_CTL) + CW_KN2 + (l >> 1) * 64;
    LAS float* red = (LAS float*)(C.lds + 81920);
    for (int item = blockIdx.x; item < 256; item += gridDim.x) {
        const int bhc = item >> 3, q = item & 7, b = bhc >> 3, hc = bhc & 7;
        const bf16* Kb = QKV + (size_t)(b * S + q * 512 + C.tid) * QP + C_AK + hc * 64; float s2 = 0.f;
#pragma unroll
        for (int c = 0; c < 8; ++c) { const v4u u = *(const v4u*)(Kb + c * 8);
            const float a0 = bf2f(u.x & 0xffffu), a1 = bf2f(u.x >> 16), a2 = bf2f(u.y & 0xffffu), a3 = bf2f(u.y >> 16), a4 = bf2f(u.z & 0xffffu), a5 = bf2f(u.z >> 16), a6 = bf2f(u.w & 0xffffu), a7 = bf2f(u.w >> 16);
            s2 += (a0 * a0 + a1 * a1) + (a2 * a2 + a3 * a3) + (a4 * a4 + a5 * a5) + (a6 * a6 + a7 * a7); }
        const float m2 = wave_max(s2);
        __syncthreads();
        if (C.lane == 0) red[C.wave] = m2;
        __syncthreads();
        if (C.tid == 0) { const float m = fmaxf(fmaxf(fmaxf(red[0], red[1]), fmaxf(red[2], red[3])), fmaxf(fmaxf(red[4], red[5]), fmaxf(red[6], red[7])));
            __hip_atomic_fetch_max(KN + bhc, __float_as_uint(m), __ATOMIC_RELAXED, __HIP_MEMORY_SCOPE_AGENT); }
    }
}

__device__ __forceinline__ void p_knorm(const Ctx& C0, int l) {
    PHASE_PROLOG(C0);
    const bf16* QKV = WSP(bf16, WS_QKV); unsigned* KN = WSP(unsigned, WS_CTL) + CW_KN + (l >> 1) * 64;
    LAS float* red = (LAS float*)C.lds;
    for (int item = blockIdx.x; item < 256; item += gridDim.x) {
        const int bh = item >> 2, q = item & 3;
        const bf16* Kb = QKV + (size_t)((bh >> 4) * S + q * 1024) * QP + 1024 + (bh & 15) * 64; float m2 = 0.f;
#pragma unroll
        for (int kk = 0; kk < 2; ++kk) { const int k = C.tid + kk * NTHR; float s2 = 0.f;
#pragma unroll
            for (int c = 0; c < 8; ++c) { const v4u u = *(const v4u*)(Kb + (size_t)k * QP + c * 8);
                const float a0 = bf2f(u.x & 0xffffu), a1 = bf2f(u.x >> 16), a2 = bf2f(u.y & 0xffffu), a3 = bf2f(u.y >> 16), a4 = bf2f(u.z & 0xffffu), a5 = bf2f(u.z >> 16), a6 = bf2f(u.w & 0xffffu), a7 = bf2f(u.w >> 16);
                s2 += (a0 * a0 + a1 * a1) + (a2 * a2 + a3 * a3) + (a4 * a4 + a5 * a5) + (a6 * a6 + a7 * a7); }
            m2 = fmaxf(m2, s2); }
        m2 = wave_max(m2);
        __syncthreads();
        if (C.lane == 0) red[C.wave] = m2;
        __syncthreads();
        if (C.tid == 0) { const float m = fmaxf(fmaxf(fmaxf(red[0], red[1]), fmaxf(red[2], red[3])), fmaxf(fmaxf(red[4], red[5]), fmaxf(red[6], red[7])));
            __hip_atomic_fetch_max(KN + bh, __float_as_uint(m), __ATOMIC_RELAXED, __HIP_MEMORY_SCOPE_AGENT); }
    }
}
__device__ __forceinline__ void p_norm2(const Ctx& C0, int l, int dup = 0) {
    PHASE_PROLOG(C0);
    unsigned char* wsw = ws + (dup ? DUMMY_OFF : (size_t)0);
    const bf16* xcur = WSP(bf16, WS_XCUR); const float* mod = WSP(float, WS_MOD);
    bf16* H = (bf16*)(wsw + WS_H);
    const float* rwt = WSP(float, WS_RWT) + (size_t)l * 32 * 1024;
    int* tope = (int*)(wsw + WS_TOPE); float* topg = (float*)(wsw + WS_TOPG); int* slot = (int*)(wsw + WS_SLOT);
    unsigned* cnt = (unsigned*)(wsw + WS_CTL) + CW_CNT + l * 32;
    LAS float* wl = (LAS float*)C.lds;
    for (int i = C.tid; i < 32 * 256; i += NTHR) *(LAS f32x4*)(wl + 4 * i) = *(const f32x4*)(rwt + 4 * i);
    LAS unsigned* lcnt = (LAS unsigned*)(C.lds + 131072);
    LAS unsigned* lbase = lcnt + 32;
    LAS int* le = (LAS int*)(lbase + 32);
    LAS int* ls = le + 256;
    LAS float* lg = (LAS float*)(ls + 256);
    int* etok = WSP(int, WS_ETOK); float* egate = WSP(float, WS_EGATE);
    const float* p_nfg = INP(I_NFG); const float* p_rb = INP(I_RB);
    for (int chunk = blockIdx.x; chunk < T / 64; chunk += gridDim.x) {
        if (C.tid < 32) lcnt[C.tid] = 0u;
        __syncthreads();
        const int b = (chunk * 64) / S;
        const float* mrow = mod + ((size_t)l * 4 + b) * 6144;
#pragma unroll 1
        for (int pr = 0; pr < 2; ++pr) {
            const int ri0 = C.wave * 8 + pr * 4, t0 = chunk * 64 + ri0;
            int ln = C.lane; asm volatile("" : "+v"(ln));
            f32x4 v[4][4]; float ss[4];
#pragma unroll
            for (int rr = 0; rr < 4; ++rr) { float a = 0.f;
#pragma unroll
                for (int j = 0; j < 4; ++j) { const v2u u = *(const v2u*)(xcur + (size_t)(t0 + rr) * D + 4 * (ln + 64 * j));
                    v[rr][j] = (f32x4){bf2f(u.x & 0xffffu), bf2f(u.x >> 16), bf2f(u.y & 0xffffu), bf2f(u.y >> 16)}; a += (v[rr][j].x * v[rr][j].x + v[rr][j].y * v[rr][j].y) + (v[rr][j].z * v[rr][j].z + v[rr][j].w * v[rr][j].w); }
                ss[rr] = a; }
            float rinv[4];
#pragma unroll
            for (int rr = 0; rr < 4; ++rr) rinv[rr] = rsqrtf(wave_sum(ss[rr]) * (1.f / D) + EPS);
            f32x4 h[4][4];
#pragma unroll
            for (int j = 0; j < 4; ++j) { const int i0 = 4 * (ln + 64 * j);
                const f32x4 g = *(const f32x4*)(p_nfg + l * D + i0), sh = *(const f32x4*)(mrow + 3 * 1024 + i0), scl = *(const f32x4*)(mrow + 4 * 1024 + i0);
                const f32x4 gs = g * (scl + 1.f);
#pragma unroll
                for (int rr = 0; rr < 4; ++rr) { h[rr][j] = v[rr][j] * rinv[rr] * gs + sh;
                    v2u o; o.x = pk2(h[rr][j].x, h[rr][j].y); o.y = pk2(h[rr][j].z, h[rr][j].w);
                    *(v2u*)(H + (size_t)(t0 + rr) * D + i0) = o; } }
            float res[4];
            router_dots4(h, wl, C.lane, res);
            const float rb = p_rb[l * NE + (C.lane >> 1)];
#pragma unroll
            for (int rr = 0; rr < 4; ++rr) {
                float mine = res[rr] + rb;
                float tv[4]; int te[4];
#pragma unroll
                for (int k = 0; k < 4; ++k) {
                    const float mx = wave_max(mine);
                    const unsigned long long bm = __ballot(mine == mx);
                    const int idx = __builtin_ctzll(bm) >> 1;
                    tv[k] = mx; te[k] = idx;
                    if ((C.lane >> 1) == idx) mine = NEGBIG * 2.f;
                }
                const float e1 = __expf(tv[1] - tv[0]), e2 = __expf(tv[2] - tv[0]), e3 = __expf(tv[3] - tv[0]);
                const float inv = 1.f / (1.f + e1 + e2 + e3);
                if (C.lane < 4) {
                    const int k = C.lane, ri = ri0 + rr, t = t0 + rr;
                    const int ek = (k == 0) ? te[0] : (k == 1) ? te[1] : (k == 2) ? te[2] : te[3];
                    const float gk = ((k == 0) ? 1.f : (k == 1) ? e1 : (k == 2) ? e2 : e3) * inv;
                    tope[t * 4 + k] = ek; topg[t * 4 + k] = gk;
                    le[ri * 4 + k] = ek; ls[ri * 4 + k] = (int)atomicAdd((unsigned*)(lcnt + ek), 1u); lg[ri * 4 + k] = gk;
                }
            }
        }
        __syncthreads();
        int tt = C.tid; asm volatile("" : "+v"(tt));
        if (tt < 32) lbase[tt] = atomicAdd(cnt + tt, lcnt[tt]);
        __syncthreads();
        if (tt < 256) { const int e = le[tt], s = (int)lbase[e] + ls[tt]; slot[(size_t)chunk * 256 + tt] = s;
            if (!dup) { etok[e * 16384 + s] = chunk * 64 + (tt >> 2); egate[e * 16384 + s] = lg[tt]; } }
        __syncthreads();
    }
}

__device__ __forceinline__ void p_gather(const Ctx& C0, int l) {
    PHASE_PROLOG(C0);
    const bf16* H = WSP(bf16, WS_H); bf16* XG = WSP(bf16, WS_XG);
    const int* tope = WSP(int, WS_TOPE); const float* topg = WSP(float, WS_TOPG); const int* slot = WSP(int, WS_SLOT);
    int* rpos = WSP(int, WS_RPOS); float* rgate = WSP(float, WS_RGATE);
    const unsigned* cnt = WSP(unsigned, WS_CTL) + CW_CNT + l * 32;
    int pad = 0; if (C.lane < 32) pad = ((int)cnt[C.lane] + 255) & ~255;
    int inc = pad;
#pragma unroll
    for (int o = 1; o < 32; o <<= 1) { const int u = shl_(inc, C.lane - o); if (C.lane >= o) inc += u; }
    const int pstart = inc - pad;
    for (int t = C.gw; t < T; t += C.NGW) {
        const v4u h0 = *(const v4u*)(H + (size_t)t * D + 8 * C.lane), h1 = *(const v4u*)(H + (size_t)t * D + 512 + 8 * C.lane);
#pragma unroll
        for (int k = 0; k < 4; ++k) {
            const int e = tope[t * 4 + k]; const int row = shl_(pstart, e) + slot[t * 4 + k];
            *(v4u*)(XG + (size_t)row * D + 8 * C.lane) = h0; *(v4u*)(XG + (size_t)row * D + 512 + 8 * C.lane) = h1;
            if (C.lane == 0) { rpos[t * 4 + k] = row; rgate[row] = topg[t * 4 + k]; }
        }
    }
}


#ifndef USE_MFMA_GEMM
#define USE_MFMA_GEMM 1
#endif
#ifndef DUP_MASK
#define DUP_MASK 0
#endif
#define REP(k) _Pragma("unroll 1") for (int rep_ = 0; rep_ < 1 + ((DUP_MASK >> (k)) & 1); ++rep_)
__device__ __forceinline__ bool ph_in(int lo, int hi, int k) { asm volatile("" : "+s"(lo), "+s"(hi)); return lo <= k && k < hi; }
__global__ void __launch_bounds__(NTHR, 2) mega(Args args) {
    extern __shared__ __attribute__((aligned(16))) unsigned char lds_raw[];
    Ctx C0;
    C0.in = args.in; C0.out = args.out; C0.ws = args.ws; C0.lds = (LAS unsigned char*)lds_raw;
    C0.tid = threadIdx.x; C0.lane = C0.tid & 63; C0.wave = __builtin_amdgcn_readfirstlane(C0.tid >> 6);
    C0.gw = blockIdx.x * NWAVES + C0.wave; C0.NGW = gridDim.x * NWAVES;
    const int lo = args.ph_lo, hi = args.ph_hi;
    volatile LAS unsigned* barst = (volatile LAS unsigned*)(C0.lds + LDS_BYTES - 16);
    if (C0.tid < 4) barst[C0.tid] = 0u;
    if (C0.tid < 26) ((LAS unsigned long long*)(C0.lds + LDS_BYTES - 256))[C0.tid] = (unsigned long long)args.in[C0.tid];
    __syncthreads();
    XcdBarrier bar; bar.bar = (unsigned*)(args.ws + WS_CTL) + CW_BAR; bar.x = 0; bar.st = barst;
    const bool multi = (hi - lo) > 1;
    if (multi) bar = xcd_barrier_post((unsigned*)(args.ws + WS_CTL) + CW_BAR, barst);
#define IN(k) (ph_in(lo, hi, (k)))
#define SEAM(k) do { if (IN(k) && IN((k) + 1)) xcd_barrier(bar); } while (0)

    if (IN(0)) { REP(11) p_prologue(C0);
#if USE_MFMA_GEMM
        REP(0) p_convert(C0);
#endif
    }
    SEAM(0);
    for (int l = 0; l < DEPTH; ++l) {
        const int pb = 1 + l * 9;
        const bool even = (l & 1) == 0; const int e = l >> 1;
        if (IN(pb + 0)) { REP(8) p_norm1(C0, l, rep_); }
        SEAM(pb + 0);
        if (IN(pb + 1)) REP(1) {
            PHASE_PROLOG(C0);
#if USE_MFMA_GEMM
            pg8::Gemm g{WSP(bf16, WS_H), WSP(bf16, WS_WINT) + (size_t)l * 3072 * 1024, D};
            pg8::StaticOrder So; So.init(T, even ? 2816 : 3072, (int)gridDim.x, (int)blockIdx.x);
            pg8::EpiQKV E{WSP(bf16, WS_QKV), QP, WSP(unsigned, WS_CTL) + CW_KNP + l * 384, even ? 2 : 4, even ? 4 : 8};
            pg8::gemm_phase<pg8::EpiQKV, pg8::StaticOrder, true, true>(C.lds, C.tid, g, So, E);
#else
            const float* W = even ? INP(I_EWIN) + (size_t)e * D * EVEN_IN : INP(I_OWIN) + (size_t)e * D * ODD_IN;
            const int ldw = even ? EVEN_IN : ODD_IN, NT = even ? 22 : 24;
            bf16* QKV = WSP(bf16, WS_QKV);
            auto tf = [&](int, int, const float*& W0, const float*& W1) { W0 = W; W1 = W; return true; };
            auto epi = [&](int row, int col, const float* a0, const float*) {
                v2u o; o.x = pk2(a0[0], a0[1]); o.y = pk2(a0[2], a0[3]); *(v2u*)(QKV + (size_t)row * QP + col) = o; };
            simple_gemm<1>(C, WSP(bf16, WS_H), D, T / 64, NT, D, ldw, tf, epi);
#endif
        }
        SEAM(pb + 1);
        if (even) {
            if (IN(pb + 2)) REP(2) { p_cmp_mfma(C0, l); }
            SEAM(pb + 2);
        }
        if (IN(pb + 3)) { const int nrep_ = 1 + ((DUP_MASK >> (even ? 3 : 4)) & 1);
            _Pragma("unroll 1") for (int rep_ = 0; rep_ < nrep_; ++rep_) p_attn(C0, l); }
        SEAM(pb + 3);
        if (IN(pb + 4)) REP(10) {
            PHASE_PROLOG(C0);
#if USE_MFMA_GEMM
            pg8::Gemm g{WSP(bf16, WS_AO), WSP(bf16, WS_WOUTT) + (size_t)l * 1024 * 1024, D};
            pg8::StaticOrder So; So.init(T, D, (int)gridDim.x, (int)blockIdx.x);
            pg8::EpiOut E{(l == 0) ? INP(I_X) : (const float*)nullptr, WSP(bf16, WS_XCUR), (bf16*)(ws + (rep_ ? DUMMY_OFF : (size_t)0) + WS_XCUR), WSP(float, WS_MOD) + (size_t)l * 4 * 6144 + 2 * 1024};
            pg8::gemm_phase<pg8::EpiOut, pg8::StaticOrder, true, true>(C.lds, C.tid, g, So, E);
#else
            const float* W = even ? INP(I_EWOUT) + (size_t)e * D * D : INP(I_OWOUT) + (size_t)e * D * D;
            const float* xprev = (l == 0) ? INP(I_X) : WSP(float, WS_XCUR);
            float* xcur = WSP(float, WS_XCUR); const float* mod = WSP(float, WS_MOD);
            auto tf = [&](int, int, const float*& W0, const float*& W1) { W0 = W; W1 = W; return true; };
            auto epi = [&](int row, int col, const float* a0, const float*) {
                const int b = row / S; const f32x4 g1 = *(const f32x4*)(mod + ((size_t)l * 4 + b) * 6144 + 2 * 1024 + col);
                const f32x4 xp = *(const f32x4*)(xprev + (size_t)row * D + col);
                f32x4 o; o.x = xp.x + g1.x * a0[0]; o.y = xp.y + g1.y * a0[1]; o.z = xp.z + g1.z * a0[2]; o.w = xp.w + g1.w * a0[3];
                *(f32x4*)(xcur + (size_t)row * D + col) = o; };
            simple_gemm<1>(C, WSP(bf16, WS_AO), D, T / 64, 8, D, D, tf, epi);
#endif
        }
        SEAM(pb + 4);
        if (IN(pb + 5)) { REP(9) p_norm2(C0, l, rep_); }
        SEAM(pb + 5);
        if (IN(pb + 7)) REP(6) {
            PHASE_PROLOG(C0);
#if USE_MFMA_GEMM
            LAS int* tp = (LAS int*)(C.lds + 131072);
            moe_tile_prefix(WSP(unsigned, WS_CTL) + CW_CNT + l * 32, tp, C.tid);
            pg8::Gemm g{WSP(bf16, WS_H), WSP(bf16, WS_WGUT) + (size_t)l * 32 * 2048 * 1024, D};
            pg8::MoeOrder So{tp, 8, (int)gridDim.x, (int)blockIdx.x, WSP(int, WS_ETOK)};
            pg8::EpiMoe1 E{WSP(bf16, WS_ACT), INP(I_BG) + (size_t)l * NE * FF, INP(I_BU) + (size_t)l * NE * FF, nullptr};
            pg8::gemm_phase<pg8::EpiMoe1, pg8::MoeOrder, true, true, true>(C.lds, C.tid, g, So, E);
#else
            const unsigned* cnt = WSP(unsigned, WS_CTL) + CW_CNT + l * 32;
            bf16* ACT = WSP(bf16, WS_ACT);
            const float* WG = INP(I_WG) + (size_t)l * NE * D * FF; const float* WU = INP(I_WU) + (size_t)l * NE * D * FF;
            const float* BG = INP(I_BG) + (size_t)l * NE * FF;    const float* BU = INP(I_BU) + (size_t)l * NE * FF;
            int ecur = 0;
            auto tf = [&](int mt, int, const float*& W0, const float*& W1) { const int ex = expert_of_row(cnt, mt * 64); if (ex < 0) return false;
                ecur = ex; W0 = WG + (size_t)ex * D * FF; W1 = WU + (size_t)ex * D * FF; return true; };
            auto epi = [&](int row, int col, const float* a0, const float* a1) {
                const f32x4 bg = *(const f32x4*)(BG + ecur * FF + col), bu = *(const f32x4*)(BU + ecur * FF + col);
                float o[4];
#pragma unroll
                for (int j = 0; j < 4; ++j) { const float hg = fminf(a0[j] + bg[j], 7.f), hu = fminf(fmaxf(a1[j] + bu[j], -7.f), 7.f);
                    o[j] = hg * sigmoidf_(1.702f * hg) * (hu + 1.f); }
                v2u w; w.x = pk2(o[0], o[1]); w.y = pk2(o[2], o[3]); *(v2u*)(ACT + (size_t)row * FF + col) = w; };
            simple_gemm<2>(C, WSP(bf16, WS_XG), D, PMAX / 64, 8, D, FF, tf, epi);
#endif
        }
        SEAM(pb + 7);
        if (IN(pb + 8)) REP(7) {
            PHASE_PROLOG(C0);
#if USE_MFMA_GEMM
            LAS int* tp = (LAS int*)(C.lds + 131072);
            moe_tile_prefix(WSP(unsigned, WS_CTL) + CW_CNT + l * 32, tp, C.tid);
            pg8::Gemm g{WSP(bf16, WS_ACT), WSP(bf16, WS_WDT) + (size_t)l * 32 * 1024 * 1024, FF};
            pg8::MoeOrder So{tp, 4, (int)gridDim.x, (int)blockIdx.x, WSP(int, WS_ETOK)};
            pg8::EpiMoe2 E{WSP(bf16, WS_Y), INP(I_BD) + (size_t)l * NE * D, WSP(float, WS_EGATE), tp, nullptr};
            pg8::gemm_phase<pg8::EpiMoe2, pg8::MoeOrder, true, true>(C.lds, C.tid, g, So, E);
#else
            const unsigned* cnt = WSP(unsigned, WS_CTL) + CW_CNT + l * 32;
            bf16* Y = WSP(bf16, WS_Y); const float* rgate = WSP(float, WS_RGATE);
            const float* WD = INP(I_WD) + (size_t)l * NE * FF * D; const float* BD = INP(I_BD) + (size_t)l * NE * D;
            int ecur = 0;
            auto tf = [&](int mt, int, const float*& W0, const float*& W1) { const int ex = expert_of_row(cnt, mt * 64); if (ex < 0) return false;
                ecur = ex; W0 = WD + (size_t)ex * FF * D; W1 = W0; return true; };
            auto epi = [&](int row, int col, const float* a0, const float*) {
                const f32x4 bd = *(const f32x4*)(BD + ecur * D + col); const float gt = rgate[row];
                v2u w; w.x = pk2((a0[0] + bd.x) * gt, (a0[1] + bd.y) * gt); w.y = pk2((a0[2] + bd.z) * gt, (a0[3] + bd.w) * gt);
                *(v2u*)(Y + (size_t)row * D + col) = w; };
            simple_gemm<1>(C, WSP(bf16, WS_ACT), FF, PMAX / 64, 8, FF, D, tf, epi);
#endif
        }
        SEAM(pb + 8);
    }
    if (IN(37)) { p_norm1(C0, 4); }
#undef IN
#undef SEAM
}

constexpr int NPHASE = 38;
#ifndef MK_PER_PHASE
#define MK_PER_PHASE 0
#endif

extern "C" void kernel_launch(void* const* d_in, const int* in_sizes, int n_in, void* d_out, int out_size, void* d_ws, size_t ws_size, hipStream_t stream) {
    static int grid = 0;
    if (grid == 0) {
        if (n_in != 26 || ws_size < WS_END) { fprintf(stderr, "kernel_launch: unexpected n_in %d / ws %zu\n", n_in, ws_size); grid = -1; return; }
        int dev = 0, cus = 0, per_cu = 0;
        hipGetDevice(&dev); hipDeviceGetAttribute(&cus, hipDeviceAttributeMultiprocessorCount, dev);
        hipFuncSetAttribute((const void*)mega, hipFuncAttributeMaxDynamicSharedMemorySize, LDS_BYTES);
        hipOccupancyMaxActiveBlocksPerMultiprocessor(&per_cu, (const void*)mega, NTHR, LDS_BYTES);
        (void)hipGetLastError();
        grid = cus > 0 ? cus : 256;
    }
    if (grid < 0) return;
    hipMemsetAsync((char*)d_ws + WS_CTL, 0, CTL_ZERO_BYTES, stream);
    Args a{};
    for (int i = 0; i < 26; ++i) a.in[i] = (const float*)d_in[i];
    a.out = (float*)d_out; a.ws = (unsigned char*)d_ws;
#if MK_PER_PHASE
    for (int ph = 0; ph < NPHASE; ++ph) {
        a.ph_lo = ph; a.ph_hi = ph + 1;
        hipLaunchKernelGGL(mega, dim3(grid), dim3(NTHR), LDS_BYTES, stream, a);
    }
#else
    a.ph_lo = 0; a.ph_hi = NPHASE;
    hipLaunchKernelGGL(mega, dim3(grid), dim3(NTHR), LDS_BYTES, stream, a);
#endif
}
```
